# Optimizing an MI355X kernel written in HIP

```python
import math
import jax, jax.numpy as jnp
from jax import lax
import numpy as np

D_MODEL = 2048
BATCH = 2
SEQ = 8192
DEPTH = 4

N_A = DEPTH // 2
N_B = DEPTH - N_A
N_HEADS = 16
HEAD_DIM = 128
N_KV = 4
GROUP = N_HEADS // N_KV
IDX_HEADS = 16
IDX_DIM = 64
TOPK_MAX = 256
WINDOW = 128
BLOCK = 128
N_BUCKETS = 32
MAX_DIST = 128
D_FF = ((8 * D_MODEL + 3 * 256 - 1) // (3 * 256)) * 256
PLE_DIM = 256
EPS = 1e-6
NEG = -1e30

A_Q = N_HEADS * HEAD_DIM
A_KV = N_KV * HEAD_DIM
A_QI = IDX_HEADS * IDX_DIM
A_IN = A_Q + 2 * A_KV + A_QI + IDX_DIM + IDX_HEADS
A_SPLITS = [A_Q, A_Q + A_KV, A_Q + 2 * A_KV, A_Q + 2 * A_KV + A_QI, A_Q + 2 * A_KV + A_QI + IDX_DIM]

kernel_name = "yoco_dsa_swa_sink_hybrid"


def rmsnorm(x, g):
    xf = x.astype(jnp.float32)
    y = xf * lax.rsqrt(jnp.mean(xf * xf, axis=-1, keepdims=True) + EPS)
    return (y * g.astype(jnp.float32)).astype(x.dtype)


def t5_bucket(rel):
    n = jnp.maximum(rel, 0)
    max_exact = N_BUCKETS // 2
    nf = jnp.maximum(n, 1).astype(jnp.float32)
    large = max_exact + (jnp.log(nf / max_exact) / math.log(MAX_DIST / max_exact)
                         * (N_BUCKETS - max_exact)).astype(jnp.int32)
    large = jnp.minimum(large, N_BUCKETS - 1)
    return jnp.where(n < max_exact, n, large)


def swiglu(h, w1, w3, w2):
    return (jax.nn.silu(h @ w1) * (h @ w3)) @ w2


def dsa_attention(h, w_in, w_out, rel_bias):
    B, S, _ = h.shape
    nb = S // BLOCK
    topk = min(TOPK_MAX, S // 4)
    proj = h @ w_in
    q, k, v, qi, ki, wi = jnp.split(proj, A_SPLITS, axis=-1)
    q = q.reshape(B, nb, BLOCK, N_KV, GROUP, HEAD_DIM).swapaxes(0, 1)
    k = k.reshape(B, S, N_KV, HEAD_DIM)
    v = v.reshape(B, S, N_KV, HEAD_DIM)
    qi = qi.reshape(B, nb, BLOCK, IDX_HEADS, IDX_DIM).swapaxes(0, 1)
    wi = wi.reshape(B, nb, BLOCK, IDX_HEADS).swapaxes(0, 1)
    key_pos = jnp.arange(S)

    def block_fn(args):
        j, qb, qib, wib = args
        t = j * BLOCK + jnp.arange(BLOCK)
        sc = jnp.einsum('bqhd,bsd->bqhs', qib, ki).astype(jnp.float32) * (IDX_DIM ** -0.5)
        w = wib.astype(jnp.float32) * (IDX_HEADS ** -0.5)
        score = jnp.einsum('bqhs,bqh->bqs', jax.nn.relu(sc), w)
        causal = key_pos[None, :] <= t[:, None]
        score = jnp.where(causal[None], score, NEG)
        _, idx = lax.top_k(score, topk)
        ks = jax.vmap(lambda kb, ib: kb[ib])(k, idx)
        vs = jax.vmap(lambda vb, ib: vb[ib])(v, idx)
        logits = jnp.einsum('bqgrd,bqkgd->bqgrk', qb, ks).astype(jnp.float32) * (HEAD_DIM ** -0.5)
        rel = t[None, :, None] - idx
        bias = rel_bias[t5_bucket(rel)].astype(jnp.float32)
        bias = bias.reshape(B, BLOCK, topk, N_KV, GROUP).transpose(0, 1, 3, 4, 2)
        valid = (rel >= 0)[:, :, None, None, :]
        logits = jnp.where(valid, logits + bias, NEG)
        probs = jax.nn.softmax(logits, axis=-1).astype(vs.dtype)
        return jnp.einsum('bqgrk,bqkgd->bqgrd', probs, vs)

    out = lax.map(block_fn, (jnp.arange(nb), q, qi, wi))
    out = out.swapaxes(0, 1).reshape(B, S, A_Q)
    return out @ w_out


def band_blocks(a):
    B, S = a.shape[0], a.shape[1]
    ab = a.reshape(B, S // BLOCK, BLOCK, N_KV, HEAD_DIM)
    prev = jnp.pad(ab[:, :-1], ((0, 0), (1, 0), (0, 0), (0, 0), (0, 0)))
    return jnp.concatenate([prev, ab], axis=2)


def swa_attention(h, w_q, w_out, sinks, k_band, v_band, bias_band, valid):
    B, S, _ = h.shape
    nb = S // BLOCK
    q = (h @ w_q).reshape(B, nb, BLOCK, N_KV, GROUP, HEAD_DIM)
    logits = jnp.einsum('bnqgrd,bnkgd->bngrqk', q, k_band).astype(jnp.float32) * (HEAD_DIM ** -0.5)
    logits = jnp.where(valid[None, :, None, None], logits + bias_band[None, None], NEG)
    sink = jnp.broadcast_to(sinks.astype(jnp.float32).reshape(N_KV, GROUP, 1, 1), logits.shape[:-1] + (1,))
    probs = jax.nn.softmax(jnp.concatenate([logits, sink], axis=-1), axis=-1)[..., :-1]
    out = jnp.einsum('bngrqk,bnkgd->bnqgrd', probs.astype(v_band.dtype), v_band)
    return out.reshape(B, S, A_Q) @ w_out


def setup_inputs(seed: int = 0) -> dict:
    key = jax.random.key(seed)
    ks = jax.random.split(key, 20)
    f32 = jnp.float32

    def w(k, shape, fan_in):
        return jax.random.normal(k, shape, f32) * (fan_in ** -0.5)

    def gain(k, shape):
        return 1.0 + 0.02 * jax.random.normal(k, shape, f32)

    return {
        "x": jax.random.normal(ks[0], (BATCH, SEQ, D_MODEL), f32),
        "p": jax.random.normal(ks[1], (DEPTH, BATCH, SEQ, PLE_DIM), f32),
        "w_in_a": w(ks[2], (N_A, D_MODEL, A_IN), D_MODEL),
        "w_out_a": w(ks[3], (N_A, A_Q, D_MODEL), A_Q),
        "w_q_b": w(ks[4], (N_B, D_MODEL, A_Q), D_MODEL),
        "w_out_b": w(ks[5], (N_B, A_Q, D_MODEL), A_Q),
        "sinks": jax.random.normal(ks[6], (N_B, N_HEADS), f32),
        "g_kv": gain(ks[7], (D_MODEL,)),
        "w_kv": w(ks[8], (D_MODEL, 2 * A_KV), D_MODEL),
        "rel_bias": 0.5 * jax.random.normal(ks[9], (N_BUCKETS, N_HEADS), f32),
        "g_attn": gain(ks[10], (DEPTH, D_MODEL)),
        "g_ffn": gain(ks[11], (DEPTH, D_MODEL)),
        "w1": w(ks[12], (DEPTH, D_MODEL, D_FF), D_MODEL),
        "w3": w(ks[13], (DEPTH, D_MODEL, D_FF), D_MODEL),
        "w2": w(ks[14], (DEPTH, D_FF, D_MODEL), D_FF),
        "g_pe": gain(ks[15], (DEPTH, D_MODEL)),
        "w_pe": w(ks[16], (DEPTH, PLE_DIM, D_MODEL), PLE_DIM),
        "w_pg": w(ks[17], (DEPTH, D_MODEL, D_MODEL), D_MODEL),
        "g_final": gain(ks[18], (D_MODEL,)),
    }


def reference(x, p, w_in_a, w_out_a, w_q_b, w_out_b, sinks, g_kv, w_kv, rel_bias,
              g_attn, g_ffn, w1, w3, w2, g_pe, w_pe, w_pg, g_final):
    B, S, _ = x.shape
    nb = S // BLOCK
    qi_ = jnp.arange(BLOCK)
    ci_ = jnp.arange(2 * BLOCK)
    rel = qi_[:, None] + BLOCK - ci_[None, :]
    in_win = (rel >= 0) & (rel < WINDOW)
    key_abs = jnp.arange(nb)[:, None, None] * BLOCK - BLOCK + ci_[None, None, :]
    valid = in_win[None] & (key_abs >= 0)
    bias_band = rel_bias[t5_bucket(rel)].astype(jnp.float32)
    bias_band = bias_band.reshape(BLOCK, 2 * BLOCK, N_KV, GROUP).transpose(2, 3, 0, 1)

    k_band = None
    v_band = None
    for i in range(DEPTH):
        h = rmsnorm(x, g_attn[i])
        if i < N_A:
            x = x + dsa_attention(h, w_in_a[i], w_out_a[i], rel_bias)
        else:
            j = i - N_A
            x = x + swa_attention(h, w_q_b[j], w_out_b[j], sinks[j], k_band, v_band, bias_band, valid)
        x = x + swiglu(rmsnorm(x, g_ffn[i]), w1[i], w3[i], w2[i])
        gate = jax.nn.sigmoid(rmsnorm(x, g_pe[i]) @ w_pg[i])
        x = x + (p[i] @ w_pe[i]) * gate
        if i == N_A - 1:
            kv = rmsnorm(x, g_kv) @ w_kv
            k_s, v_s = jnp.split(kv, 2, axis=-1)
            k_band = band_blocks(k_s.reshape(B, S, N_KV, HEAD_DIM))
            v_band = band_blocks(v_s.reshape(B, S, N_KV, HEAD_DIM))
    return rmsnorm(x, g_final)
```

```cpp
#include <hip/hip_runtime.h>
#include <cstdio>
#include <cstdint>
#ifndef MK_PER_PHASE
#define MK_PER_PHASE 0
#endif
namespace pg8 {
#define PG8_LAS __attribute__((address_space(3)))
typedef unsigned short bf16_t;
typedef short bf16x8 __attribute__((ext_vector_type(8)));
typedef float f32x4 __attribute__((ext_vector_type(4)));
typedef unsigned u32x4 __attribute__((ext_vector_type(4)));
constexpr int BM = 256, BK = 64, HALF = 128, HTB = HALF * BK * 2  , STAGE_BYTES = 8 * HTB, NXCD = 8, WGM = 8;

__host__ __device__ __forceinline__ int lds_byte(int r, int c) { const int st = (r >> 4) * 2 + (c >> 5), rr = r & 15, cc = c & 31, ob = rr * 64 + cc * 2; return st * 1024 + (ob ^ (((ob >> 9) & 1) << 5)); }
__host__ __device__ __forceinline__ void stage_rc(int b, int& R, int& C) { const int st = b / 1024, sb = b % 1024, swz = sb ^ (((sb >> 9) & 1) << 5); R = (st >> 1) * 16 + swz / 64; C = (st & 1) * 32 + (swz % 64) / 2; }
__host__ __device__ __forceinline__ int perm32(int rho) { const int n = rho >> 4, i = rho & 15; return 8 * (i >> 2) + 4 * n + (i & 3); }

struct Unit { int pm, pn, ord; };
struct Gemm { const bf16_t* A; const bf16_t* Bt; int M, N, K; int tiledA; };

struct StaticOrder {
    int nM, nN, nwg, G, c;
    __host__ __device__ void init(int M, int N, int G_, int c_) { nM = M / BM; nN = N / BM; nwg = nM * nN; G = G_; c = c_; }
    __host__ __device__ bool next(int i, Unit& u) const {
        const long L = (long)i * G + c; if (L >= nwg) return false;
        int wgid = (int)L; { const int q = nwg / NXCD, r = nwg % NXCD, xcd = wgid % NXCD, off = wgid / NXCD; wgid = (xcd < r ? xcd * (q + 1) : r * (q + 1) + (xcd - r) * q) + off; }
        const int nig = WGM * nN, gid = wgid / nig, fm = gid * WGM, gsz = (nM - fm) < WGM ? (nM - fm) : WGM;
        u.pm = fm + ((wgid % nig) % gsz); u.pn = (wgid % nig) / gsz; u.ord = i; return true;
    }
    __device__ __forceinline__ void a_ready(const Unit&) const {}
    __device__ __forceinline__ void done(const Unit&) const {}
};

__device__ __forceinline__ unsigned cvt_pk_bf16(float lo, float hi) { unsigned r; asm volatile("v_cvt_pk_bf16_f32 %0, %1, %2" : "=v"(r) : "v"(lo), "v"(hi)); return r; }
#define PG8_GAS __attribute__((address_space(1)))

__device__ __forceinline__ float fast_sigmoid(float a) { return __builtin_amdgcn_rcpf(1.0f + __builtin_amdgcn_exp2f(-1.4426950408889634f * a)); }

__device__ __forceinline__ void row_scales(const PG8_LAS float* rtab, const Unit& u, int wr, int fr, float (&r)[2][4]) {
#pragma unroll
    for (int ai = 0; ai < 2; ++ai)
#pragma unroll
        for (int m = 0; m < 4; ++m) r[ai][m] = rtab ? rtab[u.ord * BM + ai * HALF + wr * 64 + m * 16 + fr] : 1.0f;
}
template <class Sched> __device__ __forceinline__ void rs_finalize(PG8_LAS float* rtab, const Sched& S, const float* ssp, int tid) {
    const int row = tid >> 1, h = tid & 1;
    for (int i0 = 0; ; i0 += 4) {
        Unit u[4]; bool ok[4]; f32x4 v[4][4];
#pragma unroll
        for (int j = 0; j < 4; ++j) { ok[j] = S.next(i0 + j, u[j]); if (!ok[j]) u[j].pm = 0; }
        if (!ok[0]) break;
#pragma unroll
        for (int j = 0; j < 4; ++j) { const PG8_GAS f32x4* p = (const PG8_GAS f32x4*)(ssp + ((size_t)(u[j].pm * BM + row)) * 32 + h * 16);
#pragma unroll
            for (int e = 0; e < 4; ++e) v[j][e] = p[e]; }
#pragma unroll
        for (int j = 0; j < 4; ++j) { const f32x4 a = v[j][0], b = v[j][1], c = v[j][2], d = v[j][3];
            const float s = (((a[0] + a[1]) + (a[2] + a[3])) + ((b[0] + b[1]) + (b[2] + b[3]))) + (((c[0] + c[1]) + (c[2] + c[3])) + ((d[0] + d[1]) + (d[2] + d[3])));
            const float o = __shfl_xor(s, 1); const float tot = h ? (o + s) : (s + o);
            if (h == 0 && ok[j]) rtab[(i0 + j) * BM + row] = __builtin_amdgcn_rsqf(tot * (1.0f / 2048.0f) + 1e-6f); }
    }
    __syncthreads();
}
struct EpiBf16Map {
    static constexpr bool PERM = true, AFTER_DRAIN = false;
    int kind; bf16_t* O; int ldc; bf16_t* KV; bf16_t* QI; bf16_t* KIW; const PG8_LAS float* rtab; bf16_t* KIT;
    __device__ __forceinline__ void operator()(const f32x4 (&acc)[2][2][4][2], const Unit& u, int wr, int wc, int fr, int fq) const {
        const int row0 = u.pm * BM + wr * 64 + fr; bf16_t* base; int ld;
        if (kind == 0) { base = O + u.pn * BM; ld = ldc; }
        else if (kind == 3) { base = O + ((size_t)(u.pm * 8 + u.pn) << 16) - (size_t)u.pm * BM * 256; ld = 256; }
        else if (kind == 1) {
            if (u.pn < 8) { base = O + u.pn * BM; ld = 2048; }
            else if (u.pn < 12) { const int b = u.pm >> 5, g = u.pn - 8; base = KV + ((size_t)(b * 4 + g) * 8192 - (size_t)b * 8192) * 256; ld = 256; }
            else if (u.pn < 16) { base = QI + (u.pn - 12) * BM; ld = 1024; }
            else { base = KIW; ld = 256; }
        } else { const int b = u.pm >> 5, g = u.pn; base = KV + ((size_t)(b * 4 + g) * 8192 - (size_t)b * 8192) * 256; ld = 256; }
        const int col0 = wc * 32 + 8 * fq; float rs[2][4]; row_scales(rtab, u, wr, fr, rs);
        if (kind == 1 && u.pn == 16) {
            if (wc < 2) {
#pragma unroll
                for (int ai = 0; ai < 2; ++ai)
#pragma unroll
                    for (int m = 0; m < 4; ++m) { const int row = row0 + ai * HALF + m * 16, d0 = wc * 32 + 8 * fq;
                        bf16_t* dst = QI  ; dst = KIT + ((size_t)((row >> 5) * 4 + (d0 >> 4)) * 64 + ((d0 >> 3) & 1) * 32 + (row & 31)) * 8;
                        const f32x4 v0 = acc[ai][0][m][0] * rs[ai][m], v1 = acc[ai][0][m][1] * rs[ai][m];
                        u32x4 w; w.x = cvt_pk_bf16(v0[0], v0[1]); w.y = cvt_pk_bf16(v0[2], v0[3]); w.z = cvt_pk_bf16(v1[0], v1[1]); w.w = cvt_pk_bf16(v1[2], v1[3]);
                        *(PG8_GAS u32x4*)dst = w; }
            } else if (wc == 2 && fq < 2) {
#pragma unroll
                for (int ai = 0; ai < 2; ++ai)
#pragma unroll
                    for (int m = 0; m < 4; ++m) { bf16_t* rowp = KIW + (size_t)(row0 + ai * HALF + m * 16) * 256 + col0;
                        const f32x4 v0 = acc[ai][0][m][0] * rs[ai][m], v1 = acc[ai][0][m][1] * rs[ai][m];
                        u32x4 w; w.x = cvt_pk_bf16(v0[0], v0[1]); w.y = cvt_pk_bf16(v0[2], v0[3]); w.z = cvt_pk_bf16(v1[0], v1[1]); w.w = cvt_pk_bf16(v1[2], v1[3]);
                        *(PG8_GAS u32x4*)rowp = w; }
            }
            return;
        }
        if (kind == 1 && u.pn >= 8 && u.pn < 12) {
            unsigned char* b8 = (unsigned char*)KV + ((size_t)((u.pm >> 5) * 4 + (u.pn - 8)) * 8192 - (size_t)(u.pm >> 5) * 8192) * 256 + col0;
#pragma unroll
            for (int ai = 0; ai < 2; ++ai)
#pragma unroll
                for (int m = 0; m < 4; ++m) { unsigned char* rowp = b8 + (size_t)(row0 + ai * HALF + m * 16) * 256; const float sc = rs[ai][m] * 16.0f;
#pragma unroll
                    for (int bj = 0; bj < 2; ++bj) { const f32x4 v0 = acc[ai][bj][m][0] * sc, v1 = acc[ai][bj][m][1] * sc; typedef unsigned u32x2 __attribute__((ext_vector_type(2)));
                        int w0 = __builtin_amdgcn_cvt_pk_fp8_f32(v0[0], v0[1], 0, false); w0 = __builtin_amdgcn_cvt_pk_fp8_f32(v0[2], v0[3], w0, true);
                        int w1 = __builtin_amdgcn_cvt_pk_fp8_f32(v1[0], v1[1], 0, false); w1 = __builtin_amdgcn_cvt_pk_fp8_f32(v1[2], v1[3], w1, true);
                        u32x2 w; w.x = (unsigned)w0; w.y = (unsigned)w1; *(PG8_GAS u32x2*)(rowp + bj * HALF) = w; } }
            return;
        }
#pragma unroll
        for (int ai = 0; ai < 2; ++ai)
#pragma unroll
            for (int m = 0; m < 4; ++m) { bf16_t* rowp = base + (size_t)(row0 + ai * HALF + m * 16) * ld + col0;
#pragma unroll
                for (int bj = 0; bj < 2; ++bj) { const f32x4 v0 = acc[ai][bj][m][0] * rs[ai][m], v1 = acc[ai][bj][m][1] * rs[ai][m];
                    u32x4 w; w.x = cvt_pk_bf16(v0[0], v0[1]); w.y = cvt_pk_bf16(v0[2], v0[3]); w.z = cvt_pk_bf16(v1[0], v1[1]); w.w = cvt_pk_bf16(v1[2], v1[3]);
                    *(PG8_GAS u32x4*)(rowp + bj * HALF) = w; } }
    }
};
__device__ __forceinline__ float bflo(unsigned w) { return __uint_as_float(w << 16); }
__device__ __forceinline__ float bfhi(unsigned w) { return __uint_as_float(w & 0xffff0000u); }
typedef float f32x2 __attribute__((ext_vector_type(2)));
__device__ __forceinline__ f32x2 bf2(unsigned w) { f32x2 r; r.x = bflo(w); r.y = bfhi(w); return r; }
typedef __bf16 bf16x2_t __attribute__((ext_vector_type(2)));
__device__ __forceinline__ float ssq2(unsigned w, float acc) { return __builtin_amdgcn_fdot2_f32_bf16(__builtin_bit_cast(bf16x2_t, w), __builtin_bit_cast(bf16x2_t, w), acc, false); }
#define PG8_LO2(v) __builtin_shufflevector(v, v, 0, 1)
#define PG8_HI2(v) __builtin_shufflevector(v, v, 2, 3)
__device__ __forceinline__ void sig8(f32x4& s0, f32x4& s1, const f32x4 a0, const f32x4 a1, float nrs) {
    f32x4 t0 = a0 * nrs, t1 = a1 * nrs;
    __builtin_amdgcn_sched_barrier(0);
#pragma unroll
    for (int e = 0; e < 4; ++e) { t0[e] = __builtin_amdgcn_exp2f(t0[e]); t1[e] = __builtin_amdgcn_exp2f(t1[e]); }
    __builtin_amdgcn_sched_barrier(0);
    t0 = t0 + 1.0f; t1 = t1 + 1.0f;
    __builtin_amdgcn_sched_barrier(0);
#pragma unroll
    for (int e = 0; e < 4; ++e) { t0[e] = __builtin_amdgcn_rcpf(t0[e]); t1[e] = __builtin_amdgcn_rcpf(t1[e]); }
    __builtin_amdgcn_sched_barrier(0);
    s0 = t0; s1 = t1;
}
struct EpiResid {
    static constexpr bool PERM = true, AFTER_DRAIN = false;
    const bf16_t* Xin; bf16_t* Xout; float* ssp;
    __device__ __forceinline__ void operator()(const f32x4 (&acc)[2][2][4][2], const Unit& u, int wr, int wc, int fr, int fq) const {
        const int row0 = u.pm * BM + wr * 64 + fr, rl0 = wr * 64 + fr, cl0 = wc * 32 + 8 * fq; const size_t tb = (size_t)(u.pm * 8 + u.pn) << 16;
        u32x4 xv[2][4][2];
#pragma unroll
        for (int ai = 0; ai < 2; ++ai)
#pragma unroll
            for (int m = 0; m < 4; ++m)
#pragma unroll
                for (int bj = 0; bj < 2; ++bj) xv[ai][m][bj] = *(const PG8_GAS u32x4*)(Xin + tb + (size_t)(rl0 + ai * HALF + m * 16) * 256 + cl0 + bj * HALF);
#pragma unroll
        for (int ai = 0; ai < 2; ++ai)
#pragma unroll
            for (int m = 0; m < 4; ++m) { float q; f32x2 qq = (f32x2){0.f, 0.f};
#pragma unroll
                for (int bj = 0; bj < 2; ++bj) { const u32x4 x = xv[ai][m][bj]; const f32x4 a0 = acc[ai][bj][m][0], a1 = acc[ai][bj][m][1];
                    const f32x2 o0 = bf2(x.x) + PG8_LO2(a0), o1 = bf2(x.y) + PG8_HI2(a0), o2 = bf2(x.z) + PG8_LO2(a1), o3 = bf2(x.w) + PG8_HI2(a1);
                    u32x4 w; w.x = cvt_pk_bf16(o0.x, o0.y); w.y = cvt_pk_bf16(o1.x, o1.y); w.z = cvt_pk_bf16(o2.x, o2.y); w.w = cvt_pk_bf16(o3.x, o3.y);
                    *(PG8_GAS u32x4*)(Xout + tb + (size_t)(rl0 + ai * HALF + m * 16) * 256 + cl0 + bj * HALF) = w;
                    qq.x = ssq2(w.x, qq.x); qq.y = ssq2(w.y, qq.y); qq.x = ssq2(w.z, qq.x); qq.y = ssq2(w.w, qq.y); }
                q = qq.x + qq.y;
                { auto r16_ = __builtin_amdgcn_permlane16_swap(__float_as_uint(q), __float_as_uint(q), false, false); q = __uint_as_float(r16_[0]) + __uint_as_float(r16_[1]); auto r32_ = __builtin_amdgcn_permlane32_swap(__float_as_uint(q), __float_as_uint(q), false, false); q = __uint_as_float(r32_[0]) + __uint_as_float(r32_[1]); }
                if (fq == 0) ((PG8_GAS float*)ssp)[(size_t)(row0 + ai * HALF + m * 16) * 32 + u.pn * 4 + wc] = q; }
    }
};
struct EpiSwiglu {
    static constexpr bool PERM = true, AFTER_DRAIN = false;
    bf16_t* U; const PG8_LAS float* rtab;
    __device__ __forceinline__ void operator()(const f32x4 (&acc)[2][2][4][2], const Unit& u, int wr, int wc, int fr, int fq) const {
        const int row0 = wr * 64 + fr; float rs[2][4]; row_scales(rtab, u, wr, fr, rs);
        bf16_t* const ub = U + ((size_t)(u.pm * 22 + (u.pn >> 1)) << 16) + (u.pn & 1) * HALF + wc * 32 + 8 * fq;
#ifndef EPI_SWIGLU_REP
#define EPI_SWIGLU_REP 1
#endif
        for (int er_ = 0; er_ < EPI_SWIGLU_REP; ++er_) { asm volatile("" ::: "memory");
#pragma unroll
        for (int ai = 0; ai < 2; ++ai)
#pragma unroll
            for (int m = 0; m < 4; ++m) { bf16_t* rowp = ub + (size_t)(row0 + ai * HALF + m * 16) * 256;
                f32x4 o[2]; const float rsv = rs[ai][m], rr = rsv * rsv;
                { f32x4 s0, s1; sig8(s0, s1, acc[ai][0][m][0], acc[ai][0][m][1], rsv * -1.4426950408889634f);
                  o[0] = (acc[ai][0][m][0] * acc[ai][1][m][0]) * (s0 * rr); o[1] = (acc[ai][0][m][1] * acc[ai][1][m][1]) * (s1 * rr); }
                u32x4 w; w.x = cvt_pk_bf16(o[0][0], o[0][1]); w.y = cvt_pk_bf16(o[0][2], o[0][3]); w.z = cvt_pk_bf16(o[1][0], o[1][1]); w.w = cvt_pk_bf16(o[1][2], o[1][3]);
                *(PG8_GAS u32x4*)rowp = w; }
        }
    }
};
struct EpiGate {
    static constexpr bool PERM = true, AFTER_DRAIN = false;
    const bf16_t* Xin; const bf16_t* PE; const PG8_LAS float* rtab; bf16_t* Xout; float* ssp;
    __device__ __forceinline__ void operator()(const f32x4 (&acc)[2][2][4][2], const Unit& u, int wr, int wc, int fr, int fq) const {
        const int row0 = u.pm * BM + wr * 64 + fr, rl0 = wr * 64 + fr, cl0 = wc * 32 + 8 * fq; const size_t tb = (size_t)(u.pm * 8 + u.pn) << 16;
#pragma unroll
        for (int ai = 0; ai < 2; ++ai) {
            u32x4 xv[4][2], pv[4][2];
#pragma unroll
            for (int m = 0; m < 4; ++m)
#pragma unroll
                for (int bj = 0; bj < 2; ++bj) { const size_t off = tb + (size_t)(rl0 + ai * HALF + m * 16) * 256 + cl0 + bj * HALF; xv[m][bj] = *(const PG8_GAS u32x4*)(Xin + off); pv[m][bj] = *(const PG8_GAS u32x4*)(PE + off); }
#pragma unroll
            for (int m = 0; m < 4; ++m) { float q; f32x2 qq = (f32x2){0.f, 0.f}; const float nr = rtab[u.ord * BM + ai * HALF + wr * 64 + m * 16 + fr] * -1.4426950408889634f;
#pragma unroll
                for (int bj = 0; bj < 2; ++bj) { const u32x4 x = xv[m][bj], p = pv[m][bj]; f32x4 s0, s1; sig8(s0, s1, acc[ai][bj][m][0], acc[ai][bj][m][1], nr);
                    const f32x2 o0 = bf2(x.x) + bf2(p.x) * PG8_LO2(s0), o1 = bf2(x.y) + bf2(p.y) * PG8_HI2(s0), o2 = bf2(x.z) + bf2(p.z) * PG8_LO2(s1), o3 = bf2(x.w) + bf2(p.w) * PG8_HI2(s1);
                    u32x4 w; w.x = cvt_pk_bf16(o0.x, o0.y); w.y = cvt_pk_bf16(o1.x, o1.y); w.z = cvt_pk_bf16(o2.x, o2.y); w.w = cvt_pk_bf16(o3.x, o3.y);
                    *(PG8_GAS u32x4*)(Xout + tb + (size_t)(rl0 + ai * HALF + m * 16) * 256 + cl0 + bj * HALF) = w;
                    qq.x = ssq2(w.x, qq.x); qq.y = ssq2(w.y, qq.y); qq.x = ssq2(w.z, qq.x); qq.y = ssq2(w.w, qq.y); }
                q = qq.x + qq.y;
                { auto r16_ = __builtin_amdgcn_permlane16_swap(__float_as_uint(q), __float_as_uint(q), false, false); q = __uint_as_float(r16_[0]) + __uint_as_float(r16_[1]); auto r32_ = __builtin_amdgcn_permlane32_swap(__float_as_uint(q), __float_as_uint(q), false, false); q = __uint_as_float(r32_[0]) + __uint_as_float(r32_[1]); }
                if (fq == 0) ((PG8_GAS float*)ssp)[(size_t)(row0 + ai * HALF + m * 16) * 32 + u.pn * 4 + wc] = q; }
            asm volatile("" ::: "memory"); }
    }
};
template <class Epi, class Sched, bool ALIGN_EPI = false, bool SP2 = false>
__device__ __forceinline__ void gemm_phase(PG8_LAS unsigned char* lds, const Gemm g, const Sched& S, const Epi& E) {
    int tid_l = threadIdx.x; asm volatile("" : "+v"(tid_l));
    const int tid = tid_l, wid = __builtin_amdgcn_readfirstlane(tid >> 6), lane = tid & 63, wr = wid >> 2, wc = wid & 3, fr = lane & 15, fq = lane >> 4;
    const int K = g.K, nt = K / BK;
    unsigned voffA[2], voffB[2];
#pragma unroll
    for (int i = 0; i < 2; ++i) { int R, C; stage_rc(tid * 16 + i * 8192, R, C); const int Rb = Epi::PERM ? ((R & ~31) + perm32(R & 31)) : R;
        voffA[i] = (unsigned)(R * (g.tiledA ? 256 : K) + C) * 2u; voffB[i] = (unsigned)(Rb * K + C) * 2u; }
    const unsigned kstep = (unsigned)(BK * 2);
    const unsigned hstep = (unsigned)HALF * K * 2;
    const unsigned tstep = 2 * hstep;
    const unsigned hstepA = g.tiledA ? 65536u : hstep;
#define PG8_KA(t_) (g.tiledA ? ((((unsigned)(t_)) >> 2) << 17) + ((((unsigned)(t_)) & 3u) << 7) : (unsigned)(t_) * kstep)
    const unsigned ldsw = (unsigned)wid * 1024u;
    const int aoff = lds_byte(wr * 64 + fr, fq * 8), boff = lds_byte(wc * 32 + fr, fq * 8);
#define PG8_SA(b, h) (((b) * 2 + (h)) * HTB)
#define PG8_SB(b, h) ((4 + (b) * 2 + (h)) * HTB)
    const unsigned long long pA_ = (unsigned long long)g.A, pB_ = (unsigned long long)g.Bt;
    void* const uA_ = (void*)(((unsigned long long)(unsigned)__builtin_amdgcn_readfirstlane((int)(unsigned)(pA_ >> 32)) << 32) | (unsigned)__builtin_amdgcn_readfirstlane((int)(unsigned)pA_));
    void* const uB_ = (void*)(((unsigned long long)(unsigned)__builtin_amdgcn_readfirstlane((int)(unsigned)(pB_ >> 32)) << 32) | (unsigned)__builtin_amdgcn_readfirstlane((int)(unsigned)pB_));
    const __amdgpu_buffer_rsrc_t rs_voffA = __builtin_amdgcn_make_buffer_rsrc(uA_, (short)0, __builtin_amdgcn_readfirstlane((int)((unsigned)g.M * (unsigned)K * 2u)), 0x00020000);
    const __amdgpu_buffer_rsrc_t rs_voffB = __builtin_amdgcn_make_buffer_rsrc(uB_, (short)0, __builtin_amdgcn_readfirstlane((int)((unsigned)g.N * (unsigned)K * 2u)), 0x00020000);
#define PG8_STAGE(bufoff, goff, voff) do { _Pragma("unroll") for (int _i = 0; _i < 2; ++_i) \
        __builtin_amdgcn_raw_ptr_buffer_load_lds(rs_##voff, (PG8_LAS void*)(lds + (bufoff) + ldsw + _i * 8192), 16, (int)(voff)[_i], (int)(goff), 0, 0); } while (0)
#define PG8_LDA(dst, b, h) do { _Pragma("unroll") for (int m = 0; m < 4; ++m) _Pragma("unroll") for (int k = 0; k < 2; ++k) dst[m][k] = *(const PG8_LAS bf16x8*)(lds + PG8_SA(b, h) + aoff + m * 2048 + k * 1024); } while (0)
#define PG8_LDB(dst, b, h) do { _Pragma("unroll") for (int n = 0; n < 2; ++n) _Pragma("unroll") for (int k = 0; k < 2; ++k) dst[n][k] = *(const PG8_LAS bf16x8*)(lds + PG8_SB(b, h) + boff + n * 2048 + k * 1024); } while (0)
#define PG8_MMA(ai, bj, At, Bt) do { __builtin_amdgcn_s_setprio(1); _Pragma("unroll") for (int m = 0; m < 4; ++m) _Pragma("unroll") for (int n = 0; n < 2; ++n) _Pragma("unroll") for (int k = 0; k < 2; ++k) \
        acc[ai][bj][m][n] = __builtin_amdgcn_mfma_f32_16x16x32_bf16(Bt[n][k], At[m][k], acc[ai][bj][m][n], 0, 0, 0); __builtin_amdgcn_s_setprio(0); } while (0)
#define PG8_WAIT_V(n) asm volatile("s_waitcnt vmcnt(" #n ")" ::: "memory")
#define PG8_WAIT_L(n) asm volatile("s_waitcnt lgkmcnt(" #n ")" ::: "memory")
#define PG8_BAR __builtin_amdgcn_s_barrier()
#define PG8_SCHED __builtin_amdgcn_sched_barrier(0)
    Unit cur, nxt; int ui = 0;
    if (!S.next(0, cur)) return;
    f32x4 acc[2][2][4][2];
#pragma unroll
    for (int a = 0; a < 2; ++a)
#pragma unroll
        for (int b = 0; b < 2; ++b)
#pragma unroll
            for (int m = 0; m < 4; ++m)
#pragma unroll
                for (int n = 0; n < 2; ++n) acc[a][b][m][n] = (f32x4){0.f, 0.f, 0.f, 0.f};
    bf16x8 At[4][2], B0[2][2], B1[2][2];
    unsigned cA = (unsigned)cur.pm * tstep, cB = (unsigned)cur.pn * tstep;
    S.a_ready(cur);
    if constexpr (SP2) {
        PG8_STAGE(PG8_SB(0, 0), cB, voffB); PG8_STAGE(PG8_SB(0, 1), cB + hstep, voffB); PG8_STAGE(PG8_SA(0, 0), cA, voffA); PG8_STAGE(PG8_SA(0, 1), cA + hstepA, voffA);
        if (wr == 1) PG8_BAR;
        PG8_WAIT_V(2); PG8_BAR;
        PG8_STAGE(PG8_SB(1, 0), cB + kstep, voffB); PG8_STAGE(PG8_SA(1, 0), cA + kstep, voffA); PG8_STAGE(PG8_SB(1, 1), cB + hstep + kstep, voffB);
        PG8_WAIT_V(6); PG8_BAR;
    } else {
        PG8_STAGE(PG8_SB(0, 0), cB, voffB); PG8_STAGE(PG8_SA(0, 0), cA, voffA); PG8_STAGE(PG8_SB(0, 1), cB + hstep, voffB); PG8_STAGE(PG8_SA(0, 1), cA + hstepA, voffA);
        if (wr == 1) PG8_BAR;
        PG8_WAIT_V(4); PG8_BAR;
        PG8_STAGE(PG8_SB(1, 0), cB + kstep, voffB); PG8_STAGE(PG8_SA(1, 0), cA + kstep, voffA); PG8_STAGE(PG8_SB(1, 1), cB + hstep + kstep, voffB);
        PG8_WAIT_V(6); PG8_BAR;
    }
    for (;;) {
        const bool has_next = S.next(ui + 1, nxt);
        const unsigned nA = has_next ? (unsigned)nxt.pm * tstep : cA, nB = has_next ? (unsigned)nxt.pn * tstep : cB;
        for (int t = 0; t < nt; t += 2) {
            const bool last = (t == nt - 2);
            const unsigned a1 = cA + PG8_KA(t + 1);
            const unsigned a2 = last ? nA : cA + PG8_KA(t + 2), b2 = last ? nB : cB + (unsigned)(t + 2) * kstep;
            const unsigned a3 = a2 + kstep, b3 = b2 + kstep;
            if (last && has_next) S.a_ready(nxt);
            if constexpr (SP2) {
            PG8_LDB(B0, 0, 0); PG8_LDB(B1, 0, 1); PG8_SCHED; PG8_LDA(At, 0, 0); PG8_STAGE(PG8_SA(1, 1), a1 + hstepA, voffA);
            PG8_WAIT_V(8); PG8_WAIT_L(0); PG8_BAR; PG8_MMA(0, 0, At, B0); PG8_MMA(0, 1, At, B1); PG8_BAR; PG8_SCHED;
            PG8_LDA(At, 0, 1); PG8_STAGE(PG8_SB(0, 0), b2, voffB); PG8_STAGE(PG8_SB(0, 1), b2 + hstep, voffB); PG8_STAGE(PG8_SA(0, 0), a2, voffA);
            PG8_WAIT_V(8); PG8_WAIT_L(0); PG8_BAR; PG8_MMA(1, 0, At, B0); PG8_MMA(1, 1, At, B1); PG8_BAR; PG8_SCHED;
            PG8_LDB(B0, 1, 0); PG8_LDB(B1, 1, 1); PG8_SCHED; PG8_LDA(At, 1, 0); PG8_STAGE(PG8_SA(0, 1), a2 + hstepA, voffA);
            PG8_WAIT_V(8); PG8_WAIT_L(0); PG8_BAR; PG8_MMA(0, 0, At, B0); PG8_MMA(0, 1, At, B1); PG8_BAR; PG8_SCHED;
            PG8_LDA(At, 1, 1); PG8_STAGE(PG8_SB(1, 0), b3, voffB); PG8_STAGE(PG8_SB(1, 1), b3 + hstep, voffB); PG8_STAGE(PG8_SA(1, 0), a3, voffA);
            PG8_WAIT_V(8); PG8_WAIT_L(0); PG8_BAR; PG8_MMA(1, 0, At, B0); PG8_MMA(1, 1, At, B1); PG8_BAR; PG8_SCHED;
            } else {
            PG8_LDB(B0, 0, 0); PG8_SCHED; PG8_LDA(At, 0, 0); PG8_STAGE(PG8_SA(1, 1), a1 + hstepA, voffA);
            PG8_WAIT_L(8); PG8_BAR; PG8_WAIT_L(0); PG8_MMA(0, 0, At, B0); PG8_BAR; PG8_SCHED;
            PG8_LDB(B1, 0, 1); PG8_STAGE(PG8_SB(0, 0), b2, voffB);
            PG8_BAR; PG8_WAIT_L(0); PG8_MMA(0, 1, At, B1); PG8_BAR;
            PG8_LDA(At, 0, 1); PG8_STAGE(PG8_SA(0, 0), a2, voffA);
            PG8_BAR; PG8_WAIT_L(0); PG8_MMA(1, 0, At, B0); PG8_BAR; PG8_SCHED;
            PG8_STAGE(PG8_SB(0, 1), b2 + hstep, voffB);
            PG8_WAIT_V(6); PG8_BAR; PG8_MMA(1, 1, At, B1); PG8_BAR;
            PG8_LDB(B0, 1, 0); PG8_SCHED; PG8_LDA(At, 1, 0); PG8_STAGE(PG8_SA(0, 1), a2 + hstepA, voffA);
            PG8_WAIT_L(8); PG8_BAR; PG8_WAIT_L(0); PG8_MMA(0, 0, At, B0); PG8_BAR; PG8_SCHED;
            PG8_LDB(B1, 1, 1); PG8_STAGE(PG8_SB(1, 0), b3, voffB);
            PG8_BAR; PG8_WAIT_L(0); PG8_MMA(0, 1, At, B1); PG8_BAR;
            PG8_LDA(At, 1, 1); PG8_STAGE(PG8_SA(1, 0), a3, voffA);
            PG8_BAR; PG8_WAIT_L(0); PG8_MMA(1, 0, At, B0); PG8_BAR; PG8_SCHED;
            PG8_STAGE(PG8_SB(1, 1), b3 + hstep, voffB);
            PG8_WAIT_V(6); PG8_BAR; PG8_MMA(1, 1, At, B1); PG8_BAR;
            }
        }
        if constexpr (ALIGN_EPI) { if (wr == 0) PG8_BAR; }
        if constexpr (!Epi::AFTER_DRAIN) { E(acc, cur, wr, wc, fr, fq); S.done(cur); }
        if (!has_next) break;
#pragma unroll
        for (int a = 0; a < 2; ++a)
#pragma unroll
            for (int b = 0; b < 2; ++b)
#pragma unroll
                for (int m = 0; m < 4; ++m)
#pragma unroll
                    for (int n = 0; n < 2; ++n) acc[a][b][m][n] = (f32x4){0.f, 0.f, 0.f, 0.f};
        cur = nxt; cA = nA; cB = nB; ++ui;
        if constexpr (ALIGN_EPI) { if (wr == 1) PG8_BAR; }
    }
    PG8_WAIT_V(0);
    if constexpr (!ALIGN_EPI) { if (wr == 0) PG8_BAR; }
    PG8_BAR;
    if constexpr (Epi::AFTER_DRAIN) { E.fused(acc, cur, wr, wc, fr, fq, lds, wid, lane); S.done(cur); }
#undef PG8_KA
#undef PG8_SA
#undef PG8_SB
#undef PG8_STAGE
#undef PG8_LDA
#undef PG8_LDB
#undef PG8_MMA
#undef PG8_WAIT_V
#undef PG8_WAIT_L
#undef PG8_BAR
#undef PG8_SCHED
}
}

constexpr int NWAVES = 8;
constexpr int BATCH = 2, SEQ = 8192, DM = 2048, DEPTH = 4, N_A = 2, NHEAD = 16, HDIM = 128, NKV = 4, GRP = 4, IHEAD = 16, IDIM = 64, TOPK = 256, DFF = 5632, PLE = 256;
constexpr int M = BATCH * SEQ;
constexpr int A_IN = 4176, A_INP = 4352;
constexpr float RMS_EPS = 1e-6f;

constexpr size_t MiB = 1u << 20;
constexpr size_t WS_CTL = 0, CTL_ZERO_BYTES = 32 * 1024;
constexpr size_t SZ_WIN = (size_t)A_INP * DM * 2, SZ_SQ = (size_t)DM * DM * 2, SZ_W13 = (size_t)2 * DFF * DM * 2, SZ_W2 = (size_t)DM * DFF * 2, SZ_WPE = (size_t)DM * PLE * 2, SZ_WKV = (size_t)1024 * DM * 2;
constexpr size_t WS_WIN = 1 * MiB;
constexpr size_t WS_WOA = WS_WIN + 2 * SZ_WIN;
constexpr size_t WS_WQB = WS_WOA + 2 * SZ_SQ;
constexpr size_t WS_WOB = WS_WQB + 2 * SZ_SQ;
constexpr size_t WS_WPG = WS_WOB + 2 * SZ_SQ;
constexpr size_t WS_W13 = WS_WPG + 4 * SZ_SQ;
constexpr size_t WS_W2 = WS_W13 + 4 * SZ_W13;
constexpr size_t WS_WPE = WS_W2 + 4 * SZ_W2;
constexpr size_t WS_WKV = WS_WPE + 4 * SZ_WPE;
constexpr size_t WS_PB = WS_WKV + SZ_WKV;
constexpr size_t WS_XN = WS_PB + (size_t)4 * M * PLE * 2;
constexpr size_t WS_KVA = WS_XN + (size_t)M * DM * 2;
constexpr size_t WS_KVB = WS_KVA + (size_t)8 * SEQ * 256 * 2;
constexpr size_t WS_R1 = WS_KVB + (size_t)8 * SEQ * 256 * 2;
constexpr size_t WS_Q = WS_R1;
constexpr size_t WS_AO = WS_Q + (size_t)M * DM * 2;
constexpr size_t WS_QI = WS_AO + (size_t)M * DM * 2;
constexpr size_t WS_KIW = WS_QI + (size_t)M * 1024 * 2;
constexpr size_t WS_IDX = WS_KIW + (size_t)M * 256 * 2;
constexpr size_t WS_KIT = WS_IDX + (size_t)M * 256 * 4;
constexpr size_t WS_R1_END = WS_KIT + (size_t)M * 64 * 2;
constexpr size_t WS_U = WS_R1;
static_assert(WS_U + (size_t)M * DFF * 2 <= WS_R1_END, "U fits the attention scratch region");
constexpr size_t WS_XNB = WS_R1_END;
constexpr size_t WS_PE = WS_XNB + (size_t)M * DM * 2;
constexpr size_t WS_SSP = WS_PE + (size_t)M * DM * 2;
constexpr size_t WS_END = WS_SSP + (size_t)13 * M * 32 * 4;
constexpr int RTAB_OFF = 131072;
constexpr int CW_BAR = 4096;

constexpr int LDS_BYTES = 163840;
constexpr int MISC_OFF = LDS_BYTES - 256;
constexpr int TAB_ENTRIES = 129 * 16;

#define GAS __attribute__((address_space(1)))
#define LAS __attribute__((address_space(3)))
typedef unsigned short bf16;
typedef unsigned v4u __attribute__((ext_vector_type(4)));
typedef unsigned v2u __attribute__((ext_vector_type(2)));
typedef float f32x4 __attribute__((ext_vector_type(4)));
typedef float f32x16 __attribute__((ext_vector_type(16)));
typedef short bf16x8 __attribute__((ext_vector_type(8)));
typedef short s16x4 __attribute__((ext_vector_type(4)));
typedef GAS unsigned gu32;
#define RLX_AGENT __ATOMIC_RELAXED, __HIP_MEMORY_SCOPE_AGENT
#define LDS_WAIT() asm volatile("s_waitcnt lgkmcnt(0)" ::: "memory")
__device__ __forceinline__ unsigned f2bf(float f) { unsigned u = __builtin_bit_cast(unsigned, f); return (u + 0x7fffu + ((u >> 16) & 1u)) >> 16; }
__device__ __forceinline__ unsigned pk2(float lo, float hi) { return pg8::cvt_pk_bf16(lo, hi); }
__device__ __forceinline__ float bf2f(unsigned short b) { return __uint_as_float(((unsigned)b) << 16); }
__device__ __forceinline__ s16x4 vtr(const LAS unsigned char* p) { typedef short v4i16_t __attribute__((ext_vector_type(4))); return __builtin_bit_cast(s16x4, __builtin_amdgcn_ds_read_tr16_b64_v4i16((LAS v4i16_t*)p)); }
__device__ __forceinline__ float bfly16_max(float v) { auto rr = __builtin_amdgcn_permlane16_swap(__float_as_uint(v), __float_as_uint(v), false, false); return fmaxf(__uint_as_float(rr[0]), __uint_as_float(rr[1])); }
__device__ __forceinline__ float bfly32_max(float v) { auto rr = __builtin_amdgcn_permlane32_swap(__float_as_uint(v), __float_as_uint(v), false, false); return fmaxf(__uint_as_float(rr[0]), __uint_as_float(rr[1])); }
__device__ __forceinline__ float bfly16_sum(float v) { auto rr = __builtin_amdgcn_permlane16_swap(__float_as_uint(v), __float_as_uint(v), false, false); return __uint_as_float(rr[0]) + __uint_as_float(rr[1]); }
__device__ __forceinline__ float bfly32_sum(float v) { auto rr = __builtin_amdgcn_permlane32_swap(__float_as_uint(v), __float_as_uint(v), false, false); return __uint_as_float(rr[0]) + __uint_as_float(rr[1]); }
__device__ __forceinline__ float wave_sum(float v) {
#pragma unroll
    for (int o = 1; o < 64; o <<= 1) v += __shfl_xor(v, o);
    return v;
}
#define XB_TMO      128
#define XB_XCNT(j)  (256  + 64 * (j))
#define XB_XSUB(j)  (1280 + 64 * (j))
#define XB_XGEN(j)  (2304 + 64 * (j))
#define XB_TOP      3328
#define XB_TOPGEN   3392
#define XCD_BAR_WORDS 3456
#define XB_SPIN_CAP (1u << 18)

__device__ __forceinline__ unsigned xb_ld(unsigned* p)              { return __hip_atomic_load(p, __ATOMIC_RELAXED, __HIP_MEMORY_SCOPE_AGENT); }
__device__ __forceinline__ unsigned xb_add(unsigned* p, unsigned v) { return __hip_atomic_fetch_add(p, v, __ATOMIC_RELAXED, __HIP_MEMORY_SCOPE_AGENT); }
__device__ __forceinline__ unsigned xb_xcc_id() { return (unsigned)__builtin_amdgcn_s_getreg((3 << 11) | 20) & 0xFu; }
#define XB_SPIN(cond, bar) do { unsigned _sp = 0; while (cond) { __builtin_amdgcn_s_sleep(1); \
    if ((++_sp & 255u) == 0u) { if (xb_ld(&(bar)[XB_TMO])) break; if (_sp > XB_SPIN_CAP) { atomicAdd(&(bar)[XB_TMO], 1u); break; } } } } while (0)

struct XcdBarrier {
    unsigned* bar; unsigned x;
    volatile LAS unsigned* st;
};

__device__ __forceinline__ XcdBarrier xcd_barrier_post(unsigned* bar, volatile LAS unsigned* st) {
    XcdBarrier b; b.bar = bar; b.x = xb_xcc_id(); b.st = st;
    if (threadIdx.x == 0) (void)xb_add(&bar[XB_XCNT(b.x)], 1u);
    return b;
}
__device__ __forceinline__ void xcd_barrier_complete(unsigned* bar, unsigned x, unsigned& nloc, unsigned& nx) {
    const unsigned G = gridDim.x * gridDim.y * gridDim.z;
    unsigned sum, cnt, mine, sp = 0u;
    for (;;) {
        sum = 0u; cnt = 0u; mine = 0u;
#pragma unroll
        for (unsigned j = 0; j < 16; ++j) { const unsigned c = xb_ld(&bar[XB_XCNT(j)]); sum += c; cnt += (c > 0u) ? 1u : 0u; mine = (j == x) ? c : mine; }
        if (sum == G) break;
        __builtin_amdgcn_s_sleep(1);
        if ((++sp & 255u) == 0u) { if (xb_ld(&bar[XB_TMO])) break; if (sp > XB_SPIN_CAP) { atomicAdd(&bar[XB_TMO], 1u); break; } }
    }
    nloc = mine > 0u ? mine : 1u; nx = cnt > 0u ? cnt : 1u;
}

__device__ __forceinline__ void xcd_barrier(const XcdBarrier& b) {
    asm volatile("s_waitcnt vmcnt(0)" ::: "memory");
    __syncthreads();
    if (threadIdx.x == 0) {
        unsigned* bar = b.bar;
        __builtin_amdgcn_s_waitcnt(0);
        unsigned nloc = b.st[0], nx = b.st[1];
        if (nloc == 0u) { xcd_barrier_complete(bar, b.x, nloc, nx); b.st[0] = nloc; b.st[1] = nx; }
        const unsigned old = xb_add(&bar[XB_XSUB(b.x)], 1u);
        const unsigned gen = old / nloc;
        if (old + 1u == (gen + 1u) * nloc) {
            __builtin_amdgcn_fence(__ATOMIC_RELEASE, "agent");
            asm volatile("s_waitcnt vmcnt(0)" ::: "memory");
            const unsigned og = xb_add(&bar[XB_TOP], 1u);
            const unsigned tg = og / nx;
            if (og + 1u == (tg + 1u) * nx) xb_add(&bar[XB_TOPGEN], 1u);
            else XB_SPIN(xb_ld(&bar[XB_TOPGEN]) == tg, bar);
            __builtin_amdgcn_fence(__ATOMIC_ACQUIRE, "agent");
            xb_add(&bar[XB_XGEN(b.x)], 1u);
            asm volatile("s_waitcnt vmcnt(0)" ::: "memory");
        } else {
            XB_SPIN(xb_ld(&bar[XB_XGEN(b.x)]) == gen, bar);
            __builtin_amdgcn_fence(__ATOMIC_ACQUIRE, "agent");
            asm volatile("s_waitcnt vmcnt(0)" ::: "memory");
        }
    }
    __syncthreads();
}

__device__ __forceinline__ void tr_load(const float* W, const float* gain, int N, int k0, int n0, f32x4 (&v)[16], f32x4 (&g)[2], int lane) {
    int nc = n0 + (lane & 15) * 4; nc = nc < N - 4 ? nc : N - 4; const int kr = lane >> 4;
    const GAS float* gp = (const GAS float*)(gain ? gain : W) + k0 + 8 * (lane & 7);
    g[0] = *(const GAS f32x4*)gp; g[1] = *(const GAS f32x4*)(gp + 4);
    const GAS float* src = (const GAS float*)W + (size_t)(k0 + kr) * N + nc;
#pragma unroll
    for (int i = 0; i < 16; ++i) v[i] = *(const GAS f32x4*)(src + (size_t)(4 * i) * N);
}
__device__ __forceinline__ void tr_store(bf16* WT, bool hg, int K, int N, int k0, int n0, int drow0, const f32x4 (&v)[16], const f32x4 (&g)[2], LAS float* scr, int lane) {
    const int c4 = (lane & 15) * 4, kr = lane >> 4;
#pragma unroll
    for (int i = 0; i < 16; ++i) { const int k = 4 * i + kr; scr[(c4 + 0) * 65 + k] = v[i].x; scr[(c4 + 1) * 65 + k] = v[i].y; scr[(c4 + 2) * 65 + k] = v[i].z; scr[(c4 + 3) * 65 + k] = v[i].w; }
    LDS_WAIT(); asm volatile("" ::: "memory");
    const int c = lane & 7;
    const float m0 = hg ? g[0].x : 1.f, m1 = hg ? g[0].y : 1.f, m2 = hg ? g[0].z : 1.f, m3 = hg ? g[0].w : 1.f, m4 = hg ? g[1].x : 1.f, m5 = hg ? g[1].y : 1.f, m6 = hg ? g[1].z : 1.f, m7 = hg ? g[1].w : 1.f;
#pragma unroll
    for (int j = 0; j < 8; ++j) { const int n = (lane >> 3) + 8 * j; const LAS float* s = scr + n * 65 + 8 * c;
        v4u o; o.x = pk2(s[0] * m0, s[1] * m1); o.y = pk2(s[2] * m2, s[3] * m3); o.z = pk2(s[4] * m4, s[5] * m5); o.w = pk2(s[6] * m6, s[7] * m7);
        if (n0 + n < N) *(GAS v4u*)(WT + (size_t)(drow0 + n) * K + k0 + 8 * c) = o; }
    LDS_WAIT(); asm volatile("" ::: "memory");
}
__device__ __forceinline__ int map_row(int mt, int n) {
    if (mt == 1) { if (n >= 2048 && n < 3072) { const int v = (n >= 2560) ? 1 : 0, nn = n - 2048 - v * 512; return 2048 + (nn >> 7) * 256 + v * 128 + (nn & 127); } return n; }
    if (mt == 2) { const int v = (n >= 512) ? 1 : 0, nn = n - v * 512; return (nn >> 7) * 256 + v * 128 + (nn & 127); }
    if (mt == 3) return (n >> 7) * 256 + (n & 127);
    if (mt == 4) return (n >> 7) * 256 + 128 + (n & 127);
    return n;
}
__device__ __forceinline__ void conv_matrix(const float* W, const float* gain, int K, int N, bf16* WT, int mt, LAS float* scr, int gw, int NGW, int lane, int& rot) {
    const int nblk = (N + 63) / 64, nitems = (K / 64) * nblk;
    int it = gw - rot; if (it < 0) it += NGW;
    rot = (rot + nitems) % NGW;
    f32x4 va[16], vb[16], ga[2], gb[2];
#define CONV_KB(i_) ((i_) / nblk)
#define CONV_LOAD(v_, g_, i_) tr_load(W, gain, N, 64 * CONV_KB(i_), 64 * ((i_) - CONV_KB(i_) * nblk), v_, g_, lane)
#define CONV_STORE(v_, g_, i_) tr_store(WT, gain != nullptr, K, N, 64 * CONV_KB(i_), 64 * ((i_) - CONV_KB(i_) * nblk), map_row(mt, 64 * ((i_) - CONV_KB(i_) * nblk)), v_, g_, scr, lane)
    if (it < nitems) CONV_LOAD(va, ga, it);
    while (it < nitems) {
        const int i1 = it + NGW; if (i1 < nitems) CONV_LOAD(vb, gb, i1);
        CONV_STORE(va, ga, it);
        if (i1 >= nitems) break;
        const int i2 = i1 + NGW; if (i2 < nitems) CONV_LOAD(va, ga, i2);
        CONV_STORE(vb, gb, i1);
        it = i2;
    }
#undef CONV_KB
#undef CONV_LOAD
#undef CONV_STORE
}

__device__ __forceinline__ float wave_sum_dpp(float v) {
#define FN_DPP(ctrl) v += __uint_as_float((unsigned)__builtin_amdgcn_update_dpp(0, (int)__float_as_uint(v), ctrl, 0xf, 0xf, false))
    FN_DPP(0xB1); FN_DPP(0x4E); FN_DPP(0x124); FN_DPP(0x128);
#undef FN_DPP
    return bfly32_sum(bfly16_sum(v));
}
__device__ __forceinline__ void xb_phase(const float* x, bf16* XB, float* ss, int gw, int NGW, int lane) {
    for (int m = gw; m < M; m += NGW) {
        const GAS f32x4* xr = (const GAS f32x4*)(x + (size_t)m * DM) + lane; f32x4 v[8]; float s = 0.f;
#pragma unroll
        for (int j = 0; j < 8; ++j) { v[j] = xr[64 * j]; s += (v[j].x * v[j].x + v[j].y * v[j].y) + (v[j].z * v[j].z + v[j].w * v[j].w); }
        s = wave_sum_dpp(s);
#pragma unroll
        for (int j = 0; j < 8; ++j) { const int c0 = 4 * (lane + 64 * j); v2u w; w.x = pk2(v[j].x, v[j].y); w.y = pk2(v[j].z, v[j].w);
            *(GAS v2u*)(XB + ((size_t)((m >> 8) * 8 + (c0 >> 8)) << 16) + (size_t)(m & 255) * 256 + (c0 & 255)) = w; }
        if (lane < 32) ((GAS float*)ss)[(size_t)m * 32 + lane] = lane == 0 ? s : 0.f;
    }
}
__device__ __forceinline__ void final_norm_phase(const bf16* xb, const float* g, float* out, int gw, int NGW, int lane) {
    f32x4 gg[4][2];
#pragma unroll
    for (int j = 0; j < 4; ++j) { const int c0 = (lane + 64 * j) * 8; gg[j][0] = *(const GAS f32x4*)(g + c0); gg[j][1] = *(const GAS f32x4*)(g + c0 + 4); }
    v4u v[4], vn[4];
#define FN_LOAD(dst, m_) do { _Pragma("unroll") for (int j = 0; j < 4; ++j) { const int c0 = 8 * (lane + 64 * j); dst[j] = *(const GAS v4u*)(xb + ((size_t)(((m_) >> 8) * 8 + (c0 >> 8)) << 16) + (size_t)((m_) & 255) * 256 + (c0 & 255)); } } while (0)
    if (gw < M) FN_LOAD(vn, gw);
    for (int m = gw; m < M; m += NGW) {
#pragma unroll
        for (int j = 0; j < 4; ++j) v[j] = vn[j];
        { const int mn = m + NGW < M ? m + NGW : m; FN_LOAD(vn, mn); }
        float s = 0.f;
#pragma unroll
        for (int j = 0; j < 4; ++j) { const unsigned w[4] = {v[j].x, v[j].y, v[j].z, v[j].w};
#pragma unroll
            for (int e = 0; e < 4; ++e) { const float lo = __uint_as_float(w[e] << 16), hi = __uint_as_float(w[e] & 0xffff0000u); s += lo * lo + hi * hi; } }
        const float r = 1.0f / sqrtf(wave_sum_dpp(s) * (1.f / DM) + RMS_EPS);
#pragma unroll
        for (int j = 0; j < 4; ++j) { const int c0 = (lane + 64 * j) * 8; const unsigned w[4] = {v[j].x, v[j].y, v[j].z, v[j].w};
            const f32x4 g0 = gg[j][0], g1 = gg[j][1];
            f32x4 o0, o1; o0.x = __uint_as_float(w[0] << 16) * r * g0.x; o0.y = __uint_as_float(w[0] & 0xffff0000u) * r * g0.y; o0.z = __uint_as_float(w[1] << 16) * r * g0.z; o0.w = __uint_as_float(w[1] & 0xffff0000u) * r * g0.w;
            o1.x = __uint_as_float(w[2] << 16) * r * g1.x; o1.y = __uint_as_float(w[2] & 0xffff0000u) * r * g1.y; o1.z = __uint_as_float(w[3] << 16) * r * g1.z; o1.w = __uint_as_float(w[3] & 0xffff0000u) * r * g1.w;
            GAS f32x4* op = (GAS f32x4*)(out + (size_t)m * DM + c0); op[0] = o0; op[1] = o1; }
    }
#undef FN_LOAD
}

__device__ __forceinline__ void build_bias_tab(LAS float* tab, const float* rel_bias, int tid) {
    for (int e = tid; e < TAB_ENTRIES; e += NWAVES * 64) { const int rel = e >> 4, h = e & 15; int bk;
        if (rel < 16) bk = rel; else if (rel >= 128) bk = 31; else { bk = 16 + (int)(logf((float)rel * (1.f / 16.f)) / logf(8.f) * 16.f); bk = bk > 31 ? 31 : bk; }
        tab[e] = rel_bias[bk * 16 + h]; }
}

__device__ __forceinline__ unsigned mono_key(float s) { const unsigned u = __float_as_uint(s); return (u & 0x80000000u) ? ~u : (u | 0x80000000u); }
__device__ __forceinline__ int mbcnt64(unsigned long long m) { return (int)__builtin_amdgcn_mbcnt_hi((unsigned)(m >> 32), __builtin_amdgcn_mbcnt_lo((unsigned)m, 0u)); }
constexpr int IDX_CAND = 512;
__device__ __forceinline__ void idx_scan(LAS unsigned* hrow, unsigned k_rem, int lane, unsigned& D, unsigned& above, unsigned& cD) {
    const int rl = 63 - lane;
    v4u w[4];
#pragma unroll
    for (int k = 0; k < 4; ++k) w[k] = *(const LAS v4u*)(hrow + 16 * rl + 4 * k);
    const unsigned wd[16] = {w[0].x, w[0].y, w[0].z, w[0].w, w[1].x, w[1].y, w[1].z, w[1].w, w[2].x, w[2].y, w[2].z, w[2].w, w[3].x, w[3].y, w[3].z, w[3].w};
    unsigned tot = 0u;
#pragma unroll
    for (int k = 0; k < 16; ++k) tot += (wd[k] & 0xffffu) + (wd[k] >> 16);
    unsigned v = tot;
#define IDX_DPP_ADD(ctrl, rmask, bmask) v += (unsigned)__builtin_amdgcn_update_dpp(0, (int)v, ctrl, rmask, bmask, false)
    IDX_DPP_ADD(0x111, 0xf, 0xf); IDX_DPP_ADD(0x112, 0xf, 0xf); IDX_DPP_ADD(0x114, 0xf, 0xe); IDX_DPP_ADD(0x118, 0xf, 0xc); IDX_DPP_ADD(0x142, 0xa, 0xf); IDX_DPP_ADD(0x143, 0xc, 0xf);
#undef IDX_DPP_ADD
    const unsigned sx = v - tot;
    const bool mine = (sx < k_rem) && (k_rem <= sx + tot);
    unsigned S = sx + tot, kw = 0u, alw = sx, xw = 0u;
#pragma unroll
    for (int k = 0; k < 16; ++k) { const unsigned wsk = (wd[k] & 0xffffu) + (wd[k] >> 16), Sn = S - wsk; const bool ge = S >= k_rem;
        xw = ge ? wd[k] : xw; alw = ge ? Sn : alw; kw = ge ? (unsigned)k : kw; S = Sn; }
    const unsigned chi = xw >> 16, clo = xw & 0xffffu;
    const bool inhi = alw + chi >= k_rem;
    const unsigned Dl = (unsigned)(32 * rl) + 2u * kw + (inhi ? 1u : 0u), al = inhi ? alw : alw + chi, cl = inhi ? chi : clo;
    const unsigned long long bal = __ballot(mine); const int Ls = bal ? (__ffsll((long long)bal) - 1) : 0;
    D = (unsigned)__builtin_amdgcn_readlane((int)Dl, Ls); above = (unsigned)__builtin_amdgcn_readlane((int)al, Ls); cD = (unsigned)__builtin_amdgcn_readlane((int)cl, Ls);
#pragma unroll
    for (int k = 0; k < 4; ++k) *(LAS v4u*)(hrow + 16 * rl + 4 * k) = (v4u){0u, 0u, 0u, 0u};
}
__device__ __forceinline__ void indexer_phase(LAS unsigned char* lds, const bf16* QI, const bf16* KIW, const bf16* KIT, int* IDX, int c, int G, int tid, int wave, int lane) {
    LAS unsigned* sc = (LAS unsigned*)lds;
    LAS unsigned* hist = (LAS unsigned*)(lds + 131072);
    LAS int* cand = (LAS int*)(lds + 131072 + 16384);
    volatile LAS unsigned* st = (volatile LAS unsigned*)(lds + 131072 + 16384 + 8192);
    for (int i = tid; i < 4096; i += NWAVES * 64) hist[i] = 0u;
    __syncthreads();
    const int q = wave >> 1, half = wave & 1;
    const int r32 = lane & 31, hf = lane >> 5;
    constexpr int NU = M / 4;
    for (int rnd = 0; rnd * G < NU; ++rnd) {
        const int L = rnd * G + ((rnd & 1) ? (G - 1 - c) : c);
        if (L >= NU) continue;
        const int b = L & 1, t0 = (L >> 1) * 4; const size_t tok0 = (size_t)b * SEQ;
        const int t = t0 + q, n = t + 1;
        GAS int* orow = (GAS int*)(IDX + (tok0 + t) * TOPK);
        if (t0 + 4 <= TOPK) {
#pragma unroll
            for (int j = 0; j < 2; ++j) { const int p = half * 128 + j * 64 + lane; orow[p] = p < n ? p : -1; }
            continue;
        }
#ifndef IDX_REP_SCORE
#define IDX_REP_SCORE 1
#endif
        for (int srep = 0; srep < IDX_REP_SCORE; ++srep) {
            const int ntiles = (t0 + 4 + 31) >> 5;
            const int nmine = (ntiles - wave + NWAVES - 1) / NWAVES;
            const GAS bf16* kbase = (const GAS bf16*)(KIT + (tok0 >> 5) * (4 * 64 * 8) + lane * 8);
            bf16x8 B0[4], B1[4], B2[4];
#define IDX_LOAD(Bx, i) do { const int ii_ = (i) < nmine ? (i) : nmine - 1; const GAS bf16* ks_ = kbase + (size_t)(wave + NWAVES * ii_) * (4 * 64 * 8); _Pragma("unroll") for (int ks = 0; ks < 4; ++ks) Bx[ks] = *(const GAS bf16x8*)(ks_ + ks * (64 * 8)); } while (0)
            IDX_LOAD(B0, 0); IDX_LOAD(B1, 1);
            bf16x8 A[2][4]; float wgt[2][16];
            const int ql = (r32 >> 2) & 1, h = (r32 & 3) + 4 * (r32 >> 3);
#pragma unroll
            for (int rb = 0; rb < 2; ++rb) { const GAS bf16* src = (const GAS bf16*)(QI + (tok0 + t0 + 2 * rb + ql) * 1024 + h * 64 + 8 * hf);
#pragma unroll
                for (int ks = 0; ks < 4; ++ks) A[rb][ks] = *(const GAS bf16x8*)(src + ks * 16); }
#pragma unroll
            for (int rb = 0; rb < 2; ++rb) { const GAS bf16* wsrc = (const GAS bf16*)(KIW + (tok0 + t0 + 2 * rb + hf) * 256 + 64);
                const v4u w0 = *(const GAS v4u*)wsrc, w1 = *(const GAS v4u*)(wsrc + 8);
                const unsigned ww[8] = {w0.x, w0.y, w0.z, w0.w, w1.x, w1.y, w1.z, w1.w};
#pragma unroll
                for (int i = 0; i < 8; ++i) { wgt[rb][2 * i] = __uint_as_float(ww[i] << 16) * (1.f / 32.f); wgt[rb][2 * i + 1] = __uint_as_float(ww[i] & 0xffff0000u) * (1.f / 32.f); } }
#define IDX_PROBE_ATOM
#define IDX_TILE(Bx, i) do { if ((i) < nmine) { const int j_ = wave + NWAVES * (i); \
                f32x16 acc0, acc1; _Pragma("unroll") for (int e = 0; e < 16; ++e) { acc0[e] = 0.f; acc1[e] = 0.f; } \
                _Pragma("unroll") for (int ks = 0; ks < 4; ++ks) { acc0 = __builtin_amdgcn_mfma_f32_32x32x16_bf16(A[0][ks], Bx[ks], acc0, 0, 0, 0); acc1 = __builtin_amdgcn_mfma_f32_32x32x16_bf16(A[1][ks], Bx[ks], acc1, 0, 0, 0); }     \
                _Pragma("unroll") for (int rb = 0; rb < 2; ++rb) { \
                    float sa_ = 0.f, sb_ = 0.f, sc_ = 0.f, sd_ = 0.f;                                                                   \
                    _Pragma("unroll") for (int e = 0; e < 4; ++e) { const float x0 = rb ? acc1[e] : acc0[e], x1 = rb ? acc1[e + 4] : acc0[e + 4], x2 = rb ? acc1[e + 8] : acc0[e + 8], x3 = rb ? acc1[e + 12] : acc0[e + 12]; \
                        sa_ = fmaf(wgt[rb][e], __int_as_float(max(__float_as_int(x0), 0)), sa_); sb_ = fmaf(wgt[rb][e + 4], __int_as_float(max(__float_as_int(x1), 0)), sb_); \
                        sc_ = fmaf(wgt[rb][e + 8], __int_as_float(max(__float_as_int(x2), 0)), sc_); sd_ = fmaf(wgt[rb][e + 12], __int_as_float(max(__float_as_int(x3), 0)), sd_); } \
                    const float s_ = (sa_ + sb_) + (sc_ + sd_); \
                    const int tq_ = t0 + 2 * rb + hf, key_ = j_ * 32 + r32; const bool ok_ = key_ <= tq_; const unsigned mk_ = ok_ ? mono_key(s_) : 0u; \
                    sc[(2 * rb + hf) * 8192 + key_] = mk_; \
                    if (ok_ && srep == 0) { __hip_atomic_fetch_add(hist + (2 * rb + hf) * 1024 + (mk_ >> 22), 1u << ((mk_ >> 17) & 16u), __ATOMIC_RELAXED, __HIP_MEMORY_SCOPE_WORKGROUP); IDX_PROBE_ATOM } } } } while (0)
#define IDX_TILE2(Bx, i) IDX_TILE(Bx, i)
#define IDX_LOAD2(Bx, i) IDX_LOAD(Bx, i)
#pragma unroll 1
            for (int i = 0; i < nmine; i += 3) {
                IDX_LOAD2(B2, i + 2); IDX_TILE2(B0, i);
                IDX_LOAD2(B0, i + 3); IDX_TILE2(B1, i + 1);
                IDX_LOAD2(B1, i + 4); IDX_TILE2(B2, i + 2);
            }
#undef IDX_TILE2
#undef IDX_LOAD2
#undef IDX_LOAD
#undef IDX_TILE
        }
        __syncthreads();
        LAS unsigned* srow = sc + q * 8192; LAS unsigned* hrow = hist + q * 1024; LAS int* crow = cand + q * IDX_CAND;
        if (half == 0) { unsigned D, above, cD; idx_scan(hrow, (unsigned)TOPK, lane, D, above, cD);
            if (lane == 0) { st[q * 4 + 0] = D << 21; st[q * 4 + 1] = (unsigned)TOPK - above; st[q * 4 + 2] = cD; } }
        __syncthreads();
        int shift = 21;
        while (shift > 0 && (st[2] > IDX_CAND || st[6] > IDX_CAND || st[10] > IDX_CAND || st[14] > IDX_CAND)) {
            const unsigned prefix = st[q * 4 + 0], k_rem = st[q * 4 + 1]; const int nshift = shift > 11 ? shift - 11 : 0; const unsigned dmask = (1u << (shift - nshift)) - 1u;
            const int nh_ = ((n >> 1) + 63) & ~63; const int lo_ = half ? nh_ : 0, hi_ = half ? n : (nh_ < n ? nh_ : n);
            __syncthreads();
            for (int i = lo_ + lane; i < hi_; i += 64) { const unsigned key = srow[i];
                if ((key >> shift) == (prefix >> shift)) { const unsigned d = (key >> nshift) & dmask; __hip_atomic_fetch_add(hrow + (d >> 1), 1u << (16 * (d & 1)), __ATOMIC_RELAXED, __HIP_MEMORY_SCOPE_WORKGROUP); } }
            __syncthreads();
            if (half == 0) { unsigned D, above, cD; idx_scan(hrow, k_rem, lane, D, above, cD);
                if (lane == 0) { st[q * 4 + 0] = prefix | (D << nshift); st[q * 4 + 1] = k_rem - above; st[q * 4 + 2] = cD; } }
            __syncthreads();
            shift = nshift;
        }
        const unsigned prefix = st[q * 4 + 0]; const int need = (int)st[q * 4 + 1], cD = (int)st[q * 4 + 2], c_gt = TOPK - need;
        const unsigned tp = prefix >> shift; const bool exact_dup = cD > IDX_CAND;
        const int nh = ((n >> 1) + 63) & ~63; const int lo = half ? nh : 0, hi = half ? n : (nh < n ? nh : n);
        if (exact_dup) {
          if (half == 0) {
            int cg = 0, ce = 0;
            for (int base = 0; base < n; base += 64) { const int i = base + lane; const unsigned kp = (i < n) ? srow[i] : 0u;
                const bool gt = (i < hi) && kp > tp, eq = (i < n) && kp == tp;
                const unsigned long long mg = __ballot(gt), me = __ballot(eq);
                const int pg = cg + mbcnt64(mg), pe = ce + mbcnt64(me);
                if (gt) orow[pg] = i;
                if (eq && pe < need) orow[c_gt + pe] = i;
                cg += __popcll(mg); ce += __popcll(me); }
          } else if (hi > lo) {
            int cg = 0;
            for (int base = lo + ((hi - 1 - lo) & ~63); base >= lo; base -= 64) { const int i = base + lane; const bool in = i < hi; const unsigned kp = in ? srow[i] : 0u;
                const bool gt = in && kp > tp; const unsigned long long mg = __ballot(gt);
                const int ag = __popcll(mg) - mbcnt64(mg) - (gt ? 1 : 0);
                if (gt) orow[c_gt - 1 - cg - ag] = i;
                cg += __popcll(mg); }
          }
        } else {
          LAS unsigned short* hl_ = (LAS unsigned short*)hrow + half * 1024;
          int nhit = 0;
          for (int base = lo; base < hi; base += 256) {
              const int i0 = base + 4 * lane; const v4u k4 = (i0 < hi) ? *(const LAS v4u*)(srow + i0) : (v4u){0u, 0u, 0u, 0u};
              const bool h0 = (i0 < hi) && (k4.x >> shift) >= tp, h1 = (i0 + 1 < hi) && (k4.y >> shift) >= tp, h2 = (i0 + 2 < hi) && (k4.z >> shift) >= tp, h3 = (i0 + 3 < hi) && (k4.w >> shift) >= tp;
              const int cnt = (int)h0 + (int)h1 + (int)h2 + (int)h3;
              int v = cnt;
#define IDX_DPP_ADD(ctrl, rmask, bmask) v += __builtin_amdgcn_update_dpp(0, v, ctrl, rmask, bmask, false)
              IDX_DPP_ADD(0x111, 0xf, 0xf); IDX_DPP_ADD(0x112, 0xf, 0xf); IDX_DPP_ADD(0x114, 0xf, 0xe); IDX_DPP_ADD(0x118, 0xf, 0xc); IDX_DPP_ADD(0x142, 0xa, 0xf); IDX_DPP_ADD(0x143, 0xc, 0xf);
#undef IDX_DPP_ADD
              int p = nhit + v - cnt;
              if (h0) { hl_[p] = (unsigned short)i0; ++p; }
              if (h1) { hl_[p] = (unsigned short)(i0 + 1); ++p; }
              if (h2) { hl_[p] = (unsigned short)(i0 + 2); ++p; }
              if (h3) { hl_[p] = (unsigned short)(i0 + 3); }
              nhit += __builtin_amdgcn_readlane(v, 63);
          }
          if (half == 0) {
            int cg = 0, ce = 0;
            for (int j0 = 0; j0 < nhit; j0 += 64) { const int j = j0 + lane; const bool in = j < nhit; const int i = in ? (int)hl_[j] : 0; const unsigned kp = in ? (srow[i] >> shift) : 0u;
                const bool gt = in && kp > tp, eq = in && kp == tp;
                const unsigned long long mg = __ballot(gt), me = __ballot(eq);
                const int pg = cg + mbcnt64(mg), pe = ce + mbcnt64(me);
                if (gt) orow[pg] = i;
                if (eq) crow[pe] = i;
                cg += __popcll(mg); ce += __popcll(me); }
          } else if (nhit > 0) {
            int cg = 0, ce = 0;
            for (int j0 = (nhit - 1) & ~63; j0 >= 0; j0 -= 64) { const int j = j0 + lane; const bool in = j < nhit; const int i = in ? (int)hl_[j] : 0; const unsigned kp = in ? (srow[i] >> shift) : 0u;
                const bool gt = in && kp > tp, eq = in && kp == tp;
                const unsigned long long mg = __ballot(gt), me = __ballot(eq);
                const int ag = __popcll(mg) - mbcnt64(mg) - (gt ? 1 : 0), ae = __popcll(me) - mbcnt64(me) - (eq ? 1 : 0);
                if (gt) orow[c_gt - 1 - cg - ag] = i;
                if (eq) crow[cD - 1 - ce - ae] = i;
                cg += __popcll(mg); ce += __popcll(me); }
          }
        }
        __syncthreads();
#ifndef IDX_REP_TAIL
#define IDX_REP_TAIL 1
#endif
        for (int trep = 0; trep < IDX_REP_TAIL; ++trep)
        if (half == 0 && !exact_dup) {
#pragma unroll
            for (int k = 0; k < 4; ++k) *(LAS v4u*)(hrow + 16 * lane + 4 * k) = (v4u){0u, 0u, 0u, 0u};
            unsigned pfx = prefix, k_rem = (unsigned)need; int sh = shift;
            int ci[8]; unsigned ck[8];
#pragma unroll
            for (int m = 0; m < 8; ++m) { const int j = lane + 64 * m; ci[m] = j < cD ? crow[j] : 0; }
            __builtin_amdgcn_sched_barrier(0);
#pragma unroll
            for (int m = 0; m < 8; ++m) { const int j = lane + 64 * m; ck[m] = j < cD ? srow[ci[m]] : 0u; }
            __builtin_amdgcn_sched_barrier(0);
            while (sh > 0) {
                const int nsh = sh > 11 ? sh - 11 : 0; const unsigned dmask = (1u << (sh - nsh)) - 1u;
#pragma unroll
                for (int m = 0; m < 8; ++m) { const int j = lane + 64 * m; const unsigned key = ck[m];
                    if (j < cD && (key >> sh) == (pfx >> sh)) { const unsigned d = (key >> nsh) & dmask; __hip_atomic_fetch_add(hrow + (d >> 1), 1u << (16 * (d & 1)), __ATOMIC_RELAXED, __HIP_MEMORY_SCOPE_WORKGROUP); } }
                unsigned D, above, cDn; idx_scan(hrow, k_rem, lane, D, above, cDn);
                pfx |= D << nsh; k_rem -= above; sh = nsh;
            }
            int cg = 0, ce = 0; const int n_gt = need - (int)k_rem;
#pragma unroll
            for (int m = 0; m < 8; ++m) { const int j = lane + 64 * m; const bool in = j < cD; const unsigned key = ck[m];
                const bool gt = in && key > pfx, eq = in && key == pfx;
                const unsigned long long mg = __ballot(gt), me = __ballot(eq);
                const int pg = cg + mbcnt64(mg), pe = ce + mbcnt64(me);
                if (gt) orow[c_gt + pg] = ci[m];
                if (eq && pe < (int)k_rem) orow[c_gt + n_gt + pe] = ci[m];
                cg += __popcll(mg); ce += __popcll(me); }
        }
        __syncthreads();
    }
}
constexpr float ATT_SCALE = 0.08838834764831845f;
__device__ __forceinline__ unsigned pkbf(float lo, float hi) { return pg8::cvt_pk_bf16(lo, hi); }
__device__ __forceinline__ void dsa_attn_phase(LAS unsigned char* lds, const bf16* Q, const unsigned char* KV8, const int* IDX, bf16* AO, const float* rel_bias, int c, int G, int tid, int wave, int lane) {
    typedef int v4i __attribute__((ext_vector_type(4))); typedef float f32x2 __attribute__((ext_vector_type(2)));
    constexpr int KSTR = 144, VSTR = 272, WBYTES = 32 * KSTR + 32 * VSTR;
    LAS unsigned char* kb = lds + wave * WBYTES; LAS unsigned char* vb = kb + 32 * KSTR;
    LAS int* idl = (LAS int*)(lds + NWAVES * WBYTES + wave * 2048);
    LAS float* tab = (LAS float*)(lds + NWAVES * WBYTES + NWAVES * 2048);
    build_bias_tab(tab, rel_bias, tid);
    __syncthreads();
    const int hl = lane & 15, Gq = lane >> 4, hsel = hl & 3, qrow = hl >> 2, pcol = lane & 3;
    const int NGW = G * NWAVES;
    const int uid0 = c * NWAVES + wave, nun = (8 * SEQ - uid0 + NGW - 1) / NGW;
    v4i ivn; v4u qraw[4];
#define DSA_UNIT(u_, k_, bg_, t_, tok_) const int u_ = uid0 + ((k_) < nun ? (k_) : nun - 1) * NGW; const int bg_ = (u_ >> 3) & 7, t_ = ((u_ >> 6) << 3) | (u_ & 7); const size_t tok_ = (size_t)(bg_ >> 2) * SEQ + t_
    { DSA_UNIT(ua_, 0, bg0, t0_, tok0); ivn = *(const GAS v4i*)(IDX + tok0 * TOPK + lane * 4);
      const GAS bf16* qs = (const GAS bf16*)(Q + tok0 * DM + ((bg0 & 3) * 4 + hsel) * HDIM + 8 * Gq);
#pragma unroll
      for (int ks = 0; ks < 4; ++ks) qraw[ks] = *(const GAS v4u*)(qs + ks * 32);
      *(LAS v4i*)(idl + lane * 4) = ivn; }
    v4u stk[4], stv[4];
#define DSA_RSRC(bg_) __builtin_amdgcn_make_buffer_rsrc((void*)(((unsigned long long)(unsigned)__builtin_amdgcn_readfirstlane((int)(unsigned)(((unsigned long long)(KV8 + (size_t)(bg_) * SEQ * 256)) >> 32)) << 32) | (unsigned)__builtin_amdgcn_readfirstlane((int)(unsigned)(unsigned long long)(KV8 + (size_t)(bg_) * SEQ * 256))), (short)0, SEQ * 256, 0x00020000)
#define DSA_LOAD(idp, cc, rs_) { int sj_[4]; _Pragma("unroll") for (int j = 0; j < 4; ++j) sj_[j] = (idp)[(cc) * 32 + 8 * j + (lane >> 3)]; __builtin_amdgcn_sched_barrier(0); \
        _Pragma("unroll") for (int j = 0; j < 4; ++j) { const int vo_ = (max(sj_[j], 0) << 8) + (lane & 7) * 16; stk[j] = __builtin_bit_cast(v4u, __builtin_amdgcn_raw_buffer_load_b128(rs_, vo_, 0, 0)); stv[j] = __builtin_bit_cast(v4u, __builtin_amdgcn_raw_buffer_load_b128(rs_, vo_ + 128, 0, 0)); } }
    { DSA_UNIT(ub_, 0, bg0, t0_, tok0); (void)t0_; (void)tok0; const __amdgpu_buffer_rsrc_t rs0 = DSA_RSRC(bg0); DSA_LOAD(idl, 0, rs0) }
    for (int k = 0; k < nun; ++k) {
        DSA_UNIT(uc_, k, bg, t, tok); const int b = bg >> 2, g = bg & 3; (void)b;
        LAS int* idc = idl + (k & 1) * 256; LAS int* idn = idl + ((k + 1) & 1) * 256;
        long qf[4];
#pragma unroll
        for (int ks = 0; ks < 4; ++ks) { const v4u v = qraw[ks];
            int w0 = __builtin_amdgcn_cvt_pk_fp8_f32(__uint_as_float(v.x << 16) * 16.f, __uint_as_float(v.x & 0xffff0000u) * 16.f, 0, false); w0 = __builtin_amdgcn_cvt_pk_fp8_f32(__uint_as_float(v.y << 16) * 16.f, __uint_as_float(v.y & 0xffff0000u) * 16.f, w0, true);
            int w1 = __builtin_amdgcn_cvt_pk_fp8_f32(__uint_as_float(v.z << 16) * 16.f, __uint_as_float(v.z & 0xffff0000u) * 16.f, 0, false); w1 = __builtin_amdgcn_cvt_pk_fp8_f32(__uint_as_float(v.w << 16) * 16.f, __uint_as_float(v.w & 0xffff0000u) * 16.f, w1, true);
            qf[ks] = hl < 4 ? (long)(((unsigned long long)(unsigned)w1 << 32) | (unsigned)w0) : 0L; }
        unsigned long long fastmask;
        { const int mn_ = min(min(ivn[0], ivn[1]), min(ivn[2], ivn[3])), mx_ = max(max(ivn[0], ivn[1]), max(ivn[2], ivn[3])); fastmask = __ballot(mn_ >= 0 && t - mx_ >= 128); }
        DSA_UNIT(un_, k + 1, bgn, tn, tokn); (void)tn;
        ivn = *(const GAS v4i*)(IDX + tokn * TOPK + lane * 4);
        { const GAS bf16* qs = (const GAS bf16*)(Q + tokn * DM + ((bgn & 3) * 4 + hsel) * HDIM + 8 * Gq);
#pragma unroll
          for (int ks = 0; ks < 4; ++ks) qraw[ks] = *(const GAS v4u*)(qs + ks * 32); }
        const __amdgpu_buffer_rsrc_t kvbn = DSA_RSRC(bgn), kvbase = DSA_RSRC(bg);
        const int hq = g * 4 + hsel; const float bfar = tab[128 * 16 + hq] * 1.4426950408889634f;
        float mrun = -3.0e38f, lsum = 0.f; f32x4 O[8];
#pragma unroll
        for (int db = 0; db < 8; ++db) O[db] = (f32x4){0.f, 0.f, 0.f, 0.f};
#pragma unroll 1
        for (int cc = 0; cc < 8; ++cc) {
#pragma unroll
            for (int j = 0; j < 4; ++j) { const int key = 8 * j + (lane >> 3), pc = lane & 7;
                *(LAS v4u*)(kb + key * KSTR + pc * 16) = stk[j];
                const unsigned w[4] = {stv[j].x, stv[j].y, stv[j].z, stv[j].w}; unsigned o[8];
#pragma unroll
                for (int e = 0; e < 4; ++e) { typedef __bf16 bf2_t __attribute__((ext_vector_type(2))); o[2 * e] = __builtin_bit_cast(unsigned, (bf2_t)__builtin_amdgcn_cvt_scalef32_pk_bf16_fp8(w[e], 1.0f, false)); o[2 * e + 1] = __builtin_bit_cast(unsigned, (bf2_t)__builtin_amdgcn_cvt_scalef32_pk_bf16_fp8(w[e], 1.0f, true)); }
                *(LAS v4u*)(vb + key * VSTR + pc * 32) = (v4u){o[0], o[1], o[2], o[3]}; *(LAS v4u*)(vb + key * VSTR + pc * 32 + 16) = (v4u){o[4], o[5], o[6], o[7]}; }
            if (cc < 7) { DSA_LOAD(idc, cc + 1, kvbase) } else { *(LAS v4i*)(idn + lane * 4) = ivn; DSA_LOAD(idn, 0, kvbn) }
            long ka[2][4];
#pragma unroll
            for (int rb = 0; rb < 2; ++rb)
#pragma unroll
                for (int ks = 0; ks < 4; ++ks) ka[rb][ks] = *(const LAS long*)(kb + (16 * rb + hl) * KSTR + ks * 32 + 8 * Gq);
            __builtin_amdgcn_sched_barrier(0);
            f32x4 S[2];
#pragma unroll
            for (int rb = 0; rb < 2; ++rb) S[rb] = (f32x4){0.f, 0.f, 0.f, 0.f};
#pragma unroll
            for (int ks = 0; ks < 4; ++ks)
#pragma unroll
                for (int rb = 0; rb < 2; ++rb) S[rb] = __builtin_amdgcn_mfma_f32_16x16x32_fp8_fp8(ka[rb][ks], qf[ks], S[rb], 0, 0, 0);
            float l[2][4]; float cmax = -3.0e38f;
            if (((fastmask >> (8 * cc)) & 0xFFull) == 0xFFull) {
#pragma unroll
                for (int rb = 0; rb < 2; ++rb)
#pragma unroll
                    for (int i = 0; i < 4; ++i) { const float v = fmaf(S[rb][i], ATT_SCALE * (1.f / 256.f) * 1.4426950408889634f, bfar); l[rb][i] = v; cmax = fmaxf(cmax, v); }
            } else {
                const v4i sv0 = *(const LAS v4i*)(idc + cc * 32 + 4 * Gq), sv1 = *(const LAS v4i*)(idc + cc * 32 + 16 + 4 * Gq);
#pragma unroll
                for (int rb = 0; rb < 2; ++rb)
#pragma unroll
                    for (int i = 0; i < 4; ++i) { const int s_ = rb ? sv1[i] : sv0[i]; int rel = t - s_; rel = rel > 128 ? 128 : (rel < 0 ? 0 : rel);
                        const float v = (s_ >= 0) ? (S[rb][i] * (ATT_SCALE * (1.f / 256.f)) + tab[rel * 16 + hq]) * 1.4426950408889634f : -1.0e30f; l[rb][i] = v; cmax = fmaxf(cmax, v); }
            }
            cmax = bfly32_max(bfly16_max(cmax));
            const float mnew = fmaxf(mrun, cmax);
            if (__any(mnew > mrun)) {
                const float alpha = __builtin_amdgcn_exp2f(mrun - mnew); lsum *= alpha;
#pragma unroll
                for (int db = 0; db < 8; ++db) O[db] = O[db] * alpha;
            }
            mrun = mnew;
            float ps = 0.f;
#pragma unroll
            for (int rb = 0; rb < 2; ++rb)
#pragma unroll
                for (int i = 0; i < 4; ++i) { l[rb][i] = __builtin_amdgcn_exp2f(l[rb][i] - mnew); ps += l[rb][i]; }
            lsum += ps;
            v4u pu; pu.x = pkbf(l[0][0], l[0][1]); pu.y = pkbf(l[0][2], l[0][3]); pu.z = pkbf(l[1][0], l[1][1]); pu.w = pkbf(l[1][2], l[1][3]);
            const bf16x8 pa = __builtin_bit_cast(bf16x8, pu);
            s16x4 vt[8][2];
#pragma unroll
            for (int db = 0; db < 8; ++db) { vt[db][0] = vtr(vb + (4 * Gq + qrow) * VSTR + (16 * db + 4 * pcol) * 2); vt[db][1] = vtr(vb + (16 + 4 * Gq + qrow) * VSTR + (16 * db + 4 * pcol) * 2); }
            __builtin_amdgcn_sched_barrier(0);
#pragma unroll
            for (int db = 0; db < 8; ++db) { const s16x4 v0 = vt[db][0], v1 = vt[db][1];
                const bf16x8 a = (bf16x8){v0[0], v0[1], v0[2], v0[3], v1[0], v1[1], v1[2], v1[3]};
                O[db] = __builtin_amdgcn_mfma_f32_16x16x32_bf16(a, pa, O[db], 0, 0, 0); }
        }
#undef DSA_LOAD
#undef DSA_RSRC
#undef DSA_UNIT
        lsum = bfly32_sum(bfly16_sum(lsum));
        const float inv = 1.0f / (lsum * 16.0f);
        if (hl < 4) { GAS bf16* op = (GAS bf16*)(AO + tok * DM + (g * 4 + hl) * HDIM + 4 * Gq);
#pragma unroll
            for (int db = 0; db < 8; ++db) { const f32x4 o = O[db] * inv; v2u w; w.x = pkbf(o[0], o[1]); w.y = pkbf(o[2], o[3]); *(GAS v2u*)(op + 16 * db) = w; } }
    }
}

__device__ __forceinline__ void swa_attn_phase(LAS unsigned char* lds, const bf16* Q, const bf16* KV, bf16* AO, const float* rel_bias, const float* sinks, int c, int G, int tid, int wave, int lane) {
    LAS unsigned char* band = lds;
    LAS float* tab = (LAS float*)(lds + 272 * 528);
    LAS float* tabM = tab + TAB_ENTRIES;
    build_bias_tab(tab, rel_bias, tid);
    for (int i = tid; i < 16 * 528 / 4; i += NWAVES * 64) ((LAS unsigned*)(band + 256 * 528))[i] = 0u;
    const int hl = lane & 15, Gq = lane >> 4, qrow = hl >> 2, pcol = lane & 3;
    for (int uid = c; uid < 512; uid += G) {
        const int b = uid >> 8, nb = (uid & 255) >> 2, g = uid & 3, bg = b * 4 + g;
        __syncthreads();
        { const int piece = tid & 31;
#pragma unroll 4
          for (int i = 0; i < 16; ++i) { const int row = (tid >> 5) + 16 * i, ka = nb * 128 - 128 + row; v4u v = (v4u){0u, 0u, 0u, 0u};
              if (ka >= 0) v = *(const GAS v4u*)(KV + ((size_t)bg * SEQ + ka) * 256 + piece * 8);
              *(LAS v4u*)(band + row * 528 + piece * 16) = v; } }
        for (int e = tid; e < 4 * 176; e += NWAVES * 64) { const int r = e / 176, rel = e - r * 176 - 31; tabM[e] = (rel >= 0 && rel < 128) ? tab[rel * 16 + g * 4 + r] * 1.4426950408889634f : -1.0e30f; }
        __syncthreads();
        const int ql = 16 * wave + hl, t = nb * 128 + ql, cbase = 16 * wave; const size_t tok = (size_t)b * SEQ + t;
        bf16x8 qn[4];
        { const GAS bf16* qs = (const GAS bf16*)(Q + tok * DM + (g * 4) * HDIM + 8 * Gq);
#pragma unroll
          for (int ks = 0; ks < 4; ++ks) qn[ks] = *(const GAS bf16x8*)(qs + ks * 32); }
#pragma unroll 1
        for (int r = 0; r < 4; ++r) {
            const int hq = g * 4 + r;
            bf16x8 qf[4];
#pragma unroll
            for (int ks = 0; ks < 4; ++ks) qf[ks] = qn[ks];
            { const GAS bf16* qs = (const GAS bf16*)(Q + tok * DM + (g * 4 + (r < 3 ? r + 1 : 3)) * HDIM + 8 * Gq);
#pragma unroll
              for (int ks = 0; ks < 4; ++ks) qn[ks] = *(const GAS bf16x8*)(qs + ks * 32); }
            f32x4 S[10];
#pragma unroll
            for (int rh = 0; rh < 2; ++rh) {
                bf16x8 ka[5][4];
#pragma unroll
                for (int r5 = 0; r5 < 5; ++r5)
#pragma unroll
                    for (int ks = 0; ks < 4; ++ks) ka[r5][ks] = *(const LAS bf16x8*)(band + (cbase + 16 * (5 * rh + r5) + hl) * 528 + (ks * 32 + 8 * Gq) * 2);
                __builtin_amdgcn_sched_barrier(0);
#pragma unroll
                for (int r5 = 0; r5 < 5; ++r5) S[5 * rh + r5] = (f32x4){0.f, 0.f, 0.f, 0.f};
#pragma unroll
                for (int ks = 0; ks < 4; ++ks)
#pragma unroll
                    for (int r5 = 0; r5 < 5; ++r5) S[5 * rh + r5] = __builtin_amdgcn_mfma_f32_16x16x32_bf16(ka[r5][ks], qf[ks], S[5 * rh + r5], 0, 0, 0);
            }
            const float sink2 = sinks[hq] * 1.4426950408889634f; float mx = sink2;
            const LAS float* tlow = tabM + r * 176 + (hl - 4 * Gq + 12);
            float bv[10][4];
#pragma unroll
            for (int rb = 0; rb < 10; ++rb)
#pragma unroll
                for (int i = 0; i < 4; ++i) bv[rb][i] = tlow[147 - 16 * rb - i];
#pragma unroll
            for (int rb = 0; rb < 10; ++rb)
#pragma unroll
                for (int i = 0; i < 4; ++i) S[rb][i] = S[rb][i] * (ATT_SCALE * 1.4426950408889634f) + bv[rb][i];
            if (nb == 0) {
#pragma unroll
                for (int rb = 0; rb < 8; ++rb) if (rb < 8 - wave) S[rb] = (f32x4){-1.0e30f, -1.0e30f, -1.0e30f, -1.0e30f};
            }
#pragma unroll
            for (int rb = 0; rb < 10; ++rb) mx = fmaxf(mx, fmaxf(fmaxf(S[rb][0], S[rb][1]), fmaxf(S[rb][2], S[rb][3])));
            mx = bfly32_max(bfly16_max(mx));
            float sum = 0.f;
#pragma unroll
            for (int rb = 0; rb < 10; ++rb)
#pragma unroll
                for (int i = 0; i < 4; ++i) { const float p = __builtin_amdgcn_exp2f(S[rb][i] - mx); S[rb][i] = p; sum += p; }
            sum = bfly32_sum(bfly16_sum(sum)); sum += __builtin_amdgcn_exp2f(sink2 - mx);
            const float inv = 1.0f / sum;
            f32x4 O[8];
#pragma unroll
            for (int db = 0; db < 8; ++db) O[db] = (f32x4){0.f, 0.f, 0.f, 0.f};
#pragma unroll
            for (int ch = 0; ch < 5; ++ch) {
                v4u pu; pu.x = pkbf(S[2 * ch][0], S[2 * ch][1]); pu.y = pkbf(S[2 * ch][2], S[2 * ch][3]); pu.z = pkbf(S[2 * ch + 1][0], S[2 * ch + 1][1]); pu.w = pkbf(S[2 * ch + 1][2], S[2 * ch + 1][3]);
                const bf16x8 pa = __builtin_bit_cast(bf16x8, pu);
                s16x4 vt[8][2];
#pragma unroll
                for (int db = 0; db < 8; ++db) { vt[db][0] = vtr(band + (cbase + 32 * ch + 4 * Gq + qrow) * 528 + 256 + (16 * db + 4 * pcol) * 2); vt[db][1] = vtr(band + (cbase + 32 * ch + 16 + 4 * Gq + qrow) * 528 + 256 + (16 * db + 4 * pcol) * 2); }
                __builtin_amdgcn_sched_barrier(0);
#pragma unroll
                for (int db = 0; db < 8; ++db) { const s16x4 v0 = vt[db][0], v1 = vt[db][1];
                    const bf16x8 a = (bf16x8){v0[0], v0[1], v0[2], v0[3], v1[0], v1[1], v1[2], v1[3]};
                    O[db] = __builtin_amdgcn_mfma_f32_16x16x32_bf16(a, pa, O[db], 0, 0, 0); }
            }
            GAS bf16* op = (GAS bf16*)(AO + tok * DM + hq * HDIM + 4 * Gq);
#pragma unroll
            for (int db = 0; db < 8; ++db) { const f32x4 o = O[db] * inv; v2u w; w.x = pkbf(o[0], o[1]); w.y = pkbf(o[2], o[3]); *(GAS v2u*)(op + 16 * db) = w; }
        }
    }
}
#ifndef REPP
#define REPP 1
#endif
#ifndef REP0
#define REP0 1
#endif
#ifndef REP1
#define REP1 1
#endif
#ifndef REP2
#define REP2 1
#endif
#ifndef REP3D
#define REP3D 1
#endif
#ifndef REP3S
#define REP3S 1
#endif
#ifndef REP4
#define REP4 1
#endif
#ifndef REP5
#define REP5 1
#endif
#ifndef REP6
#define REP6 1
#endif
#ifndef REP7
#define REP7 1
#endif
#ifndef REP8
#define REP8 1
#endif
#ifndef REP9
#define REP9 1
#endif
#ifndef REP10
#define REP10 1
#endif
#ifndef REP11
#define REP11 1
#endif
#ifndef DEFER_CONV
#define DEFER_CONV 1
#endif
#ifndef CONV_GG
#define CONV_GG 224
#endif
#ifndef NOS1
#define NOS1 0
#endif
#ifndef NOS4
#define NOS4 0
#endif
#ifndef NOS6
#define NOS6 0
#endif
#ifndef NOS7
#define NOS7 0
#endif
#ifndef NOS8
#define NOS8 0
#endif
#ifndef NOS9
#define NOS9 0
#endif
#ifndef NOS11
#define NOS11 0
#endif

constexpr int PH_FINAL = 1 + 12 * DEPTH, PH_END = PH_FINAL + 1;
struct Args { const float* in[19]; float* out; unsigned char* ws; int ph_lo, ph_hi; };
__global__ void __launch_bounds__(NWAVES * 64, 2) yoco_fwd(Args args) {
    extern __shared__ __attribute__((aligned(16))) unsigned char lds_raw[];
    LAS unsigned char* lds = (LAS unsigned char*)lds_raw;
    volatile LAS unsigned* MISC = (volatile LAS unsigned*)(lds + MISC_OFF);
    const int tid = threadIdx.x, lane = tid & 63, wave = __builtin_amdgcn_readfirstlane(tid >> 6);
    const int G = gridDim.x, bx = blockIdx.x, vcu = (G % 8 == 0) ? (bx % 8) * (G / 8) + bx / 8 : bx;
    const int gw = vcu * NWAVES + wave, NGW = G * NWAVES;
    for (int u = tid; u < 64; u += NWAVES * 64) MISC[u] = 0u;
    __syncthreads();
    gu32* ctl = (gu32*)(args.ws + WS_CTL);
    XcdBarrier bar; bar.bar = (unsigned*)ctl + CW_BAR; bar.x = 0; bar.st = nullptr;
    if (!MK_PER_PHASE) bar = xcd_barrier_post((unsigned*)ctl + CW_BAR, MISC + 8);
#define GRID_BAR() do { if (!MK_PER_PHASE) xcd_barrier(bar); } while (0)
    const int lo = args.ph_lo, hi = args.ph_hi;
#define IN(k) (lo <= (k) && (k) < hi)
#define SITE() unsigned char* wsp = args.ws; float* Xp = args.out; int bxs = blockIdx.x, Gs = gridDim.x, tids = threadIdx.x; \
    asm volatile("" : "+s"(wsp), "+s"(Xp), "+s"(bxs), "+s"(Gs), "+v"(tids)); \
    const int lanes = tids & 63, waves = __builtin_amdgcn_readfirstlane(tids >> 6); \
    const int vcus = (Gs % 8 == 0) ? (bxs % 8) * (Gs / 8) + bxs / 8 : bxs, gws = vcus * NWAVES + waves, NGWs = Gs * NWAVES; (void)lanes; (void)gws; (void)NGWs; (void)Xp; (void)wsp
#define x_in (args.in[0])
#define X (Xp)
#define XN ((bf16*)(wsp + WS_XN))
#define Qb ((bf16*)(wsp + WS_Q))
#define AOb ((bf16*)(wsp + WS_AO))
#define QIb ((bf16*)(wsp + WS_QI))
#define KIWb ((bf16*)(wsp + WS_KIW))
#define IDXb ((int*)(wsp + WS_IDX))
#define KITb ((bf16*)(wsp + WS_KIT))
#define KVA ((bf16*)(wsp + WS_KVA))
#define KVB ((bf16*)(wsp + WS_KVB))
#define Ub ((bf16*)(wsp + WS_U))
#define PEb ((bf16*)(wsp + WS_PE))
#define PB ((bf16*)(wsp + WS_PB))
#define XNB2 ((bf16*)(wsp + WS_XNB))
#define SSQ(i) ((float*)(wsp + WS_SSP) + (size_t)(i) * M * 32)
#define RTAB ((LAS float*)(lds + RTAB_OFF))

#ifndef NO_PRO
    for (int rep = 0; rep < REPP; ++rep) if (IN(0)) { SITE();
        LAS float* scr = (LAS float*)(lds + waves * 16640);
        int rot = 0;
        for (int i = 0; i < N_A; ++i) conv_matrix(args.in[2] + (size_t)i * DM * A_IN, args.in[10] + (size_t)i * DM, DM, A_IN, (bf16*)(wsp + WS_WIN) + (size_t)i * A_INP * DM, 1, scr, gws, NGWs, lanes, rot);
        const bool defer = DEFER_CONV && Gs == 256;
        for (int i = 0; i < N_A; ++i) if (!(defer && i == 1)) conv_matrix(args.in[3] + (size_t)i * DM * DM, nullptr, DM, DM, (bf16*)(wsp + WS_WOA) + (size_t)i * DM * DM, 0, scr, gws, NGWs, lanes, rot);
        for (int i = 0; i < DEPTH - N_A; ++i) conv_matrix(args.in[4] + (size_t)i * DM * DM, args.in[10] + (size_t)(N_A + i) * DM, DM, DM, (bf16*)(wsp + WS_WQB) + (size_t)i * DM * DM, 0, scr, gws, NGWs, lanes, rot);
        for (int i = 0; i < DEPTH - N_A; ++i) conv_matrix(args.in[5] + (size_t)i * DM * DM, nullptr, DM, DM, (bf16*)(wsp + WS_WOB) + (size_t)i * DM * DM, 0, scr, gws, NGWs, lanes, rot);
        conv_matrix(args.in[8], args.in[7], DM, 1024, (bf16*)(wsp + WS_WKV), 2, scr, gws, NGWs, lanes, rot);
        for (int i = 0; i < DEPTH; ++i) if (!(defer && i == 1)) conv_matrix(args.in[17] + (size_t)i * DM * DM, args.in[15] + (size_t)i * DM, DM, DM, (bf16*)(wsp + WS_WPG) + (size_t)i * DM * DM, 0, scr, gws, NGWs, lanes, rot);
        for (int i = 0; i < DEPTH; ++i) conv_matrix(args.in[16] + (size_t)i * PLE * DM, nullptr, PLE, DM, (bf16*)(wsp + WS_WPE) + (size_t)i * DM * PLE, 0, scr, gws, NGWs, lanes, rot);
        for (int i = 0; i < DEPTH; ++i) if (!(defer && (i == 1 || i == 2))) conv_matrix(args.in[12] + (size_t)i * DM * DFF, args.in[11] + (size_t)i * DM, DM, DFF, (bf16*)(wsp + WS_W13) + (size_t)i * 2 * DFF * DM, 3, scr, gws, NGWs, lanes, rot);
        for (int i = 0; i < DEPTH; ++i) if (!(defer && (i == 1 || i == 2))) conv_matrix(args.in[13] + (size_t)i * DM * DFF, args.in[11] + (size_t)i * DM, DM, DFF, (bf16*)(wsp + WS_W13) + (size_t)i * 2 * DFF * DM, 4, scr, gws, NGWs, lanes, rot);
        for (int i = 0; i < DEPTH; ++i) if (!(defer && i == 2)) conv_matrix(args.in[14] + (size_t)i * DFF * DM, nullptr, DFF, DM, (bf16*)(wsp + WS_W2) + (size_t)i * DM * DFF, 0, scr, gws, NGWs, lanes, rot);
        const size_t gt = (size_t)vcus * (NWAVES * 64) + tids, NT = (size_t)Gs * (NWAVES * 64);
        for (int i = 0; i < N_A; ++i) { GAS v4u* z = (GAS v4u*)((bf16*)(wsp + WS_WIN) + ((size_t)i * A_INP + A_IN) * DM);
            for (size_t e = gt; e < (size_t)(A_INP - A_IN) * DM / 8; e += NT) z[e] = (v4u){0u, 0u, 0u, 0u}; }
        { const GAS f32x4* ps = (const GAS f32x4*)args.in[1]; GAS v4u* pd = (GAS v4u*)PB;
          for (size_t e = gt; e < (size_t)DEPTH * M * PLE / 8; e += 4 * NT) { f32x4 a[4], b[4];
#pragma unroll
              for (int u = 0; u < 4; ++u) { a[u] = ps[2 * (e + u * NT)]; b[u] = ps[2 * (e + u * NT) + 1]; }
#pragma unroll
              for (int u = 0; u < 4; ++u) { v4u o; o.x = pk2(a[u].x, a[u].y); o.y = pk2(a[u].z, a[u].w); o.z = pk2(b[u].x, b[u].y); o.w = pk2(b[u].z, b[u].w); pd[e + u * NT] = o; } } }
        xb_phase(x_in, XNB2, SSQ(12), gws, NGWs, lanes);
        GRID_BAR();
    }
#endif

    { constexpr int L = 0;
        const int pb = 1 + 12 * L; const bool dsa = L < N_A; const int Lb = L - N_A;
        for (int rep = 0; rep < REP1; ++rep) if (IN(pb + 1) && !NOS1) { SITE();
            const bf16* Bt = dsa ? (const bf16*)(wsp + WS_WIN) + (size_t)L * A_INP * DM : (const bf16*)(wsp + WS_WQB) + (size_t)Lb * DM * DM; const int N = dsa ? A_INP : DM;
            const bool part = DEFER_CONV && dsa && Gs == 256; const int Gg = part ? CONV_GG : Gs;
            pg8::Gemm g{XNB2, Bt, M, N, DM, 1}; pg8::StaticOrder S; S.init(M, N, Gg, bxs); if (part && bxs >= Gg) S.nwg = 0;
            pg8::rs_finalize(RTAB, S, SSQ(L == 0 ? 12 : 3 * (L - 1) + 2), tids);
            pg8::EpiBf16Map E{dsa ? 1 : 0, Qb, DM, KVA, QIb, KIWb, RTAB, KITb};
            pg8::gemm_phase<pg8::EpiBf16Map, pg8::StaticOrder, true, true>(lds, g, S, E);
            if (part && rep == 0 && bxs >= Gg) {
                __syncthreads();
                LAS float* scr = (LAS float*)(lds + waves * 16640); int rot = 0; const int gw2 = (bxs - Gg) * NWAVES + waves, NGW2 = (Gs - Gg) * NWAVES; const int Ld = L + 1;
                conv_matrix(args.in[12] + (size_t)Ld * DM * DFF, args.in[11] + (size_t)Ld * DM, DM, DFF, (bf16*)(wsp + WS_W13) + (size_t)Ld * 2 * DFF * DM, 3, scr, gw2, NGW2, lanes, rot);
                conv_matrix(args.in[13] + (size_t)Ld * DM * DFF, args.in[11] + (size_t)Ld * DM, DM, DFF, (bf16*)(wsp + WS_W13) + (size_t)Ld * 2 * DFF * DM, 4, scr, gw2, NGW2, lanes, rot);
                if (L == 0) { conv_matrix(args.in[17] + (size_t)1 * DM * DM, args.in[15] + (size_t)1 * DM, DM, DM, (bf16*)(wsp + WS_WPG) + (size_t)1 * DM * DM, 0, scr, gw2, NGW2, lanes, rot);
                              conv_matrix(args.in[3] + (size_t)1 * DM * DM, nullptr, DM, DM, (bf16*)(wsp + WS_WOA) + (size_t)1 * DM * DM, 0, scr, gw2, NGW2, lanes, rot); }
                else conv_matrix(args.in[14] + (size_t)2 * DFF * DM, nullptr, DFF, DM, (bf16*)(wsp + WS_W2) + (size_t)2 * DM * DFF, 0, scr, gw2, NGW2, lanes, rot);
            }
            GRID_BAR();
        }
#ifndef NO_IDX
        for (int rep = 0; rep < REP2; ++rep) if (dsa && IN(pb + 2)) { SITE(); indexer_phase(lds, QIb, KIWb, KITb, IDXb, bxs, Gs, tids, waves, lanes); GRID_BAR(); }
#endif
        for (int rep = 0; rep < (dsa ? REP3D : REP3S); ++rep) if (IN(pb + 3)) { SITE();
#ifndef NO_DSA
            if (dsa) dsa_attn_phase(lds, Qb, (const unsigned char*)KVA, IDXb, AOb, args.in[9], bxs, Gs, tids, waves, lanes);
#endif
#ifndef NO_SWA
            if (!dsa) swa_attn_phase(lds, Qb, KVB, AOb, args.in[9], args.in[6] + (size_t)Lb * NHEAD, bxs, Gs, tids, waves, lanes);
#endif
            GRID_BAR();
        }
        for (int rep = 0; rep < REP4; ++rep) if (IN(pb + 4) && !NOS4) { SITE();
            const bf16* Bt = dsa ? (const bf16*)(wsp + WS_WOA) + (size_t)L * DM * DM : (const bf16*)(wsp + WS_WOB) + (size_t)Lb * DM * DM;
            pg8::Gemm g{AOb, Bt, M, DM, DM}; pg8::StaticOrder S; S.init(M, DM, Gs, bxs);
            pg8::EpiResid E{XNB2, rep ? Qb : XN, rep ? (float*)(wsp + WS_QI) : SSQ(3 * L)};
            pg8::gemm_phase<pg8::EpiResid, pg8::StaticOrder, true, true>(lds, g, S, E);
            GRID_BAR();
        }
        for (int rep = 0; rep < REP6; ++rep) if (IN(pb + 6) && !NOS6) { SITE();
            pg8::Gemm g{XN, (const bf16*)(wsp + WS_W13) + (size_t)L * 2 * DFF * DM, M, 2 * DFF, DM, 1}; pg8::StaticOrder S; S.init(M, 2 * DFF, Gs, bxs);
            pg8::rs_finalize(RTAB, S, SSQ(3 * L), tids);
            pg8::EpiSwiglu E{Ub, RTAB};
            pg8::gemm_phase<pg8::EpiSwiglu, pg8::StaticOrder, true, true>(lds, g, S, E);
            GRID_BAR();
        }
        for (int rep = 0; rep < REP7; ++rep) if (IN(pb + 7) && !NOS7) { SITE();
            { pg8::Gemm g{Ub, (const bf16*)(wsp + WS_W2) + (size_t)L * DM * DFF, M, DM, DFF, 1}; pg8::StaticOrder S; S.init(M, DM, Gs, bxs);
              pg8::EpiResid E{XN, rep ? XNB2 : XN, rep ? SSQ(3 * L + 2) : SSQ(3 * L + 1)};
              pg8::gemm_phase<pg8::EpiResid, pg8::StaticOrder, true, true>(lds, g, S, E); }
            { pg8::Gemm g{PB + (size_t)L * M * PLE, (const bf16*)(wsp + WS_WPE) + (size_t)L * DM * PLE, M, DM, PLE}; pg8::StaticOrder S; S.init(M, DM, Gs, bxs);
              pg8::EpiBf16Map E{3, PEb, DM, nullptr, nullptr, nullptr, nullptr, nullptr};
              pg8::gemm_phase<pg8::EpiBf16Map, pg8::StaticOrder, true, true>(lds, g, S, E); }
            GRID_BAR();
        }
        for (int rep = 0; rep < REP9; ++rep) if (IN(pb + 9) && !NOS9) { SITE();
            pg8::Gemm g{XN, (const bf16*)(wsp + WS_WPG) + (size_t)L * DM * DM, M, DM, DM, 1}; pg8::StaticOrder S; S.init(M, DM, Gs, bxs);
            pg8::rs_finalize(RTAB, S, SSQ(3 * L + 1), tids);
            pg8::EpiGate E{XN, PEb, RTAB, rep ? Qb : XNB2, rep ? (float*)(wsp + WS_QI) : SSQ(3 * L + 2)};
            pg8::gemm_phase<pg8::EpiGate, pg8::StaticOrder, true, true>(lds, g, S, E);
            GRID_BAR();
        }
        if (L == N_A - 1) {
            for (int rep = 0; rep < REP11; ++rep) if (IN(pb + 11) && !NOS11) { SITE();
                pg8::Gemm g{XNB2, (const bf16*)(wsp + WS_WKV), M, 1024, DM, 1}; pg8::StaticOrder S; S.init(M, 1024, Gs, bxs);
                pg8::rs_finalize(RTAB, S, SSQ(3 * L + 2), tids);
                pg8::EpiBf16Map E{2, nullptr, 0, KVB, nullptr, nullptr, RTAB, nullptr};
                pg8::gemm_phase<pg8::EpiBf16Map, pg8::StaticOrder, true, true>(lds, g, S, E);
                GRID_BAR();
            }
        }
        }
    { constexpr int L = 1;
        const int pb = 1 + 12 * L; const bool dsa = L < N_A; const int Lb = L - N_A;
        for (int rep = 0; rep < REP1; ++rep) if (IN(pb + 1) && !NOS1) { SITE();
            const bf16* Bt = dsa ? (const bf16*)(wsp + WS_WIN) + (size_t)L * A_INP * DM : (const bf16*)(wsp + WS_WQB) + (size_t)Lb * DM * DM; const int N = dsa ? A_INP : DM;
            const bool part = DEFER_CONV && dsa && Gs == 256; const int Gg = part ? CONV_GG : Gs;
            pg8::Gemm g{XNB2, Bt, M, N, DM, 1}; pg8::StaticOrder S; S.init(M, N, Gg, bxs); if (part && bxs >= Gg) S.nwg = 0;
            pg8::rs_finalize(RTAB, S, SSQ(L == 0 ? 12 : 3 * (L - 1) + 2), tids);
            pg8::EpiBf16Map E{dsa ? 1 : 0, Qb, DM, KVA, QIb, KIWb, RTAB, KITb};
            pg8::gemm_phase<pg8::EpiBf16Map, pg8::StaticOrder, true, true>(lds, g, S, E);
            if (part && rep == 0 && bxs >= Gg) {
                __syncthreads();
                LAS float* scr = (LAS float*)(lds + waves * 16640); int rot = 0; const int gw2 = (bxs - Gg) * NWAVES + waves, NGW2 = (Gs - Gg) * NWAVES; const int Ld = L + 1;
                conv_matrix(args.in[12] + (size_t)Ld * DM * DFF, args.in[11] + (size_t)Ld * DM, DM, DFF, (bf16*)(wsp + WS_W13) + (size_t)Ld * 2 * DFF * DM, 3, scr, gw2, NGW2, lanes, rot);
                conv_matrix(args.in[13] + (size_t)Ld * DM * DFF, args.in[11] + (size_t)Ld * DM, DM, DFF, (bf16*)(wsp + WS_W13) + (size_t)Ld * 2 * DFF * DM, 4, scr, gw2, NGW2, lanes, rot);
                if (L == 0) { conv_matrix(args.in[17] + (size_t)1 * DM * DM, args.in[15] + (size_t)1 * DM, DM, DM, (bf16*)(wsp + WS_WPG) + (size_t)1 * DM * DM, 0, scr, gw2, NGW2, lanes, rot);
                              conv_matrix(args.in[3] + (size_t)1 * DM * DM, nullptr, DM, DM, (bf16*)(wsp + WS_WOA) + (size_t)1 * DM * DM, 0, scr, gw2, NGW2, lanes, rot); }
                else conv_matrix(args.in[14] + (size_t)2 * DFF * DM, nullptr, DFF, DM, (bf16*)(wsp + WS_W2) + (size_t)2 * DM * DFF, 0, scr, gw2, NGW2, lanes, rot);
            }
            GRID_BAR();
        }
#ifndef NO_IDX
        for (int rep = 0; rep < REP2; ++rep) if (dsa && IN(pb + 2)) { SITE(); indexer_phase(lds, QIb, KIWb, KITb, IDXb, bxs, Gs, tids, waves, lanes); GRID_BAR(); }
#endif
        for (int rep = 0; rep < (dsa ? REP3D : REP3S); ++rep) if (IN(pb + 3)) { SITE();
#ifndef NO_DSA
            if (dsa) dsa_attn_phase(lds, Qb, (const unsigned char*)KVA, IDXb, AOb, args.in[9], bxs, Gs, tids, waves, lanes);
#endif
#ifndef NO_SWA
            if (!dsa) swa_attn_phase(lds, Qb, KVB, AOb, args.in[9], args.in[6] + (size_t)Lb * NHEAD, bxs, Gs, tids, waves, lanes);
#endif
            GRID_BAR();
        }
        for (int rep = 0; rep < REP4; ++rep) if (IN(pb + 4) && !NOS4) { SITE();
            const bf16* Bt = dsa ? (const bf16*)(wsp + WS_WOA) + (size_t)L * DM * DM : (const bf16*)(wsp + WS_WOB) + (size_t)Lb * DM * DM;
            pg8::Gemm g{AOb, Bt, M, DM, DM}; pg8::StaticOrder S; S.init(M, DM, Gs, bxs);
            pg8::EpiResid E{XNB2, rep ? Qb : XN, rep ? (float*)(wsp + WS_QI) : SSQ(3 * L)};
            pg8::gemm_phase<pg8::EpiResid, pg8::StaticOrder, true, true>(lds, g, S, E);
            GRID_BAR();
        }
        for (int rep = 0; rep < REP6; ++rep) if (IN(pb + 6) && !NOS6) { SITE();
            pg8::Gemm g{XN, (const bf16*)(wsp + WS_W13) + (size_t)L * 2 * DFF * DM, M, 2 * DFF, DM, 1}; pg8::StaticOrder S; S.init(M, 2 * DFF, Gs, bxs);
            pg8::rs_finalize(RTAB, S, SSQ(3 * L), tids);
            pg8::EpiSwiglu E{Ub, RTAB};
            pg8::gemm_phase<pg8::EpiSwiglu, pg8::StaticOrder, true, true>(lds, g, S, E);
            GRID_BAR();
        }
        for (int rep = 0; rep < REP7; ++rep) if (IN(pb + 7) && !NOS7) { SITE();
            { pg8::Gemm g{Ub, (const bf16*)(wsp + WS_W2) + (size_t)L * DM * DFF, M, DM, DFF, 1}; pg8::StaticOrder S; S.init(M, DM, Gs, bxs);
              pg8::EpiResid E{XN, rep ? XNB2 : XN, rep ? SSQ(3 * L + 2) : SSQ(3 * L + 1)};
              pg8::gemm_phase<pg8::EpiResid, pg8::StaticOrder, true, true>(lds, g, S, E); }
            { pg8::Gemm g{PB + (size_t)L * M * PLE, (const bf16*)(wsp + WS_WPE) + (size_t)L * DM * PLE, M, DM, PLE}; pg8::StaticOrder S; S.init(M, DM, Gs, bxs);
              pg8::EpiBf16Map E{3, PEb, DM, nullptr, nullptr, nullptr, nullptr, nullptr};
              pg8::gemm_phase<pg8::EpiBf16Map, pg8::StaticOrder, true, true>(lds, g, S, E); }
            GRID_BAR();
        }
        for (int rep = 0; rep < REP9; ++rep) if (IN(pb + 9) && !NOS9) { SITE();
            pg8::Gemm g{XN, (const bf16*)(wsp + WS_WPG) + (size_t)L * DM * DM, M, DM, DM, 1}; pg8::StaticOrder S; S.init(M, DM, Gs, bxs);
            pg8::rs_finalize(RTAB, S, SSQ(3 * L + 1), tids);
            pg8::EpiGate E{XN, PEb, RTAB, rep ? Qb : XNB2, rep ? (float*)(wsp + WS_QI) : SSQ(3 * L + 2)};
            pg8::gemm_phase<pg8::EpiGate, pg8::StaticOrder, true, true>(lds, g, S, E);
            GRID_BAR();
        }
        if (L == N_A - 1) {
            for (int rep = 0; rep < REP11; ++rep) if (IN(pb + 11) && !NOS11) { SITE();
                pg8::Gemm g{XNB2, (const bf16*)(wsp + WS_WKV), M, 1024, DM, 1}; pg8::StaticOrder S; S.init(M, 1024, Gs, bxs);
                pg8::rs_finalize(RTAB, S, SSQ(3 * L + 2), tids);
                pg8::EpiBf16Map E{2, nullptr, 0, KVB, nullptr, nullptr, RTAB, nullptr};
                pg8::gemm_phase<pg8::EpiBf16Map, pg8::StaticOrder, true, true>(lds, g, S, E);
                GRID_BAR();
            }
        }
        }
    { constexpr int L = 2;
        const int pb = 1 + 12 * L; const bool dsa = L < N_A; const int Lb = L - N_A;
        for (int rep = 0; rep < REP1; ++rep) if (IN(pb + 1) && !NOS1) { SITE();
            const bf16* Bt = dsa ? (const bf16*)(wsp + WS_WIN) + (size_t)L * A_INP * DM : (const bf16*)(wsp + WS_WQB) + (size_t)Lb * DM * DM; const int N = dsa ? A_INP : DM;
            const bool part = DEFER_CONV && dsa && Gs == 256; const int Gg = part ? CONV_GG : Gs;
            pg8::Gemm g{XNB2, Bt, M, N, DM, 1}; pg8::StaticOrder S; S.init(M, N, Gg, bxs); if (part && bxs >= Gg) S.nwg = 0;
            pg8::rs_finalize(RTAB, S, SSQ(L == 0 ? 12 : 3 * (L - 1) + 2), tids);
            pg8::EpiBf16Map E{dsa ? 1 : 0, Qb, DM, KVA, QIb, KIWb, RTAB, KITb};
            pg8::gemm_phase<pg8::EpiBf16Map, pg8::StaticOrder, true, true>(lds, g, S, E);
            if (part && rep == 0 && bxs >= Gg) {
                __syncthreads();
                LAS float* scr = (LAS float*)(lds + waves * 16640); int rot = 0; const int gw2 = (bxs - Gg) * NWAVES + waves, NGW2 = (Gs - Gg) * NWAVES; const int Ld = L + 1;
                conv_matrix(args.in[12] + (size_t)Ld * DM * DFF, args.in[11] + (size_t)Ld * DM, DM, DFF, (bf16*)(wsp + WS_W13) + (size_t)Ld * 2 * DFF * DM, 3, scr, gw2, NGW2, lanes, rot);
                conv_matrix(args.in[13] + (size_t)Ld * DM * DFF, args.in[11] + (size_t)Ld * DM, DM, DFF, (bf16*)(wsp + WS_W13) + (size_t)Ld * 2 * DFF * DM, 4, scr, gw2, NGW2, lanes, rot);
                if (L == 0) { conv_matrix(args.in[17] + (size_t)1 * DM * DM, args.in[15] + (size_t)1 * DM, DM, DM, (bf16*)(wsp + WS_WPG) + (size_t)1 * DM * DM, 0, scr, gw2, NGW2, lanes, rot);
                              conv_matrix(args.in[3] + (size_t)1 * DM * DM, nullptr, DM, DM, (bf16*)(wsp + WS_WOA) + (size_t)1 * DM * DM, 0, scr, gw2, NGW2, lanes, rot); }
                else conv_matrix(args.in[14] + (size_t)2 * DFF * DM, nullptr, DFF, DM, (bf16*)(wsp + WS_W2) + (size_t)2 * DM * DFF, 0, scr, gw2, NGW2, lanes, rot);
            }
            GRID_BAR();
        }
#ifndef NO_IDX
        for (int rep = 0; rep < REP2; ++rep) if (dsa && IN(pb + 2)) { SITE(); indexer_phase(lds, QIb, KIWb, KITb, IDXb, bxs, Gs, tids, waves, lanes); GRID_BAR(); }
#endif
        for (int rep = 0; rep < (dsa ? REP3D : REP3S); ++rep) if (IN(pb + 3)) { SITE();
#ifndef NO_DSA
            if (dsa) dsa_attn_phase(lds, Qb, (const unsigned char*)KVA, IDXb, AOb, args.in[9], bxs, Gs, tids, waves, lanes);
#endif
#ifndef NO_SWA
            if (!dsa) swa_attn_phase(lds, Qb, KVB, AOb, args.in[9], args.in[6] + (size_t)Lb * NHEAD, bxs, Gs, tids, waves, lanes);
#endif
            GRID_BAR();
        }
        for (int rep = 0; rep < REP4; ++rep) if (IN(pb + 4) && !NOS4) { SITE();
            const bf16* Bt = dsa ? (const bf16*)(wsp + WS_WOA) + (size_t)L * DM * DM : (const bf16*)(wsp + WS_WOB) + (size_t)Lb * DM * DM;
            pg8::Gemm g{AOb, Bt, M, DM, DM}; pg8::StaticOrder S; S.init(M, DM, Gs, bxs);
            pg8::EpiResid E{XNB2, rep ? Qb : XN, rep ? (float*)(wsp + WS_QI) : SSQ(3 * L)};
            pg8::gemm_phase<pg8::EpiResid, pg8::StaticOrder, true, true>(lds, g, S, E);
            GRID_BAR();
        }
        for (int rep = 0; rep < REP6; ++rep) if (IN(pb + 6) && !NOS6) { SITE();
            pg8::Gemm g{XN, (const bf16*)(wsp + WS_W13) + (size_t)L * 2 * DFF * DM, M, 2 * DFF, DM, 1}; pg8::StaticOrder S; S.init(M, 2 * DFF, Gs, bxs);
            pg8::rs_finalize(RTAB, S, SSQ(3 * L), tids);
            pg8::EpiSwiglu E{Ub, RTAB};
            pg8::gemm_phase<pg8::EpiSwiglu, pg8::StaticOrder, true, true>(lds, g, S, E);
            GRID_BAR();
        }
        for (int rep = 0; rep < REP7; ++rep) if (IN(pb + 7) && !NOS7) { SITE();
            { pg8::Gemm g{Ub, (const bf16*)(wsp + WS_W2) + (size_t)L * DM * DFF, M, DM, DFF, 1}; pg8::StaticOrder S; S.init(M, DM, Gs, bxs);
              pg8::EpiResid E{XN, rep ? XNB2 : XN, rep ? SSQ(3 * L + 2) : SSQ(3 * L + 1)};
              pg8::gemm_phase<pg8::EpiResid, pg8::StaticOrder, true, true>(lds, g, S, E); }
            { pg8::Gemm g{PB + (size_t)L * M * PLE, (const bf16*)(wsp + WS_WPE) + (size_t)L * DM * PLE, M, DM, PLE}; pg8::StaticOrder S; S.init(M, DM, Gs, bxs);
              pg8::EpiBf16Map E{3, PEb, DM, nullptr, nullptr, nullptr, nullptr, nullptr};
              pg8::gemm_phase<pg8::EpiBf16Map, pg8::StaticOrder, true, true>(lds, g, S, E); }
            GRID_BAR();
        }
        for (int rep = 0; rep < REP9; ++rep) if (IN(pb + 9) && !NOS9) { SITE();
            pg8::Gemm g{XN, (const bf16*)(wsp + WS_WPG) + (size_t)L * DM * DM, M, DM, DM, 1}; pg8::StaticOrder S; S.init(M, DM, Gs, bxs);
            pg8::rs_finalize(RTAB, S, SSQ(3 * L + 1), tids);
            pg8::EpiGate E{XN, PEb, RTAB, rep ? Qb : XNB2, rep ? (float*)(wsp + WS_QI) : SSQ(3 * L + 2)};
            pg8::gemm_phase<pg8::EpiGate, pg8::StaticOrder, true, true>(lds, g, S, E);
            GRID_BAR();
        }
        if (L == N_A - 1) {
            for (int rep = 0; rep < REP11; ++rep) if (IN(pb + 11) && !NOS11) { SITE();
                pg8::Gemm g{XNB2, (const bf16*)(wsp + WS_WKV), M, 1024, DM, 1}; pg8::StaticOrder S; S.init(M, 1024, Gs, bxs);
                pg8::rs_finalize(RTAB, S, SSQ(3 * L + 2), tids);
                pg8::EpiBf16Map E{2, nullptr, 0, KVB, nullptr, nullptr, RTAB, nullptr};
                pg8::gemm_phase<pg8::EpiBf16Map, pg8::StaticOrder, true, true>(lds, g, S, E);
                GRID_BAR();
            }
        }
        }
    { constexpr int L = 3;
        const int pb = 1 + 12 * L; const bool dsa = L < N_A; const int Lb = L - N_A;
        for (int rep = 0; rep < REP1; ++rep) if (IN(pb + 1) && !NOS1) { SITE();
            const bf16* Bt = dsa ? (const bf16*)(wsp + WS_WIN) + (size_t)L * A_INP * DM : (const bf16*)(wsp + WS_WQB) + (size_t)Lb * DM * DM; const int N = dsa ? A_INP : DM;
            const bool part = DEFER_CONV && dsa && Gs == 256; const int Gg = part ? CONV_GG : Gs;
            pg8::Gemm g{XNB2, Bt, M, N, DM, 1}; pg8::StaticOrder S; S.init(M, N, Gg, bxs); if (part && bxs >= Gg) S.nwg = 0;
            pg8::rs_finalize(RTAB, S, SSQ(L == 0 ? 12 : 3 * (L - 1) + 2), tids);
            pg8::EpiBf16Map E{dsa ? 1 : 0, Qb, DM, KVA, QIb, KIWb, RTAB, KITb};
            pg8::gemm_phase<pg8::EpiBf16Map, pg8::StaticOrder, true, true>(lds, g, S, E);
            if (part && rep == 0 && bxs >= Gg) {
                __syncthreads();
                LAS float* scr = (LAS float*)(lds + waves * 16640); int rot = 0; const int gw2 = (bxs - Gg) * NWAVES + waves, NGW2 = (Gs - Gg) * NWAVES; const int Ld = L + 1;
                conv_matrix(args.in[12] + (size_t)Ld * DM * DFF, args.in[11] + (size_t)Ld * DM, DM, DFF, (bf16*)(wsp + WS_W13) + (size_t)Ld * 2 * DFF * DM, 3, scr, gw2, NGW2, lanes, rot);
                conv_matrix(args.in[13] + (size_t)Ld * DM * DFF, args.in[11] + (size_t)Ld * DM, DM, DFF, (bf16*)(wsp + WS_W13) + (size_t)Ld * 2 * DFF * DM, 4, scr, gw2, NGW2, lanes, rot);
                if (L == 0) { conv_matrix(args.in[17] + (size_t)1 * DM * DM, args.in[15] + (size_t)1 * DM, DM, DM, (bf16*)(wsp + WS_WPG) + (size_t)1 * DM * DM, 0, scr, gw2, NGW2, lanes, rot);
                              conv_matrix(args.in[3] + (size_t)1 * DM * DM, nullptr, DM, DM, (bf16*)(wsp + WS_WOA) + (size_t)1 * DM * DM, 0, scr, gw2, NGW2, lanes, rot); }
                else conv_matrix(args.in[14] + (size_t)2 * DFF * DM, nullptr, DFF, DM, (bf16*)(wsp + WS_W2) + (size_t)2 * DM * DFF, 0, scr, gw2, NGW2, lanes, rot);
            }
            GRID_BAR();
        }
#ifndef NO_IDX
        for (int rep = 0; rep < REP2; ++rep) if (dsa && IN(pb + 2)) { SITE(); indexer_phase(lds, QIb, KIWb, KITb, IDXb, bxs, Gs, tids, waves, lanes); GRID_BAR(); }
#endif
        for (int rep = 0; rep < (dsa ? REP3D : REP3S); ++rep) if (IN(pb + 3)) { SITE();
#ifndef NO_DSA
            if (dsa) dsa_attn_phase(lds, Qb, (const unsigned char*)KVA, IDXb, AOb, args.in[9], bxs, Gs, tids, waves, lanes);
#endif
#ifndef NO_SWA
            if (!dsa) swa_attn_phase(lds, Qb, KVB, AOb, args.in[9], args.in[6] + (size_t)Lb * NHEAD, bxs, Gs, tids, waves, lanes);
#endif
            GRID_BAR();
        }
        for (int rep = 0; rep < REP4; ++rep) if (IN(pb + 4) && !NOS4) { SITE();
            const bf16* Bt = dsa ? (const bf16*)(wsp + WS_WOA) + (size_t)L * DM * DM : (const bf16*)(wsp + WS_WOB) + (size_t)Lb * DM * DM;
            pg8::Gemm g{AOb, Bt, M, DM, DM}; pg8::StaticOrder S; S.init(M, DM, Gs, bxs);
            pg8::EpiResid E{XNB2, rep ? Qb : XN, rep ? (float*)(wsp + WS_QI) : SSQ(3 * L)};
            pg8::gemm_phase<pg8::EpiResid, pg8::StaticOrder, true, true>(lds, g, S, E);
            GRID_BAR();
        }
        for (int rep = 0; rep < REP6; ++rep) if (IN(pb + 6) && !NOS6) { SITE();
            pg8::Gemm g{XN, (const bf16*)(wsp + WS_W13) + (size_t)L * 2 * DFF * DM, M, 2 * DFF, DM, 1}; pg8::StaticOrder S; S.init(M, 2 * DFF, Gs, bxs);
            pg8::rs_finalize(RTAB, S, SSQ(3 * L), tids);
            pg8::EpiSwiglu E{Ub, RTAB};
            pg8::gemm_phase<pg8::EpiSwiglu, pg8::StaticOrder, true, true>(lds, g, S, E);
            GRID_BAR();
        }
        for (int rep = 0; rep < REP7; ++rep) if (IN(pb + 7) && !NOS7) { SITE();
            { pg8::Gemm g{Ub, (const bf16*)(wsp + WS_W2) + (size_t)L * DM * DFF, M, DM, DFF, 1}; pg8::StaticOrder S; S.init(M, DM, Gs, bxs);
              pg8::EpiResid E{XN, rep ? XNB2 : XN, rep ? SSQ(3 * L + 2) : SSQ(3 * L + 1)};
              pg8::gemm_phase<pg8::EpiResid, pg8::StaticOrder, true, true>(lds, g, S, E); }
            { pg8::Gemm g{PB + (size_t)L * M * PLE, (const bf16*)(wsp + WS_WPE) + (size_t)L * DM * PLE, M, DM, PLE}; pg8::StaticOrder S; S.init(M, DM, Gs, bxs);
              pg8::EpiBf16Map E{3, PEb, DM, nullptr, nullptr, nullptr, nullptr, nullptr};
              pg8::gemm_phase<pg8::EpiBf16Map, pg8::StaticOrder, true, true>(lds, g, S, E); }
            GRID_BAR();
        }
        for (int rep = 0; rep < REP9; ++rep) if (IN(pb + 9) && !NOS9) { SITE();
            pg8::Gemm g{XN, (const bf16*)(wsp + WS_WPG) + (size_t)L * DM * DM, M, DM, DM, 1}; pg8::StaticOrder S; S.init(M, DM, Gs, bxs);
            pg8::rs_finalize(RTAB, S, SSQ(3 * L + 1), tids);
            pg8::EpiGate E{XN, PEb, RTAB, rep ? Qb : XNB2, rep ? (float*)(wsp + WS_QI) : SSQ(3 * L + 2)};
            pg8::gemm_phase<pg8::EpiGate, pg8::StaticOrder, true, true>(lds, g, S, E);
            GRID_BAR();
        }
        if (L == N_A - 1) {
            for (int rep = 0; rep < REP11; ++rep) if (IN(pb + 11) && !NOS11) { SITE();
                pg8::Gemm g{XNB2, (const bf16*)(wsp + WS_WKV), M, 1024, DM, 1}; pg8::StaticOrder S; S.init(M, 1024, Gs, bxs);
                pg8::rs_finalize(RTAB, S, SSQ(3 * L + 2), tids);
                pg8::EpiBf16Map E{2, nullptr, 0, KVB, nullptr, nullptr, RTAB, nullptr};
                pg8::gemm_phase<pg8::EpiBf16Map, pg8::StaticOrder, true, true>(lds, g, S, E);
                GRID_BAR();
            }
        }
        }

    if (IN(PH_FINAL)) { SITE(); final_norm_phase(XNB2, args.in[18], X, gws, NGWs, lanes); }
#undef IN
#undef SITE
#undef GRID_BAR
#undef x_in
#undef X
#undef XN
#undef Qb
#undef AOb
#undef QIb
#undef KIWb
#undef IDXb
#undef KITb
#undef KVA
#undef KVB
#undef Ub
#undef PEb
#undef PB
#undef XNB2
#undef SSQ
#undef RTAB
}

static bool phase_exists(int p) {
    if (p == 0 || p == PH_FINAL) return true;
    if (p < 0 || p > PH_FINAL) return false;
    const int L = (p - 1) / 12, s = (p - 1) % 12;
    if (s == 0 || s == 5 || s == 8 || s == 10) return false;
    if (s == 2) return L < N_A;
    if (s == 11) return L == N_A - 1;
    return true;
}
extern "C" void kernel_launch(void* const* d_in, const int* in_sizes, int n_in, void* d_out, int out_size, void* d_ws, size_t ws_size, hipStream_t stream) {
    static int grid = 0;
    if (grid == 0) {
        if (n_in != 19 || in_sizes[0] != M * DM || out_size != M * DM || ws_size < WS_END) { fprintf(stderr, "kernel_launch: shape/workspace mismatch (n_in %d, in0 %d, out %d, ws %zu, need %zu); nothing launched\n", n_in, n_in > 0 ? in_sizes[0] : -1, out_size, ws_size, (size_t)WS_END); grid = -1; return; }
        int dev = 0, cus = 0, per_cu = 0;
        if (hipGetDevice(&dev) != hipSuccess || hipDeviceGetAttribute(&cus, hipDeviceAttributeMultiprocessorCount, dev) != hipSuccess) { fprintf(stderr, "kernel_launch: device query failed\n"); grid = -1; return; }
        if (hipFuncSetAttribute((const void*)yoco_fwd, hipFuncAttributeMaxDynamicSharedMemorySize, LDS_BYTES) != hipSuccess) { fprintf(stderr, "kernel_launch: hipFuncSetAttribute failed\n"); grid = -1; return; }
        if (hipOccupancyMaxActiveBlocksPerMultiprocessor(&per_cu, (const void*)yoco_fwd, NWAVES * 64, LDS_BYTES) != hipSuccess || per_cu < 1) fprintf(stderr, "kernel_launch: note: occupancy query reports %d workgroups per CU\n", per_cu);
        (void)hipGetLastError();
        grid = cus;
    }
    if (grid < 0) return;
    if (hipMemsetAsync((char*)d_ws + WS_CTL, 0, CTL_ZERO_BYTES, stream) != hipSuccess) { fprintf(stderr, "kernel_launch: memset failed\n"); return; }
    Args a{};
    for (int i = 0; i < 19; ++i) a.in[i] = (const float*)d_in[i];
    a.out = (float*)d_out; a.ws = (unsigned char*)d_ws;
#if MK_PER_PHASE
    for (int p = 0; p < PH_END; ++p) { if (!phase_exists(p)) continue; a.ph_lo = p; a.ph_hi = p + 1;
        hipLaunchKernelGGL(yoco_fwd, dim3(grid), dim3(NWAVES * 64), LDS_BYTES, stream, a); }
#else
    a.ph_lo = 0; a.ph_hi = PH_END;
    hipLaunchKernelGGL(yoco_fwd, dim3(grid), dim3(NWAVES * 64), LDS_BYTES, stream, a);
#endif
    const hipError_t le = hipPeekAtLastError();
    if (le != hipSuccess) fprintf(stderr, "kernel_launch: launch failed: %s\n", hipGetErrorName(le));
}
```

```cpp
#include <hip/hip_runtime.h>
#include <cstdio>
#include <cstdint>
#ifndef MK_PER_PHASE
#define MK_PER_PHASE 0
#endif
namespace pg8 {
#define PG8_LAS __attribute__((address_space(3)))
typedef unsigned short bf16_t;
typedef short bf16x8 __attribute__((ext_vector_type(8)));
typedef float f32x4 __attribute__((ext_vector_type(4)));
typedef unsigned u32x4 __attribute__((ext_vector_type(4)));
constexpr int BM = 256, BK = 64, HALF = 128, HTB = HALF * BK * 2  , STAGE_BYTES = 8 * HTB, NXCD = 8, WGM = 8;

__host__ __device__ __forceinline__ int lds_byte(int r, int c) { const int st = (r >> 4) * 2 + (c >> 5), rr = r & 15, cc = c & 31, ob = rr * 64 + cc * 2; return st * 1024 + (ob ^ (((ob >> 9) & 1) << 5)); }
__host__ __device__ __forceinline__ void stage_rc(int b, int& R, int& C) { const int st = b / 1024, sb = b % 1024, swz = sb ^ (((sb >> 9) & 1) << 5); R = (st >> 1) * 16 + swz / 64; C = (st & 1) * 32 + (swz % 64) / 2; }
__host__ __device__ __forceinline__ int perm32(int rho) { const int n = rho >> 4, i = rho & 15; return 8 * (i >> 2) + 4 * n + (i & 3); }

struct Unit { int pm, pn, ord; };
struct Gemm { const bf16_t* A; const bf16_t* Bt; int M, N, K; int tiledA; };

struct StaticOrder {
    int nM, nN, nwg, G, c;
    __host__ __device__ void init(int M, int N, int G_, int c_) { nM = M / BM; nN = N / BM; nwg = nM * nN; G = G_; c = c_; }
    __host__ __device__ bool next(int i, Unit& u) const {
        const long L = (long)i * G + c; if (L >= nwg) return false;
        int wgid = (int)L; { const int q = nwg / NXCD, r = nwg % NXCD, xcd = wgid % NXCD, off = wgid / NXCD; wgid = (xcd < r ? xcd * (q + 1) : r * (q + 1) + (xcd - r) * q) + off; }
        const int nig = WGM * nN, gid = wgid / nig, fm = gid * WGM, gsz = (nM - fm) < WGM ? (nM - fm) : WGM;
        u.pm = fm + ((wgid % nig) % gsz); u.pn = (wgid % nig) / gsz; u.ord = i; return true;
    }
    __device__ __forceinline__ void a_ready(const Unit&) const {}
    __device__ __forceinline__ void done(const Unit&) const {}
};

__device__ __forceinline__ unsigned cvt_pk_bf16(float lo, float hi) { unsigned r; asm volatile("v_cvt_pk_bf16_f32 %0, %1, %2" : "=v"(r) : "v"(lo), "v"(hi)); return r; }
#define PG8_GAS __attribute__((address_space(1)))

__device__ __forceinline__ float fast_sigmoid(float a) { return __builtin_amdgcn_rcpf(1.0f + __builtin_amdgcn_exp2f(-1.4426950408889634f * a)); }

__device__ __forceinline__ void row_scales(const PG8_LAS float* rtab, const Unit& u, int wr, int fr, float (&r)[2][4]) {
#pragma unroll
    for (int ai = 0; ai < 2; ++ai)
#pragma unroll
        for (int m = 0; m < 4; ++m) r[ai][m] = rtab ? rtab[u.ord * BM + ai * HALF + wr * 64 + m * 16 + fr] : 1.0f;
}
template <class Sched> __device__ __forceinline__ void rs_finalize(PG8_LAS float* rtab, const Sched& S, const float* ssp, int tid) {
    const int row = tid >> 1, h = tid & 1;
    for (int i0 = 0; ; i0 += 4) {
        Unit u[4]; bool ok[4]; f32x4 v[4][4];
#pragma unroll
        for (int j = 0; j < 4; ++j) { ok[j] = S.next(i0 + j, u[j]); if (!ok[j]) u[j].pm = 0; }
        if (!ok[0]) break;
#pragma unroll
        for (int j = 0; j < 4; ++j) { const PG8_GAS f32x4* p = (const PG8_GAS f32x4*)(ssp + ((size_t)(u[j].pm * BM + row)) * 32 + h * 16);
#pragma unroll
            for (int e = 0; e < 4; ++e) v[j][e] = p[e]; }
#pragma unroll
        for (int j = 0; j < 4; ++j) { const f32x4 a = v[j][0], b = v[j][1], c = v[j][2], d = v[j][3];
            const float s = (((a[0] + a[1]) + (a[2] + a[3])) + ((b[0] + b[1]) + (b[2] + b[3]))) + (((c[0] + c[1]) + (c[2] + c[3])) + ((d[0] + d[1]) + (d[2] + d[3])));
            const float o = __shfl_xor(s, 1); const float tot = h ? (o + s) : (s + o);
            if (h == 0 && ok[j]) rtab[(i0 + j) * BM + row] = __builtin_amdgcn_rsqf(tot * (1.0f / 2048.0f) + 1e-6f); }
    }
    __syncthreads();
}
struct EpiBf16Map {
    static constexpr bool PERM = true, AFTER_DRAIN = false;
    int kind; bf16_t* O; int ldc; bf16_t* KV; bf16_t* QI; bf16_t* KIW; const PG8_LAS float* rtab; bf16_t* KIT;
    __device__ __forceinline__ void operator()(const f32x4 (&acc)[2][2][4][2], const Unit& u, int wr, int wc, int fr, int fq) const {
        const int row0 = u.pm * BM + wr * 64 + fr; bf16_t* base; int ld;
        if (kind == 0) { base = O + u.pn * BM; ld = ldc; }
        else if (kind == 3) { base = O + ((size_t)(u.pm * 8 + u.pn) << 16) - (size_t)u.pm * BM * 256; ld = 256; }
        else if (kind == 1) {
            if (u.pn < 8) { base = O + u.pn * BM; ld = 2048; }
            else if (u.pn < 12) { const int b = u.pm >> 5, g = u.pn - 8; base = KV + ((size_t)(b * 4 + g) * 8192 - (size_t)b * 8192) * 256; ld = 256; }
            else if (u.pn < 16) { base = QI + (u.pn - 12) * BM; ld = 1024; }
            else { base = KIW; ld = 256; }
        } else { const int b = u.pm >> 5, g = u.pn; base = KV + ((size_t)(b * 4 + g) * 8192 - (size_t)b * 8192) * 256; ld = 256; }
        const int col0 = wc * 32 + 8 * fq; float rs[2][4]; row_scales(rtab, u, wr, fr, rs);
        if (kind == 1 && u.pn == 16) {
            if (wc < 2) {
#pragma unroll
                for (int ai = 0; ai < 2; ++ai)
#pragma unroll
                    for (int m = 0; m < 4; ++m) { const int row = row0 + ai * HALF + m * 16, d0 = wc * 32 + 8 * fq;
                        bf16_t* dst = QI  ; dst = KIT + ((size_t)((row >> 5) * 4 + (d0 >> 4)) * 64 + ((d0 >> 3) & 1) * 32 + (row & 31)) * 8;
                        const f32x4 v0 = acc[ai][0][m][0] * rs[ai][m], v1 = acc[ai][0][m][1] * rs[ai][m];
                        u32x4 w; w.x = cvt_pk_bf16(v0[0], v0[1]); w.y = cvt_pk_bf16(v0[2], v0[3]); w.z = cvt_pk_bf16(v1[0], v1[1]); w.w = cvt_pk_bf16(v1[2], v1[3]);
                        *(PG8_GAS u32x4*)dst = w; }
            } else if (wc == 2 && fq < 2) {
#pragma unroll
                for (int ai = 0; ai < 2; ++ai)
#pragma unroll
                    for (int m = 0; m < 4; ++m) { bf16_t* rowp = KIW + (size_t)(row0 + ai * HALF + m * 16) * 256 + col0;
                        const f32x4 v0 = acc[ai][0][m][0] * rs[ai][m], v1 = acc[ai][0][m][1] * rs[ai][m];
                        u32x4 w; w.x = cvt_pk_bf16(v0[0], v0[1]); w.y = cvt_pk_bf16(v0[2], v0[3]); w.z = cvt_pk_bf16(v1[0], v1[1]); w.w = cvt_pk_bf16(v1[2], v1[3]);
                        *(PG8_GAS u32x4*)rowp = w; }
            }
            return;
        }
        if (kind == 1 && u.pn >= 8 && u.pn < 12) {
            unsigned char* b8 = (unsigned char*)KV + ((size_t)((u.pm >> 5) * 4 + (u.pn - 8)) * 8192 - (size_t)(u.pm >> 5) * 8192) * 256 + col0;
#pragma unroll
            for (int ai = 0; ai < 2; ++ai)
#pragma unroll
                for (int m = 0; m < 4; ++m) { unsigned char* rowp = b8 + (size_t)(row0 + ai * HALF + m * 16) * 256; const float sc = rs[ai][m] * 16.0f;
#pragma unroll
                    for (int bj = 0; bj < 2; ++bj) { const f32x4 v0 = acc[ai][bj][m][0] * sc, v1 = acc[ai][bj][m][1] * sc; typedef unsigned u32x2 __attribute__((ext_vector_type(2)));
                        int w0 = __builtin_amdgcn_cvt_pk_fp8_f32(v0[0], v0[1], 0, false); w0 = __builtin_amdgcn_cvt_pk_fp8_f32(v0[2], v0[3], w0, true);
                        int w1 = __builtin_amdgcn_cvt_pk_fp8_f32(v1[0], v1[1], 0, false); w1 = __builtin_amdgcn_cvt_pk_fp8_f32(v1[2], v1[3], w1, true);
                        u32x2 w; w.x = (unsigned)w0; w.y = (unsigned)w1; *(PG8_GAS u32x2*)(rowp + bj * HALF) = w; } }
            return;
        }
#pragma unroll
        for (int ai = 0; ai < 2; ++ai)
#pragma unroll
            for (int m = 0; m < 4; ++m) { bf16_t* rowp = base + (size_t)(row0 + ai * HALF + m * 16) * ld + col0;
#pragma unroll
                for (int bj = 0; bj < 2; ++bj) { const f32x4 v0 = acc[ai][bj][m][0] * rs[ai][m], v1 = acc[ai][bj][m][1] * rs[ai][m];
                    u32x4 w; w.x = cvt_pk_bf16(v0[0], v0[1]); w.y = cvt_pk_bf16(v0[2], v0[3]); w.z = cvt_pk_bf16(v1[0], v1[1]); w.w = cvt_pk_bf16(v1[2], v1[3]);
                    *(PG8_GAS u32x4*)(rowp + bj * HALF) = w; } }
    }
};
__device__ __forceinline__ float bflo(unsigned w) { return __uint_as_float(w << 16); }
__device__ __forceinline__ float bfhi(unsigned w) { return __uint_as_float(w & 0xffff0000u); }
typedef float f32x2 __attribute__((ext_vector_type(2)));
__device__ __forceinline__ f32x2 bf2(unsigned w) { f32x2 r; r.x = bflo(w); r.y = bfhi(w); return r; }
#define PG8_LO2(v) __builtin_shufflevector(v, v, 0, 1)
#define PG8_HI2(v) __builtin_shufflevector(v, v, 2, 3)
__device__ __forceinline__ void sig8(f32x4& s0, f32x4& s1, const f32x4 a0, const f32x4 a1, float nrs) {
    f32x4 t0 = a0 * nrs, t1 = a1 * nrs;
    __builtin_amdgcn_sched_barrier(0);
#pragma unroll
    for (int e = 0; e < 4; ++e) { t0[e] = __builtin_amdgcn_exp2f(t0[e]); t1[e] = __builtin_amdgcn_exp2f(t1[e]); }
    __builtin_amdgcn_sched_barrier(0);
    t0 = t0 + 1.0f; t1 = t1 + 1.0f;
    __builtin_amdgcn_sched_barrier(0);
#pragma unroll
    for (int e = 0; e < 4; ++e) { t0[e] = __builtin_amdgcn_rcpf(t0[e]); t1[e] = __builtin_amdgcn_rcpf(t1[e]); }
    __builtin_amdgcn_sched_barrier(0);
    s0 = t0; s1 = t1;
}
struct EpiResid {
    static constexpr bool PERM = true, AFTER_DRAIN = false;
    const bf16_t* Xin; bf16_t* Xout; float* ssp;
    __device__ __forceinline__ void operator()(const f32x4 (&acc)[2][2][4][2], const Unit& u, int wr, int wc, int fr, int fq) const {
        const int row0 = u.pm * BM + wr * 64 + fr, rl0 = wr * 64 + fr, cl0 = wc * 32 + 8 * fq; const size_t tb = (size_t)(u.pm * 8 + u.pn) << 16;
        u32x4 xv[2][4][2];
#pragma unroll
        for (int ai = 0; ai < 2; ++ai)
#pragma unroll
            for (int m = 0; m < 4; ++m)
#pragma unroll
                for (int bj = 0; bj < 2; ++bj) xv[ai][m][bj] = *(const PG8_GAS u32x4*)(Xin + tb + (size_t)(rl0 + ai * HALF + m * 16) * 256 + cl0 + bj * HALF);
#pragma unroll
        for (int ai = 0; ai < 2; ++ai)
#pragma unroll
            for (int m = 0; m < 4; ++m) { float q; f32x2 qq = (f32x2){0.f, 0.f};
#pragma unroll
                for (int bj = 0; bj < 2; ++bj) { const u32x4 x = xv[ai][m][bj]; const f32x4 a0 = acc[ai][bj][m][0], a1 = acc[ai][bj][m][1];
                    const f32x2 o0 = bf2(x.x) + PG8_LO2(a0), o1 = bf2(x.y) + PG8_HI2(a0), o2 = bf2(x.z) + PG8_LO2(a1), o3 = bf2(x.w) + PG8_HI2(a1);
                    u32x4 w; w.x = cvt_pk_bf16(o0.x, o0.y); w.y = cvt_pk_bf16(o1.x, o1.y); w.z = cvt_pk_bf16(o2.x, o2.y); w.w = cvt_pk_bf16(o3.x, o3.y);
                    *(PG8_GAS u32x4*)(Xout + tb + (size_t)(rl0 + ai * HALF + m * 16) * 256 + cl0 + bj * HALF) = w;
                    const f32x2 w0 = bf2(w.x), w1 = bf2(w.y), w2 = bf2(w.z), w3 = bf2(w.w); qq = qq + w0 * w0; qq = qq + w1 * w1; qq = qq + w2 * w2; qq = qq + w3 * w3; }
                q = qq.x + qq.y;
                { auto r16_ = __builtin_amdgcn_permlane16_swap(__float_as_uint(q), __float_as_uint(q), false, false); q = __uint_as_float(r16_[0]) + __uint_as_float(r16_[1]); auto r32_ = __builtin_amdgcn_permlane32_swap(__float_as_uint(q), __float_as_uint(q), false, false); q = __uint_as_float(r32_[0]) + __uint_as_float(r32_[1]); }
                if (fq == 0) ((PG8_GAS float*)ssp)[(size_t)(row0 + ai * HALF + m * 16) * 32 + u.pn * 4 + wc] = q; }
    }
};
struct EpiSwiglu {
    static constexpr bool PERM = true, AFTER_DRAIN = false;
    bf16_t* U; const PG8_LAS float* rtab;
    __device__ __forceinline__ void operator()(const f32x4 (&acc)[2][2][4][2], const Unit& u, int wr, int wc, int fr, int fq) const {
        const int row0 = wr * 64 + fr; float rs[2][4]; row_scales(rtab, u, wr, fr, rs);
        bf16_t* const ub = U + ((size_t)(u.pm * 22 + (u.pn >> 1)) << 16) + (u.pn & 1) * HALF + wc * 32 + 8 * fq;
#ifndef EPI_SWIGLU_REP
#define EPI_SWIGLU_REP 1
#endif
        for (int er_ = 0; er_ < EPI_SWIGLU_REP; ++er_) { asm volatile("" ::: "memory");
#pragma unroll
        for (int ai = 0; ai < 2; ++ai)
#pragma unroll
            for (int m = 0; m < 4; ++m) { bf16_t* rowp = ub + (size_t)(row0 + ai * HALF + m * 16) * 256;
                f32x4 o[2]; const float rsv = rs[ai][m], rr = rsv * rsv;
                { f32x4 s0, s1; sig8(s0, s1, acc[ai][0][m][0], acc[ai][0][m][1], rsv * -1.4426950408889634f);
                  o[0] = (acc[ai][0][m][0] * acc[ai][1][m][0]) * (s0 * rr); o[1] = (acc[ai][0][m][1] * acc[ai][1][m][1]) * (s1 * rr); }
                u32x4 w; w.x = cvt_pk_bf16(o[0][0], o[0][1]); w.y = cvt_pk_bf16(o[0][2], o[0][3]); w.z = cvt_pk_bf16(o[1][0], o[1][1]); w.w = cvt_pk_bf16(o[1][2], o[1][3]);
                *(PG8_GAS u32x4*)rowp = w; }
        }
    }
};
struct EpiGate {
    static constexpr bool PERM = true, AFTER_DRAIN = false;
    const bf16_t* Xin; const bf16_t* PE; const PG8_LAS float* rtab; bf16_t* Xout; float* ssp;
    __device__ __forceinline__ void operator()(const f32x4 (&acc)[2][2][4][2], const Unit& u, int wr, int wc, int fr, int fq) const {
        const int row0 = u.pm * BM + wr * 64 + fr, rl0 = wr * 64 + fr, cl0 = wc * 32 + 8 * fq; const size_t tb = (size_t)(u.pm * 8 + u.pn) << 16;
#pragma unroll
        for (int ai = 0; ai < 2; ++ai) {
            u32x4 xv[4][2], pv[4][2];
#pragma unroll
            for (int m = 0; m < 4; ++m)
#pragma unroll
                for (int bj = 0; bj < 2; ++bj) { const size_t off = tb + (size_t)(rl0 + ai * HALF + m * 16) * 256 + cl0 + bj * HALF; xv[m][bj] = *(const PG8_GAS u32x4*)(Xin + off); pv[m][bj] = *(const PG8_GAS u32x4*)(PE + off); }
#pragma unroll
            for (int m = 0; m < 4; ++m) { float q; f32x2 qq = (f32x2){0.f, 0.f}; const float nr = rtab[u.ord * BM + ai * HALF + wr * 64 + m * 16 + fr] * -1.4426950408889634f;
#pragma unroll
                for (int bj = 0; bj < 2; ++bj) { const u32x4 x = xv[m][bj], p = pv[m][bj]; f32x4 s0, s1; sig8(s0, s1, acc[ai][bj][m][0], acc[ai][bj][m][1], nr);
                    const f32x2 o0 = bf2(x.x) + bf2(p.x) * PG8_LO2(s0), o1 = bf2(x.y) + bf2(p.y) * PG8_HI2(s0), o2 = bf2(x.z) + bf2(p.z) * PG8_LO2(s1), o3 = bf2(x.w) + bf2(p.w) * PG8_HI2(s1);
                    u32x4 w; w.x = cvt_pk_bf16(o0.x, o0.y); w.y = cvt_pk_bf16(o1.x, o1.y); w.z = cvt_pk_bf16(o2.x, o2.y); w.w = cvt_pk_bf16(o3.x, o3.y);
                    *(PG8_GAS u32x4*)(Xout + tb + (size_t)(rl0 + ai * HALF + m * 16) * 256 + cl0 + bj * HALF) = w;
                    const f32x2 w0 = bf2(w.x), w1 = bf2(w.y), w2 = bf2(w.z), w3 = bf2(w.w); qq = qq + w0 * w0; qq = qq + w1 * w1; qq = qq + w2 * w2; qq = qq + w3 * w3; }
                q = qq.x + qq.y;
                { auto r16_ = __builtin_amdgcn_permlane16_swap(__float_as_uint(q), __float_as_uint(q), false, false); q = __uint_as_float(r16_[0]) + __uint_as_float(r16_[1]); auto r32_ = __builtin_amdgcn_permlane32_swap(__float_as_uint(q), __float_as_uint(q), false, false); q = __uint_as_float(r32_[0]) + __uint_as_float(r32_[1]); }
                if (fq == 0) ((PG8_GAS float*)ssp)[(size_t)(row0 + ai * HALF + m * 16) * 32 + u.pn * 4 + wc] = q; }
            asm volatile("" ::: "memory"); }
    }
};
template <class Epi, class Sched, bool ALIGN_EPI = false, bool SP2 = false>
__device__ __forceinline__ void gemm_phase(PG8_LAS unsigned char* lds, const Gemm g, const Sched& S, const Epi& E) {
    int tid_l = threadIdx.x; asm volatile("" : "+v"(tid_l));
    const int tid = tid_l, wid = __builtin_amdgcn_readfirstlane(tid >> 6), lane = tid & 63, wr = wid >> 2, wc = wid & 3, fr = lane & 15, fq = lane >> 4;
    const int K = g.K, nt = K / BK;
    unsigned voffA[2], voffB[2];
#pragma unroll
    for (int i = 0; i < 2; ++i) { int R, C; stage_rc(tid * 16 + i * 8192, R, C); const int Rb = Epi::PERM ? ((R & ~31) + perm32(R & 31)) : R;
        voffA[i] = (unsigned)(R * (g.tiledA ? 256 : K) + C) * 2u; voffB[i] = (unsigned)(Rb * K + C) * 2u; }
    const unsigned kstep = (unsigned)(BK * 2);
    const unsigned hstep = (unsigned)HALF * K * 2;
    const unsigned tstep = 2 * hstep;
    const unsigned hstepA = g.tiledA ? 65536u : hstep;
#define PG8_KA(t_) (g.tiledA ? ((((unsigned)(t_)) >> 2) << 17) + ((((unsigned)(t_)) & 3u) << 7) : (unsigned)(t_) * kstep)
    const unsigned ldsw = (unsigned)wid * 1024u;
    const int aoff = lds_byte(wr * 64 + fr, fq * 8), boff = lds_byte(wc * 32 + fr, fq * 8);
#define PG8_SA(b, h) (((b) * 2 + (h)) * HTB)
#define PG8_SB(b, h) ((4 + (b) * 2 + (h)) * HTB)
    const unsigned long long pA_ = (unsigned long long)g.A, pB_ = (unsigned long long)g.Bt;
    void* const uA_ = (void*)(((unsigned long long)(unsigned)__builtin_amdgcn_readfirstlane((int)(unsigned)(pA_ >> 32)) << 32) | (unsigned)__builtin_amdgcn_readfirstlane((int)(unsigned)pA_));
    void* const uB_ = (void*)(((unsigned long long)(unsigned)__builtin_amdgcn_readfirstlane((int)(unsigned)(pB_ >> 32)) << 32) | (unsigned)__builtin_amdgcn_readfirstlane((int)(unsigned)pB_));
    const __amdgpu_buffer_rsrc_t rs_voffA = __builtin_amdgcn_make_buffer_rsrc(uA_, (short)0, __builtin_amdgcn_readfirstlane((int)((unsigned)g.M * (unsigned)K * 2u)), 0x00020000);
    const __amdgpu_buffer_rsrc_t rs_voffB = __builtin_amdgcn_make_buffer_rsrc(uB_, (short)0, __builtin_amdgcn_readfirstlane((int)((unsigned)g.N * (unsigned)K * 2u)), 0x00020000);
#define PG8_STAGE(bufoff, goff, voff) do { _Pragma("unroll") for (int _i = 0; _i < 2; ++_i) \
        __builtin_amdgcn_raw_ptr_buffer_load_lds(rs_##voff, (PG8_LAS void*)(lds + (bufoff) + ldsw + _i * 8192), 16, (int)(voff)[_i], (int)(goff), 0, 0); } while (0)
#define PG8_LDA(dst, b, h) do { _Pragma("unroll") for (int m = 0; m < 4; ++m) _Pragma("unroll") for (int k = 0; k < 2; ++k) dst[m][k] = *(const PG8_LAS bf16x8*)(lds + PG8_SA(b, h) + aoff + m * 2048 + k * 1024); } while (0)
#define PG8_LDB(dst, b, h) do { _Pragma("unroll") for (int n = 0; n < 2; ++n) _Pragma("unroll") for (int k = 0; k < 2; ++k) dst[n][k] = *(const PG8_LAS bf16x8*)(lds + PG8_SB(b, h) + boff + n * 2048 + k * 1024); } while (0)
#define PG8_MMA(ai, bj, At, Bt) do { __builtin_amdgcn_s_setprio(1); _Pragma("unroll") for (int m = 0; m < 4; ++m) _Pragma("unroll") for (int n = 0; n < 2; ++n) _Pragma("unroll") for (int k = 0; k < 2; ++k) \
        acc[ai][bj][m][n] = __builtin_amdgcn_mfma_f32_16x16x32_bf16(Bt[n][k], At[m][k], acc[ai][bj][m][n], 0, 0, 0); __builtin_amdgcn_s_setprio(0); } while (0)
#define PG8_WAIT_V(n) asm volatile("s_waitcnt vmcnt(" #n ")" ::: "memory")
#define PG8_WAIT_L(n) asm volatile("s_waitcnt lgkmcnt(" #n ")" ::: "memory")
#define PG8_BAR __builtin_amdgcn_s_barrier()
#define PG8_SCHED __builtin_amdgcn_sched_barrier(0)
    Unit cur, nxt; int ui = 0;
    if (!S.next(0, cur)) return;
    f32x4 acc[2][2][4][2];
#pragma unroll
    for (int a = 0; a < 2; ++a)
#pragma unroll
        for (int b = 0; b < 2; ++b)
#pragma unroll
            for (int m = 0; m < 4; ++m)
#pragma unroll
                for (int n = 0; n < 2; ++n) acc[a][b][m][n] = (f32x4){0.f, 0.f, 0.f, 0.f};
    bf16x8 At[4][2], B0[2][2], B1[2][2];
    unsigned cA = (unsigned)cur.pm * tstep, cB = (unsigned)cur.pn * tstep;
    S.a_ready(cur);
    if constexpr (SP2) {
        PG8_STAGE(PG8_SB(0, 0), cB, voffB); PG8_STAGE(PG8_SB(0, 1), cB + hstep, voffB); PG8_STAGE(PG8_SA(0, 0), cA, voffA); PG8_STAGE(PG8_SA(0, 1), cA + hstepA, voffA);
        if (wr == 1) PG8_BAR;
        PG8_WAIT_V(2); PG8_BAR;
        PG8_STAGE(PG8_SB(1, 0), cB + kstep, voffB); PG8_STAGE(PG8_SA(1, 0), cA + kstep, voffA); PG8_STAGE(PG8_SB(1, 1), cB + hstep + kstep, voffB);
        PG8_WAIT_V(6); PG8_BAR;
    } else {
        PG8_STAGE(PG8_SB(0, 0), cB, voffB); PG8_STAGE(PG8_SA(0, 0), cA, voffA); PG8_STAGE(PG8_SB(0, 1), cB + hstep, voffB); PG8_STAGE(PG8_SA(0, 1), cA + hstepA, voffA);
        if (wr == 1) PG8_BAR;
        PG8_WAIT_V(4); PG8_BAR;
        PG8_STAGE(PG8_SB(1, 0), cB + kstep, voffB); PG8_STAGE(PG8_SA(1, 0), cA + kstep, voffA); PG8_STAGE(PG8_SB(1, 1), cB + hstep + kstep, voffB);
        PG8_WAIT_V(6); PG8_BAR;
    }
    for (;;) {
        const bool has_next = S.next(ui + 1, nxt);
        const unsigned nA = has_next ? (unsigned)nxt.pm * tstep : cA, nB = has_next ? (unsigned)nxt.pn * tstep : cB;
        for (int t = 0; t < nt; t += 2) {
            const bool last = (t == nt - 2);
            const unsigned a1 = cA + PG8_KA(t + 1);
            const unsigned a2 = last ? nA : cA + PG8_KA(t + 2), b2 = last ? nB : cB + (unsigned)(t + 2) * kstep;
            const unsigned a3 = a2 + kstep, b3 = b2 + kstep;
            if (last && has_next) S.a_ready(nxt);
            if constexpr (SP2) {
            PG8_LDB(B0, 0, 0); PG8_LDB(B1, 0, 1); PG8_SCHED; PG8_LDA(At, 0, 0); PG8_STAGE(PG8_SA(1, 1), a1 + hstepA, voffA);
            PG8_WAIT_V(8); PG8_WAIT_L(0); PG8_BAR; PG8_MMA(0, 0, At, B0); PG8_MMA(0, 1, At, B1); PG8_BAR; PG8_SCHED;
            PG8_LDA(At, 0, 1); PG8_STAGE(PG8_SB(0, 0), b2, voffB); PG8_STAGE(PG8_SB(0, 1), b2 + hstep, voffB); PG8_STAGE(PG8_SA(0, 0), a2, voffA);
            PG8_WAIT_V(8); PG8_WAIT_L(0); PG8_BAR; PG8_MMA(1, 0, At, B0); PG8_MMA(1, 1, At, B1); PG8_BAR; PG8_SCHED;
            PG8_LDB(B0, 1, 0); PG8_LDB(B1, 1, 1); PG8_SCHED; PG8_LDA(At, 1, 0); PG8_STAGE(PG8_SA(0, 1), a2 + hstepA, voffA);
            PG8_WAIT_V(8); PG8_WAIT_L(0); PG8_BAR; PG8_MMA(0, 0, At, B0); PG8_MMA(0, 1, At, B1); PG8_BAR; PG8_SCHED;
            PG8_LDA(At, 1, 1); PG8_STAGE(PG8_SB(1, 0), b3, voffB); PG8_STAGE(PG8_SB(1, 1), b3 + hstep, voffB); PG8_STAGE(PG8_SA(1, 0), a3, voffA);
            PG8_WAIT_V(8); PG8_WAIT_L(0); PG8_BAR; PG8_MMA(1, 0, At, B0); PG8_MMA(1, 1, At, B1); PG8_BAR; PG8_SCHED;
            } else {
            PG8_LDB(B0, 0, 0); PG8_SCHED; PG8_LDA(At, 0, 0); PG8_STAGE(PG8_SA(1, 1), a1 + hstepA, voffA);
            PG8_WAIT_L(8); PG8_BAR; PG8_WAIT_L(0); PG8_MMA(0, 0, At, B0); PG8_BAR; PG8_SCHED;
            PG8_LDB(B1, 0, 1); PG8_STAGE(PG8_SB(0, 0), b2, voffB);
            PG8_BAR; PG8_WAIT_L(0); PG8_MMA(0, 1, At, B1); PG8_BAR;
            PG8_LDA(At, 0, 1); PG8_STAGE(PG8_SA(0, 0), a2, voffA);
            PG8_BAR; PG8_WAIT_L(0); PG8_MMA(1, 0, At, B0); PG8_BAR; PG8_SCHED;
            PG8_STAGE(PG8_SB(0, 1), b2 + hstep, voffB);
            PG8_WAIT_V(6); PG8_BAR; PG8_MMA(1, 1, At, B1); PG8_BAR;
            PG8_LDB(B0, 1, 0); PG8_SCHED; PG8_LDA(At, 1, 0); PG8_STAGE(PG8_SA(0, 1), a2 + hstepA, voffA);
            PG8_WAIT_L(8); PG8_BAR; PG8_WAIT_L(0); PG8_MMA(0, 0, At, B0); PG8_BAR; PG8_SCHED;
            PG8_LDB(B1, 1, 1); PG8_STAGE(PG8_SB(1, 0), b3, voffB);
            PG8_BAR; PG8_WAIT_L(0); PG8_MMA(0, 1, At, B1); PG8_BAR;
            PG8_LDA(At, 1, 1); PG8_STAGE(PG8_SA(1, 0), a3, voffA);
            PG8_BAR; PG8_WAIT_L(0); PG8_MMA(1, 0, At, B0); PG8_BAR; PG8_SCHED;
            PG8_STAGE(PG8_SB(1, 1), b3 + hstep, voffB);
            PG8_WAIT_V(6); PG8_BAR; PG8_MMA(1, 1, At, B1); PG8_BAR;
            }
        }
        if constexpr (ALIGN_EPI) { if (wr == 0) PG8_BAR; }
        if constexpr (!Epi::AFTER_DRAIN) { E(acc, cur, wr, wc, fr, fq); S.done(cur); }
        if (!has_next) break;
#pragma unroll
        for (int a = 0; a < 2; ++a)
#pragma unroll
            for (int b = 0; b < 2; ++b)
#pragma unroll
                for (int m = 0; m < 4; ++m)
#pragma unroll
                    for (int n = 0; n < 2; ++n) acc[a][b][m][n] = (f32x4){0.f, 0.f, 0.f, 0.f};
        cur = nxt; cA = nA; cB = nB; ++ui;
        if constexpr (ALIGN_EPI) { if (wr == 1) PG8_BAR; }
    }
    PG8_WAIT_V(0);
    if constexpr (!ALIGN_EPI) { if (wr == 0) PG8_BAR; }
    PG8_BAR;
    if constexpr (Epi::AFTER_DRAIN) { E.fused(acc, cur, wr, wc, fr, fq, lds, wid, lane); S.done(cur); }
#undef PG8_KA
#undef PG8_SA
#undef PG8_SB
#undef PG8_STAGE
#undef PG8_LDA
#undef PG8_LDB
#undef PG8_MMA
#undef PG8_WAIT_V
#undef PG8_WAIT_L
#undef PG8_BAR
#undef PG8_SCHED
}
}

constexpr int NWAVES = 8;
constexpr int BATCH = 2, SEQ = 8192, DM = 2048, DEPTH = 4, N_A = 2, NHEAD = 16, HDIM = 128, NKV = 4, GRP = 4, IHEAD = 16, IDIM = 64, TOPK = 256, DFF = 5632, PLE = 256;
constexpr int M = BATCH * SEQ;
constexpr int A_IN = 4176, A_INP = 4352;
constexpr float RMS_EPS = 1e-6f;

constexpr size_t MiB = 1u << 20;
constexpr size_t WS_CTL = 0, CTL_ZERO_BYTES = 32 * 1024;
constexpr size_t SZ_WIN = (size_t)A_INP * DM * 2, SZ_SQ = (size_t)DM * DM * 2, SZ_W13 = (size_t)2 * DFF * DM * 2, SZ_W2 = (size_t)DM * DFF * 2, SZ_WPE = (size_t)DM * PLE * 2, SZ_WKV = (size_t)1024 * DM * 2;
constexpr size_t WS_WIN = 1 * MiB;
constexpr size_t WS_WOA = WS_WIN + 2 * SZ_WIN;
constexpr size_t WS_WQB = WS_WOA + 2 * SZ_SQ;
constexpr size_t WS_WOB = WS_WQB + 2 * SZ_SQ;
constexpr size_t WS_WPG = WS_WOB + 2 * SZ_SQ;
constexpr size_t WS_W13 = WS_WPG + 4 * SZ_SQ;
constexpr size_t WS_W2 = WS_W13 + 4 * SZ_W13;
constexpr size_t WS_WPE = WS_W2 + 4 * SZ_W2;
constexpr size_t WS_WKV = WS_WPE + 4 * SZ_WPE;
constexpr size_t WS_PB = WS_WKV + SZ_WKV;
constexpr size_t WS_XN = WS_PB + (size_t)4 * M * PLE * 2;
constexpr size_t WS_KVA = WS_XN + (size_t)M * DM * 2;
constexpr size_t WS_KVB = WS_KVA + (size_t)8 * SEQ * 256 * 2;
constexpr size_t WS_R1 = WS_KVB + (size_t)8 * SEQ * 256 * 2;
constexpr size_t WS_Q = WS_R1;
constexpr size_t WS_AO = WS_Q + (size_t)M * DM * 2;
constexpr size_t WS_QI = WS_AO + (size_t)M * DM * 2;
constexpr size_t WS_KIW = WS_QI + (size_t)M * 1024 * 2;
constexpr size_t WS_IDX = WS_KIW + (size_t)M * 256 * 2;
constexpr size_t WS_KIT = WS_IDX + (size_t)M * 256 * 4;
constexpr size_t WS_R1_END = WS_KIT + (size_t)M * 64 * 2;
constexpr size_t WS_U = WS_R1;
static_assert(WS_U + (size_t)M * DFF * 2 <= WS_R1_END, "U fits the attention scratch region");
constexpr size_t WS_XNB = WS_R1_END;
constexpr size_t WS_PE = WS_XNB + (size_t)M * DM * 2;
constexpr size_t WS_SSP = WS_PE + (size_t)M * DM * 2;
constexpr size_t WS_END = WS_SSP + (size_t)13 * M * 32 * 4;
constexpr int RTAB_OFF = 131072;
constexpr int CW_BAR = 4096;

constexpr int LDS_BYTES = 163840;
constexpr int MISC_OFF = LDS_BYTES - 256;
constexpr int TAB_ENTRIES = 129 * 16;

#define GAS __attribute__((address_space(1)))
#define LAS __attribute__((address_space(3)))
typedef unsigned short bf16;
typedef unsigned v4u __attribute__((ext_vector_type(4)));
typedef unsigned v2u __attribute__((ext_vector_type(2)));
typedef float f32x4 __attribute__((ext_vector_type(4)));
typedef float f32x16 __attribute__((ext_vector_type(16)));
typedef short bf16x8 __attribute__((ext_vector_type(8)));
typedef short s16x4 __attribute__((ext_vector_type(4)));
typedef GAS unsigned gu32;
#define RLX_AGENT __ATOMIC_RELAXED, __HIP_MEMORY_SCOPE_AGENT
#define LDS_WAIT() asm volatile("s_waitcnt lgkmcnt(0)" ::: "memory")
__device__ __forceinline__ unsigned f2bf(float f) { unsigned u = __builtin_bit_cast(unsigned, f); return (u + 0x7fffu + ((u >> 16) & 1u)) >> 16; }
__device__ __forceinline__ unsigned pk2(float lo, float hi) { return pg8::cvt_pk_bf16(lo, hi); }
__device__ __forceinline__ float bf2f(unsigned short b) { return __uint_as_float(((unsigned)b) << 16); }
__device__ __forceinline__ s16x4 vtr(const LAS unsigned char* p) { typedef short v4i16_t __attribute__((ext_vector_type(4))); return __builtin_bit_cast(s16x4, __builtin_amdgcn_ds_read_tr16_b64_v4i16((LAS v4i16_t*)p)); }
__device__ __forceinline__ float bfly16_max(float v) { auto rr = __builtin_amdgcn_permlane16_swap(__float_as_uint(v), __float_as_uint(v), false, false); return fmaxf(__uint_as_float(rr[0]), __uint_as_float(rr[1])); }
__device__ __forceinline__ float bfly32_max(float v) { auto rr = __builtin_amdgcn_permlane32_swap(__float_as_uint(v), __float_as_uint(v), false, false); return fmaxf(__uint_as_float(rr[0]), __uint_as_float(rr[1])); }
__device__ __forceinline__ float bfly16_sum(float v) { auto rr = __builtin_amdgcn_permlane16_swap(__float_as_uint(v), __float_as_uint(v), false, false); return __uint_as_float(rr[0]) + __uint_as_float(rr[1]); }
__device__ __forceinline__ float bfly32_sum(float v) { auto rr = __builtin_amdgcn_permlane32_swap(__float_as_uint(v), __float_as_uint(v), false, false); return __uint_as_float(rr[0]) + __uint_as_float(rr[1]); }
__device__ __forceinline__ float wave_sum(float v) {
#pragma unroll
    for (int o = 1; o < 64; o <<= 1) v += __shfl_xor(v, o);
    return v;
}
#define XB_TMO      128
#define XB_XCNT(j)  (256  + 64 * (j))
#define XB_XSUB(j)  (1280 + 64 * (j))
#define XB_XGEN(j)  (2304 + 64 * (j))
#define XB_TOP      3328
#define XB_TOPGEN   3392
#define XCD_BAR_WORDS 3456
#define XB_SPIN_CAP (1u << 18)

__device__ __forceinline__ unsigned xb_ld(unsigned* p)              { return __hip_atomic_load(p, __ATOMIC_RELAXED, __HIP_MEMORY_SCOPE_AGENT); }
__device__ __forceinline__ unsigned xb_add(unsigned* p, unsigned v) { return __hip_atomic_fetch_add(p, v, __ATOMIC_RELAXED, __HIP_MEMORY_SCOPE_AGENT); }
__device__ __forceinline__ unsigned xb_xcc_id() { return (unsigned)__builtin_amdgcn_s_getreg((3 << 11) | 20) & 0xFu; }
#define XB_SPIN(cond, bar) do { unsigned _sp = 0; while (cond) { __builtin_amdgcn_s_sleep(1); \
    if ((++_sp & 255u) == 0u) { if (xb_ld(&(bar)[XB_TMO])) break; if (_sp > XB_SPIN_CAP) { atomicAdd(&(bar)[XB_TMO], 1u); break; } } } } while (0)

struct XcdBarrier {
    unsigned* bar; unsigned x;
    volatile LAS unsigned* st;
};

__device__ __forceinline__ XcdBarrier xcd_barrier_post(unsigned* bar, volatile LAS unsigned* st) {
    XcdBarrier b; b.bar = bar; b.x = xb_xcc_id(); b.st = st;
    if (threadIdx.x == 0) (void)xb_add(&bar[XB_XCNT(b.x)], 1u);
    return b;
}
__device__ __forceinline__ void xcd_barrier_complete(unsigned* bar, unsigned x, unsigned& nloc, unsigned& nx) {
    const unsigned G = gridDim.x * gridDim.y * gridDim.z;
    unsigned sum, cnt, mine, sp = 0u;
    for (;;) {
        sum = 0u; cnt = 0u; mine = 0u;
#pragma unroll
        for (unsigned j = 0; j < 16; ++j) { const unsigned c = xb_ld(&bar[XB_XCNT(j)]); sum += c; cnt += (c > 0u) ? 1u : 0u; mine = (j == x) ? c : mine; }
        if (sum == G) break;
        __builtin_amdgcn_s_sleep(1);
        if ((++sp & 255u) == 0u) { if (xb_ld(&bar[XB_TMO])) break; if (sp > XB_SPIN_CAP) { atomicAdd(&bar[XB_TMO], 1u); break; } }
    }
    nloc = mine > 0u ? mine : 1u; nx = cnt > 0u ? cnt : 1u;
}

__device__ __forceinline__ void xcd_barrier(const XcdBarrier& b) {
    asm volatile("s_waitcnt vmcnt(0)" ::: "memory");
    __syncthreads();
    if (threadIdx.x == 0) {
        unsigned* bar = b.bar;
        __builtin_amdgcn_s_waitcnt(0);
        unsigned nloc = b.st[0], nx = b.st[1];
        if (nloc == 0u) { xcd_barrier_complete(bar, b.x, nloc, nx); b.st[0] = nloc; b.st[1] = nx; }
        const unsigned old = xb_add(&bar[XB_XSUB(b.x)], 1u);
        const unsigned gen = old / nloc;
        if (old + 1u == (gen + 1u) * nloc) {
            __builtin_amdgcn_fence(__ATOMIC_RELEASE, "agent");
            asm volatile("s_waitcnt vmcnt(0)" ::: "memory");
            const unsigned og = xb_add(&bar[XB_TOP], 1u);
            const unsigned tg = og / nx;
            if (og + 1u == (tg + 1u) * nx) xb_add(&bar[XB_TOPGEN], 1u);
            else XB_SPIN(xb_ld(&bar[XB_TOPGEN]) == tg, bar);
            __builtin_amdgcn_fence(__ATOMIC_ACQUIRE, "agent");
            xb_add(&bar[XB_XGEN(b.x)], 1u);
            asm volatile("s_waitcnt vmcnt(0)" ::: "memory");
        } else {
            XB_SPIN(xb_ld(&bar[XB_XGEN(b.x)]) == gen, bar);
            __builtin_amdgcn_fence(__ATOMIC_ACQUIRE, "agent");
            asm volatile("s_waitcnt vmcnt(0)" ::: "memory");
        }
    }
    __syncthreads();
}

__device__ __forceinline__ void tr_load(const float* W, const float* gain, int N, int k0, int n0, f32x4 (&v)[16], f32x4 (&g)[2], int lane) {
    int nc = n0 + (lane & 15) * 4; nc = nc < N - 4 ? nc : N - 4; const int kr = lane >> 4;
    const GAS float* gp = (const GAS float*)(gain ? gain : W) + k0 + 8 * (lane & 7);
    g[0] = *(const GAS f32x4*)gp; g[1] = *(const GAS f32x4*)(gp + 4);
    const GAS float* src = (const GAS float*)W + (size_t)(k0 + kr) * N + nc;
#pragma unroll
    for (int i = 0; i < 16; ++i) v[i] = *(const GAS f32x4*)(src + (size_t)(4 * i) * N);
}
__device__ __forceinline__ void tr_store(bf16* WT, bool hg, int K, int N, int k0, int n0, int drow0, const f32x4 (&v)[16], const f32x4 (&g)[2], LAS float* scr, int lane) {
    const int c4 = (lane & 15) * 4, kr = lane >> 4;
#pragma unroll
    for (int i = 0; i < 16; ++i) { const int k = 4 * i + kr; scr[(c4 + 0) * 65 + k] = v[i].x; scr[(c4 + 1) * 65 + k] = v[i].y; scr[(c4 + 2) * 65 + k] = v[i].z; scr[(c4 + 3) * 65 + k] = v[i].w; }
    LDS_WAIT(); asm volatile("" ::: "memory");
    const int c = lane & 7;
    const float m0 = hg ? g[0].x : 1.f, m1 = hg ? g[0].y : 1.f, m2 = hg ? g[0].z : 1.f, m3 = hg ? g[0].w : 1.f, m4 = hg ? g[1].x : 1.f, m5 = hg ? g[1].y : 1.f, m6 = hg ? g[1].z : 1.f, m7 = hg ? g[1].w : 1.f;
#pragma unroll
    for (int j = 0; j < 8; ++j) { const int n = (lane >> 3) + 8 * j; const LAS float* s = scr + n * 65 + 8 * c;
        v4u o; o.x = pk2(s[0] * m0, s[1] * m1); o.y = pk2(s[2] * m2, s[3] * m3); o.z = pk2(s[4] * m4, s[5] * m5); o.w = pk2(s[6] * m6, s[7] * m7);
        if (n0 + n < N) *(GAS v4u*)(WT + (size_t)(drow0 + n) * K + k0 + 8 * c) = o; }
    LDS_WAIT(); asm volatile("" ::: "memory");
}
__device__ __forceinline__ int map_row(int mt, int n) {
    if (mt == 1) { if (n >= 2048 && n < 3072) { const int v = (n >= 2560) ? 1 : 0, nn = n - 2048 - v * 512; return 2048 + (nn >> 7) * 256 + v * 128 + (nn & 127); } return n; }
    if (mt == 2) { const int v = (n >= 512) ? 1 : 0, nn = n - v * 512; return (nn >> 7) * 256 + v * 128 + (nn & 127); }
    if (mt == 3) return (n >> 7) * 256 + (n & 127);
    if (mt == 4) return (n >> 7) * 256 + 128 + (n & 127);
    return n;
}
__device__ __forceinline__ void conv_matrix(const float* W, const float* gain, int K, int N, bf16* WT, int mt, LAS float* scr, int gw, int NGW, int lane, int& rot) {
    const int nblk = (N + 63) / 64, nitems = (K / 64) * nblk;
    int it = gw - rot; if (it < 0) it += NGW;
    rot = (rot + nitems) % NGW;
    f32x4 va[16], vb[16], ga[2], gb[2];
#define CONV_KB(i_) ((i_) / nblk)
#define CONV_LOAD(v_, g_, i_) tr_load(W, gain, N, 64 * CONV_KB(i_), 64 * ((i_) - CONV_KB(i_) * nblk), v_, g_, lane)
#define CONV_STORE(v_, g_, i_) tr_store(WT, gain != nullptr, K, N, 64 * CONV_KB(i_), 64 * ((i_) - CONV_KB(i_) * nblk), map_row(mt, 64 * ((i_) - CONV_KB(i_) * nblk)), v_, g_, scr, lane)
    if (it < nitems) CONV_LOAD(va, ga, it);
    while (it < nitems) {
        const int i1 = it + NGW; if (i1 < nitems) CONV_LOAD(vb, gb, i1);
        CONV_STORE(va, ga, it);
        if (i1 >= nitems) break;
        const int i2 = i1 + NGW; if (i2 < nitems) CONV_LOAD(va, ga, i2);
        CONV_STORE(vb, gb, i1);
        it = i2;
    }
#undef CONV_KB
#undef CONV_LOAD
#undef CONV_STORE
}

__device__ __forceinline__ float wave_sum_dpp(float v) {
#define FN_DPP(ctrl) v += __uint_as_float((unsigned)__builtin_amdgcn_update_dpp(0, (int)__float_as_uint(v), ctrl, 0xf, 0xf, false))
    FN_DPP(0xB1); FN_DPP(0x4E); FN_DPP(0x124); FN_DPP(0x128);
#undef FN_DPP
    return bfly32_sum(bfly16_sum(v));
}
__device__ __forceinline__ void xb_phase(const float* x, bf16* XB, float* ss, int gw, int NGW, int lane) {
    for (int m = gw; m < M; m += NGW) {
        const GAS f32x4* xr = (const GAS f32x4*)(x + (size_t)m * DM) + lane; f32x4 v[8]; float s = 0.f;
#pragma unroll
        for (int j = 0; j < 8; ++j) { v[j] = xr[64 * j]; s += (v[j].x * v[j].x + v[j].y * v[j].y) + (v[j].z * v[j].z + v[j].w * v[j].w); }
        s = wave_sum_dpp(s);
#pragma unroll
        for (int j = 0; j < 8; ++j) { const int c0 = 4 * (lane + 64 * j); v2u w; w.x = pk2(v[j].x, v[j].y); w.y = pk2(v[j].z, v[j].w);
            *(GAS v2u*)(XB + ((size_t)((m >> 8) * 8 + (c0 >> 8)) << 16) + (size_t)(m & 255) * 256 + (c0 & 255)) = w; }
        if (lane < 32) ((GAS float*)ss)[(size_t)m * 32 + lane] = lane == 0 ? s : 0.f;
    }
}
__device__ __forceinline__ void final_norm_phase(const bf16* xb, const float* g, float* out, int gw, int NGW, int lane) {
    f32x4 gg[4][2];
#pragma unroll
    for (int j = 0; j < 4; ++j) { const int c0 = (lane + 64 * j) * 8; gg[j][0] = *(const GAS f32x4*)(g + c0); gg[j][1] = *(const GAS f32x4*)(g + c0 + 4); }
    v4u v[4], vn[4];
#define FN_LOAD(dst, m_) do { _Pragma("unroll") for (int j = 0; j < 4; ++j) { const int c0 = 8 * (lane + 64 * j); dst[j] = *(const GAS v4u*)(xb + ((size_t)(((m_) >> 8) * 8 + (c0 >> 8)) << 16) + (size_t)((m_) & 255) * 256 + (c0 & 255)); } } while (0)
    if (gw < M) FN_LOAD(vn, gw);
    for (int m = gw; m < M; m += NGW) {
#pragma unroll
        for (int j = 0; j < 4; ++j) v[j] = vn[j];
        { const int mn = m + NGW < M ? m + NGW : m; FN_LOAD(vn, mn); }
        float s = 0.f;
#pragma unroll
        for (int j = 0; j < 4; ++j) { const unsigned w[4] = {v[j].x, v[j].y, v[j].z, v[j].w};
#pragma unroll
            for (int e = 0; e < 4; ++e) { const float lo = __uint_as_float(w[e] << 16), hi = __uint_as_float(w[e] & 0xffff0000u); s += lo * lo + hi * hi; } }
        const float r = 1.0f / sqrtf(wave_sum_dpp(s) * (1.f / DM) + RMS_EPS);
#pragma unroll
        for (int j = 0; j < 4; ++j) { const int c0 = (lane + 64 * j) * 8; const unsigned w[4] = {v[j].x, v[j].y, v[j].z, v[j].w};
            const f32x4 g0 = gg[j][0], g1 = gg[j][1];
            f32x4 o0, o1; o0.x = __uint_as_float(w[0] << 16) * r * g0.x; o0.y = __uint_as_float(w[0] & 0xffff0000u) * r * g0.y; o0.z = __uint_as_float(w[1] << 16) * r * g0.z; o0.w = __uint_as_float(w[1] & 0xffff0000u) * r * g0.w;
            o1.x = __uint_as_float(w[2] << 16) * r * g1.x; o1.y = __uint_as_float(w[2] & 0xffff0000u) * r * g1.y; o1.z = __uint_as_float(w[3] << 16) * r * g1.z; o1.w = __uint_as_float(w[3] & 0xffff0000u) * r * g1.w;
            GAS f32x4* op = (GAS f32x4*)(out + (size_t)m * DM + c0); op[0] = o0; op[1] = o1; }
    }
#undef FN_LOAD
}

__device__ __forceinline__ void build_bias_tab(LAS float* tab, const float* rel_bias, int tid) {
    for (int e = tid; e < TAB_ENTRIES; e += NWAVES * 64) { const int rel = e >> 4, h = e & 15; int bk;
        if (rel < 16) bk = rel; else if (rel >= 128) bk = 31; else { bk = 16 + (int)(logf((float)rel * (1.f / 16.f)) / logf(8.f) * 16.f); bk = bk > 31 ? 31 : bk; }
        tab[e] = rel_bias[bk * 16 + h]; }
}

__device__ __forceinline__ unsigned mono_key(float s) { const unsigned u = __float_as_uint(s); return (u & 0x80000000u) ? ~u : (u | 0x80000000u); }
__device__ __forceinline__ int mbcnt64(unsigned long long m) { return (int)__builtin_amdgcn_mbcnt_hi((unsigned)(m >> 32), __builtin_amdgcn_mbcnt_lo((unsigned)m, 0u)); }
constexpr int IDX_CAND = 512;
__device__ __forceinline__ void idx_scan(LAS unsigned* hrow, unsigned k_rem, int lane, unsigned& D, unsigned& above, unsigned& cD) {
    const int rl = 63 - lane;
    v4u w[4];
#pragma unroll
    for (int k = 0; k < 4; ++k) w[k] = *(const LAS v4u*)(hrow + 16 * rl + 4 * k);
    const unsigned wd[16] = {w[0].x, w[0].y, w[0].z, w[0].w, w[1].x, w[1].y, w[1].z, w[1].w, w[2].x, w[2].y, w[2].z, w[2].w, w[3].x, w[3].y, w[3].z, w[3].w};
    unsigned tot = 0u;
#pragma unroll
    for (int k = 0; k < 16; ++k) tot += (wd[k] & 0xffffu) + (wd[k] >> 16);
    unsigned v = tot;
#define IDX_DPP_ADD(ctrl, rmask, bmask) v += (unsigned)__builtin_amdgcn_update_dpp(0, (int)v, ctrl, rmask, bmask, false)
    IDX_DPP_ADD(0x111, 0xf, 0xf); IDX_DPP_ADD(0x112, 0xf, 0xf); IDX_DPP_ADD(0x114, 0xf, 0xe); IDX_DPP_ADD(0x118, 0xf, 0xc); IDX_DPP_ADD(0x142, 0xa, 0xf); IDX_DPP_ADD(0x143, 0xc, 0xf);
#undef IDX_DPP_ADD
    const unsigned sx = v - tot;
    const bool mine = (sx < k_rem) && (k_rem <= sx + tot);
    unsigned S = sx + tot, kw = 0u, alw = sx, xw = 0u;
#pragma unroll
    for (int k = 0; k < 16; ++k) { const unsigned wsk = (wd[k] & 0xffffu) + (wd[k] >> 16), Sn = S - wsk; const bool ge = S >= k_rem;
        xw = ge ? wd[k] : xw; alw = ge ? Sn : alw; kw = ge ? (unsigned)k : kw; S = Sn; }
    const unsigned chi = xw >> 16, clo = xw & 0xffffu;
    const bool inhi = alw + chi >= k_rem;
    const unsigned Dl = (unsigned)(32 * rl) + 2u * kw + (inhi ? 1u : 0u), al = inhi ? alw : alw + chi, cl = inhi ? chi : clo;
    const unsigned long long bal = __ballot(mine); const int Ls = bal ? (__ffsll((long long)bal) - 1) : 0;
    D = (unsigned)__builtin_amdgcn_readlane((int)Dl, Ls); above = (unsigned)__builtin_amdgcn_readlane((int)al, Ls); cD = (unsigned)__builtin_amdgcn_readlane((int)cl, Ls);
#pragma unroll
    for (int k = 0; k < 4; ++k) *(LAS v4u*)(hrow + 16 * rl + 4 * k) = (v4u){0u, 0u, 0u, 0u};
}
__device__ __forceinline__ void indexer_phase(LAS unsigned char* lds, const bf16* QI, const bf16* KIW, const bf16* KIT, int* IDX, int c, int G, int tid, int wave, int lane_in) {
    int lane = lane_in;
    LAS unsigned* sc = (LAS unsigned*)lds;
    LAS unsigned* hist = (LAS unsigned*)(lds + 131072);
    LAS int* cand = (LAS int*)(lds + 131072 + 16384);
    volatile LAS unsigned* st = (volatile LAS unsigned*)(lds + 131072 + 16384 + 8192);
    for (int i = tid; i < 4096; i += NWAVES * 64) hist[i] = 0u;
    __syncthreads();
    const int q = wave >> 1, half = wave & 1;
    int r32 = lane & 31, hf = lane >> 5;
    constexpr int NU = M / 4;
    bf16x8 pA[2][4], pB0[4]; v4u pW[2][2]; bool pre = false;
#define IDX_ISSUE(L_) do { const int b_ = (L_) & 1, t0_ = ((L_) >> 1) * 4; const size_t tok0_ = (size_t)b_ * SEQ; const int nm_ = ((((t0_ + 4 + 31) >> 5) - wave + NWAVES - 1) / NWAVES); \
        const GAS bf16* kb_ = (const GAS bf16*)(KIT + (tok0_ >> 5) * (4 * 64 * 8) + lane * 8); (void)nm_; \
        _Pragma("unroll") for (int ks = 0; ks < 4; ++ks) pB0[ks] = *(const GAS bf16x8*)(kb_ + (size_t)wave * (4 * 64 * 8) + ks * (64 * 8)); \
        _Pragma("unroll") for (int rb = 0; rb < 2; ++rb) { const GAS bf16* src_ = (const GAS bf16*)(QI + (tok0_ + t0_ + 2 * rb + ((r32 >> 2) & 1)) * 1024 + ((r32 & 3) + 4 * (r32 >> 3)) * 64 + 8 * hf); \
            _Pragma("unroll") for (int ks = 0; ks < 4; ++ks) pA[rb][ks] = *(const GAS bf16x8*)(src_ + ks * 16); \
            const GAS bf16* ws_ = (const GAS bf16*)(KIW + (tok0_ + t0_ + 2 * rb + hf) * 256 + 64); pW[rb][0] = *(const GAS v4u*)ws_; pW[rb][1] = *(const GAS v4u*)(ws_ + 8); } } while (0)
    for (int rnd = 0; rnd * G < NU; ++rnd) {
        lane = lane_in; asm volatile("" : "+v"(lane)); r32 = lane & 31; hf = lane >> 5;
        const int L = rnd * G + ((rnd & 1) ? (G - 1 - c) : c);
        if (L >= NU) continue;
        const int b = L & 1, t0 = (L >> 1) * 4; const size_t tok0 = (size_t)b * SEQ;
        const int t = t0 + q, n = t + 1;
        GAS int* orow = (GAS int*)(IDX + (tok0 + t) * TOPK);
        if (t0 + 4 <= TOPK) {
#pragma unroll
            for (int j = 0; j < 2; ++j) { const int p = half * 128 + j * 64 + lane; orow[p] = p < n ? p : -1; }
            continue;
        }
#ifndef IDX_REP_SCORE
#define IDX_REP_SCORE 1
#endif
        for (int srep = 0; srep < IDX_REP_SCORE; ++srep) {
            const int ntiles = (t0 + 4 + 31) >> 5;
            const int nmine = (ntiles - wave + NWAVES - 1) / NWAVES;
            const GAS bf16* kbase = (const GAS bf16*)(KIT + (tok0 >> 5) * (4 * 64 * 8) + lane * 8);
            bf16x8 B0[4], B1[4], B2[4];
#define IDX_LOAD(Bx, i) do { const int ii_ = (i) < nmine ? (i) : nmine - 1; const GAS bf16* ks_ = kbase + (size_t)(wave + NWAVES * ii_) * (4 * 64 * 8); _Pragma("unroll") for (int ks = 0; ks < 4; ++ks) Bx[ks] = *(const GAS bf16x8*)(ks_ + ks * (64 * 8)); } while (0)
            if (!pre || srep > 0) IDX_ISSUE(L);
            IDX_LOAD(B1, 1);
            bf16x8 A[2][4]; float wgt[2][16];
#pragma unroll
            for (int ks = 0; ks < 4; ++ks) { B0[ks] = pB0[ks]; A[0][ks] = pA[0][ks]; A[1][ks] = pA[1][ks]; }
#pragma unroll
            for (int rb = 0; rb < 2; ++rb) { const v4u w0 = pW[rb][0], w1 = pW[rb][1];
                const unsigned ww[8] = {w0.x, w0.y, w0.z, w0.w, w1.x, w1.y, w1.z, w1.w};
#pragma unroll
                for (int i = 0; i < 8; ++i) { wgt[rb][2 * i] = __uint_as_float(ww[i] << 16) * (1.f / 32.f); wgt[rb][2 * i + 1] = __uint_as_float(ww[i] & 0xffff0000u) * (1.f / 32.f); } }
#define IDX_PROBE_ATOM
#define IDX_TILE(Bx, i) do { if ((i) < nmine) { const int j_ = wave + NWAVES * (i); \
                f32x16 acc0, acc1; _Pragma("unroll") for (int e = 0; e < 16; ++e) { acc0[e] = 0.f; acc1[e] = 0.f; } \
                _Pragma("unroll") for (int ks = 0; ks < 4; ++ks) { acc0 = __builtin_amdgcn_mfma_f32_32x32x16_bf16(A[0][ks], Bx[ks], acc0, 0, 0, 0); acc1 = __builtin_amdgcn_mfma_f32_32x32x16_bf16(A[1][ks], Bx[ks], acc1, 0, 0, 0); }     \
                _Pragma("unroll") for (int rb = 0; rb < 2; ++rb) { \
                    float sa_ = 0.f, sb_ = 0.f, sc_ = 0.f, sd_ = 0.f;                                                                   \
                    _Pragma("unroll") for (int e = 0; e < 4; ++e) { const float x0 = rb ? acc1[e] : acc0[e], x1 = rb ? acc1[e + 4] : acc0[e + 4], x2 = rb ? acc1[e + 8] : acc0[e + 8], x3 = rb ? acc1[e + 12] : acc0[e + 12]; \
                        sa_ = fmaf(wgt[rb][e], __int_as_float(max(__float_as_int(x0), 0)), sa_); sb_ = fmaf(wgt[rb][e + 4], __int_as_float(max(__float_as_int(x1), 0)), sb_); \
                        sc_ = fmaf(wgt[rb][e + 8], __int_as_float(max(__float_as_int(x2), 0)), sc_); sd_ = fmaf(wgt[rb][e + 12], __int_as_float(max(__float_as_int(x3), 0)), sd_); } \
                    const float s_ = (sa_ + sb_) + (sc_ + sd_); \
                    const int tq_ = t0 + 2 * rb + hf, key_ = j_ * 32 + r32; const bool ok_ = key_ <= tq_; const unsigned mk_ = ok_ ? mono_key(s_) : 0u; \
                    sc[(2 * rb + hf) * 8192 + key_] = mk_; \
                    if (ok_ && srep == 0) { __hip_atomic_fetch_add(hist + (2 * rb + hf) * 1024 + (mk_ >> 22), 1u << ((mk_ >> 17) & 16u), __ATOMIC_RELAXED, __HIP_MEMORY_SCOPE_WORKGROUP); IDX_PROBE_ATOM } } } } while (0)
#define IDX_TILE2(Bx, i) IDX_TILE(Bx, i)
#define IDX_LOAD2(Bx, i) IDX_LOAD(Bx, i)
#pragma unroll 1
            for (int i = 0; i < nmine; i += 3) {
                IDX_LOAD2(B2, i + 2); IDX_TILE2(B0, i);
                IDX_LOAD2(B0, i + 3); IDX_TILE2(B1, i + 1);
                IDX_LOAD2(B1, i + 4); IDX_TILE2(B2, i + 2);
            }
#undef IDX_TILE2
#undef IDX_LOAD2
#undef IDX_LOAD
#undef IDX_TILE
        }
        __syncthreads();
        LAS unsigned* srow = sc + q * 8192; LAS unsigned* hrow = hist + q * 1024; LAS int* crow = cand + q * IDX_CAND;
        if (half == 0) { unsigned D, above, cD; idx_scan(hrow, (unsigned)TOPK, lane, D, above, cD);
            if (lane == 0) { st[q * 4 + 0] = D << 21; st[q * 4 + 1] = (unsigned)TOPK - above; st[q * 4 + 2] = cD; } }
        __syncthreads();
        int shift = 21;
        while (shift > 0 && (st[2] > IDX_CAND || st[6] > IDX_CAND || st[10] > IDX_CAND || st[14] > IDX_CAND)) {
            const unsigned prefix = st[q * 4 + 0], k_rem = st[q * 4 + 1]; const int nshift = shift > 11 ? shift - 11 : 0; const unsigned dmask = (1u << (shift - nshift)) - 1u;
            const int nh_ = ((n >> 1) + 63) & ~63; const int lo_ = half ? nh_ : 0, hi_ = half ? n : (nh_ < n ? nh_ : n);
            __syncthreads();
            for (int i = lo_ + lane; i < hi_; i += 64) { const unsigned key = srow[i];
                if ((key >> shift) == (prefix >> shift)) { const unsigned d = (key >> nshift) & dmask; __hip_atomic_fetch_add(hrow + (d >> 1), 1u << (16 * (d & 1)), __ATOMIC_RELAXED, __HIP_MEMORY_SCOPE_WORKGROUP); } }
            __syncthreads();
            if (half == 0) { unsigned D, above, cD; idx_scan(hrow, k_rem, lane, D, above, cD);
                if (lane == 0) { st[q * 4 + 0] = prefix | (D << nshift); st[q * 4 + 1] = k_rem - above; st[q * 4 + 2] = cD; } }
            __syncthreads();
            shift = nshift;
        }
        const unsigned prefix = st[q * 4 + 0]; const int need = (int)st[q * 4 + 1], cD = (int)st[q * 4 + 2], c_gt = TOPK - need;
        const unsigned tp = prefix >> shift; const bool exact_dup = cD > IDX_CAND;
        const int nh = ((n >> 1) + 63) & ~63; const int lo = half ? nh : 0, hi = half ? n : (nh < n ? nh : n);
        if (exact_dup) {
          if (half == 0) {
            int cg = 0, ce = 0;
            for (int base = 0; base < n; base += 64) { const int i = base + lane; const unsigned kp = (i < n) ? srow[i] : 0u;
                const bool gt = (i < hi) && kp > tp, eq = (i < n) && kp == tp;
                const unsigned long long mg = __ballot(gt), me = __ballot(eq);
                const int pg = cg + mbcnt64(mg), pe = ce + mbcnt64(me);
                if (gt) orow[pg] = i;
                if (eq && pe < need) orow[c_gt + pe] = i;
                cg += __popcll(mg); ce += __popcll(me); }
          } else if (hi > lo) {
            int cg = 0;
            for (int base = lo + ((hi - 1 - lo) & ~63); base >= lo; base -= 64) { const int i = base + lane; const bool in = i < hi; const unsigned kp = in ? srow[i] : 0u;
                const bool gt = in && kp > tp; const unsigned long long mg = __ballot(gt);
                const int ag = __popcll(mg) - mbcnt64(mg) - (gt ? 1 : 0);
                if (gt) orow[c_gt - 1 - cg - ag] = i;
                cg += __popcll(mg); }
          }
        } else {
          LAS unsigned short* hl_ = (LAS unsigned short*)hrow + half * 1024;
          int nhit = 0;
          for (int base = lo; base < hi; base += 256) {
              const int i0 = base + 4 * lane; const v4u k4 = (i0 < hi) ? *(const LAS v4u*)(srow + i0) : (v4u){0u, 0u, 0u, 0u};
              const bool h0 = (i0 < hi) && (k4.x >> shift) >= tp, h1 = (i0 + 1 < hi) && (k4.y >> shift) >= tp, h2 = (i0 + 2 < hi) && (k4.z >> shift) >= tp, h3 = (i0 + 3 < hi) && (k4.w >> shift) >= tp;
              const int cnt = (int)h0 + (int)h1 + (int)h2 + (int)h3;
              int v = cnt;
#define IDX_DPP_ADD(ctrl, rmask, bmask) v += __builtin_amdgcn_update_dpp(0, v, ctrl, rmask, bmask, false)
              IDX_DPP_ADD(0x111, 0xf, 0xf); IDX_DPP_ADD(0x112, 0xf, 0xf); IDX_DPP_ADD(0x114, 0xf, 0xe); IDX_DPP_ADD(0x118, 0xf, 0xc); IDX_DPP_ADD(0x142, 0xa, 0xf); IDX_DPP_ADD(0x143, 0xc, 0xf);
#undef IDX_DPP_ADD
              int p = nhit + v - cnt;
              if (h0) { hl_[p] = (unsigned short)i0; ++p; }
              if (h1) { hl_[p] = (unsigned short)(i0 + 1); ++p; }
              if (h2) { hl_[p] = (unsigned short)(i0 + 2); ++p; }
              if (h3) { hl_[p] = (unsigned short)(i0 + 3); }
              nhit += __builtin_amdgcn_readlane(v, 63);
          }
          if (half == 0) {
            int cg = 0, ce = 0;
            for (int j0 = 0; j0 < nhit; j0 += 64) { const int j = j0 + lane; const bool in = j < nhit; const int i = in ? (int)hl_[j] : 0; const unsigned kp = in ? (srow[i] >> shift) : 0u;
                const bool gt = in && kp > tp, eq = in && kp == tp;
                const unsigned long long mg = __ballot(gt), me = __ballot(eq);
                const int pg = cg + mbcnt64(mg), pe = ce + mbcnt64(me);
                if (gt) orow[pg] = i;
                if (eq) crow[pe] = i;
                cg += __popcll(mg); ce += __popcll(me); }
          } else if (nhit > 0) {
            int cg = 0, ce = 0;
            for (int j0 = (nhit - 1) & ~63; j0 >= 0; j0 -= 64) { const int j = j0 + lane; const bool in = j < nhit; const int i = in ? (int)hl_[j] : 0; const unsigned kp = in ? (srow[i] >> shift) : 0u;
                const bool gt = in && kp > tp, eq = in && kp == tp;
                const unsigned long long mg = __ballot(gt), me = __ballot(eq);
                const int ag = __popcll(mg) - mbcnt64(mg) - (gt ? 1 : 0), ae = __popcll(me) - mbcnt64(me) - (eq ? 1 : 0);
                if (gt) orow[c_gt - 1 - cg - ag] = i;
                if (eq) crow[cD - 1 - ce - ae] = i;
                cg += __popcll(mg); ce += __popcll(me); }
          }
        }
        __syncthreads();
        { const int rn = rnd + 1; const int Ln = rn * G + ((rn & 1) ? (G - 1 - c) : c); pre = (rn * G < NU) && (Ln < NU); const int Lq = pre ? Ln : L; IDX_ISSUE(Lq); }
#ifndef IDX_REP_TAIL
#define IDX_REP_TAIL 1
#endif
        for (int trep = 0; trep < IDX_REP_TAIL; ++trep)
        if (half == 0 && !exact_dup) {
#pragma unroll
            for (int k = 0; k < 4; ++k) *(LAS v4u*)(hrow + 16 * lane + 4 * k) = (v4u){0u, 0u, 0u, 0u};
            unsigned pfx = prefix, k_rem = (unsigned)need; int sh = shift;
            int ci[8]; unsigned ck[8];
#pragma unroll
            for (int m = 0; m < 8; ++m) { const int j = lane + 64 * m; ci[m] = j < cD ? crow[j] : 0; }
            __builtin_amdgcn_sched_barrier(0);
#pragma unroll
            for (int m = 0; m < 8; ++m) { const int j = lane + 64 * m; ck[m] = j < cD ? srow[ci[m]] : 0u; }
            __builtin_amdgcn_sched_barrier(0);
            while (sh > 0) {
                const int nsh = sh > 11 ? sh - 11 : 0; const unsigned dmask = (1u << (sh - nsh)) - 1u;
#pragma unroll
                for (int m = 0; m < 8; ++m) { const int j = lane + 64 * m; const unsigned key = ck[m];
                    if (j < cD && (key >> sh) == (pfx >> sh)) { const unsigned d = (key >> nsh) & dmask; __hip_atomic_fetch_add(hrow + (d >> 1), 1u << (16 * (d & 1)), __ATOMIC_RELAXED, __HIP_MEMORY_SCOPE_WORKGROUP); } }
                unsigned D, above, cDn; idx_scan(hrow, k_rem, lane, D, above, cDn);
                pfx |= D << nsh; k_rem -= above; sh = nsh;
            }
            int cg = 0, ce = 0; const int n_gt = need - (int)k_rem;
#pragma unroll
            for (int m = 0; m < 8; ++m) { const int j = lane + 64 * m; const bool in = j < cD; const unsigned key = ck[m];
                const bool gt = in && key > pfx, eq = in && key == pfx;
                const unsigned long long mg = __ballot(gt), me = __ballot(eq);
                const int pg = cg + mbcnt64(mg), pe = ce + mbcnt64(me);
                if (gt) orow[c_gt + pg] = ci[m];
                if (eq && pe < (int)k_rem) orow[c_gt + n_gt + pe] = ci[m];
                cg += __popcll(mg); ce += __popcll(me); }
        }
        __syncthreads();
    }
}
constexpr float ATT_SCALE = 0.08838834764831845f;
__device__ __forceinline__ unsigned pkbf(float lo, float hi) { return pg8::cvt_pk_bf16(lo, hi); }
__device__ __forceinline__ void dsa_attn_phase(LAS unsigned char* lds, const bf16* Q, const unsigned char* KV8, const int* IDX, bf16* AO, const float* rel_bias, int c, int G, int tid, int wave, int lane) {
    typedef int v4i __attribute__((ext_vector_type(4))); typedef float f32x2 __attribute__((ext_vector_type(2)));
    constexpr int KSTR = 144, VSTR = 272, WBYTES = 32 * KSTR + 32 * VSTR;
    LAS unsigned char* kb = lds + wave * WBYTES; LAS unsigned char* vb = kb + 32 * KSTR;
    LAS int* idl = (LAS int*)(lds + NWAVES * WBYTES + wave * 2048);
    LAS float* tab = (LAS float*)(lds + NWAVES * WBYTES + NWAVES * 2048);
    build_bias_tab(tab, rel_bias, tid);
    __syncthreads();
    const int hl = lane & 15, Gq = lane >> 4, hsel = hl & 3, qrow = hl >> 2, pcol = lane & 3;
    const int NGW = G * NWAVES;
    const int uid0 = c * NWAVES + wave, nun = (8 * SEQ - uid0 + NGW - 1) / NGW;
    v4i ivn; v4u qraw[4];
#define DSA_UNIT(u_, k_, bg_, t_, tok_) const int u_ = uid0 + ((k_) < nun ? (k_) : nun - 1) * NGW; const int bg_ = (u_ >> 3) & 7, t_ = ((u_ >> 6) << 3) | (u_ & 7); const size_t tok_ = (size_t)(bg_ >> 2) * SEQ + t_
    { DSA_UNIT(ua_, 0, bg0, t0_, tok0); ivn = *(const GAS v4i*)(IDX + tok0 * TOPK + lane * 4);
      const GAS bf16* qs = (const GAS bf16*)(Q + tok0 * DM + ((bg0 & 3) * 4 + hsel) * HDIM + 8 * Gq);
#pragma unroll
      for (int ks = 0; ks < 4; ++ks) qraw[ks] = *(const GAS v4u*)(qs + ks * 32);
      *(LAS v4i*)(idl + lane * 4) = ivn; }
    v4u stk[4], stv[4];
#define DSA_RSRC(bg_) __builtin_amdgcn_make_buffer_rsrc((void*)(((unsigned long long)(unsigned)__builtin_amdgcn_readfirstlane((int)(unsigned)(((unsigned long long)(KV8 + (size_t)(bg_) * SEQ * 256)) >> 32)) << 32) | (unsigned)__builtin_amdgcn_readfirstlane((int)(unsigned)(unsigned long long)(KV8 + (size_t)(bg_) * SEQ * 256))), (short)0, SEQ * 256, 0x00020000)
#define DSA_LOAD(idp, cc, rs_) { int sj_[4]; _Pragma("unroll") for (int j = 0; j < 4; ++j) sj_[j] = (idp)[(cc) * 32 + 8 * j + (lane >> 3)]; __builtin_amdgcn_sched_barrier(0); \
        _Pragma("unroll") for (int j = 0; j < 4; ++j) { const int vo_ = (max(sj_[j], 0) << 8) + (lane & 7) * 16; stk[j] = __builtin_bit_cast(v4u, __builtin_amdgcn_raw_buffer_load_b128(rs_, vo_, 0, 0)); stv[j] = __builtin_bit_cast(v4u, __builtin_amdgcn_raw_buffer_load_b128(rs_, vo_ + 128, 0, 0)); } }
    { DSA_UNIT(ub_, 0, bg0, t0_, tok0); (void)t0_; (void)tok0; const __amdgpu_buffer_rsrc_t rs0 = DSA_RSRC(bg0); DSA_LOAD(idl, 0, rs0) }
    for (int k = 0; k < nun; ++k) {
        DSA_UNIT(uc_, k, bg, t, tok); const int b = bg >> 2, g = bg & 3; (void)b;
        LAS int* idc = idl + (k & 1) * 256; LAS int* idn = idl + ((k + 1) & 1) * 256;
        long qf[4];
#pragma unroll
        for (int ks = 0; ks < 4; ++ks) { const v4u v = qraw[ks];
            int w0 = __builtin_amdgcn_cvt_pk_fp8_f32(__uint_as_float(v.x << 16) * 16.f, __uint_as_float(v.x & 0xffff0000u) * 16.f, 0, false); w0 = __builtin_amdgcn_cvt_pk_fp8_f32(__uint_as_float(v.y << 16) * 16.f, __uint_as_float(v.y & 0xffff0000u) * 16.f, w0, true);
            int w1 = __builtin_amdgcn_cvt_pk_fp8_f32(__uint_as_float(v.z << 16) * 16.f, __uint_as_float(v.z & 0xffff0000u) * 16.f, 0, false); w1 = __builtin_amdgcn_cvt_pk_fp8_f32(__uint_as_float(v.w << 16) * 16.f, __uint_as_float(v.w & 0xffff0000u) * 16.f, w1, true);
            qf[ks] = hl < 4 ? (long)(((unsigned long long)(unsigned)w1 << 32) | (unsigned)w0) : 0L; }
        unsigned long long fastmask;
        { const int mn_ = min(min(ivn[0], ivn[1]), min(ivn[2], ivn[3])), mx_ = max(max(ivn[0], ivn[1]), max(ivn[2], ivn[3])); fastmask = __ballot(mn_ >= 0 && t - mx_ >= 128); }
        DSA_UNIT(un_, k + 1, bgn, tn, tokn); (void)tn;
        ivn = *(const GAS v4i*)(IDX + tokn * TOPK + lane * 4);
        { const GAS bf16* qs = (const GAS bf16*)(Q + tokn * DM + ((bgn & 3) * 4 + hsel) * HDIM + 8 * Gq);
#pragma unroll
          for (int ks = 0; ks < 4; ++ks) qraw[ks] = *(const GAS v4u*)(qs + ks * 32); }
        const __amdgpu_buffer_rsrc_t kvbn = DSA_RSRC(bgn), kvbase = DSA_RSRC(bg);
        const int hq = g * 4 + hsel; const float bfar = tab[128 * 16 + hq] * 1.4426950408889634f;
        float mrun = -3.0e38f, lsum = 0.f; f32x4 O[8];
#pragma unroll
        for (int db = 0; db < 8; ++db) O[db] = (f32x4){0.f, 0.f, 0.f, 0.f};
#pragma unroll 1
        for (int cc = 0; cc < 8; ++cc) {
#pragma unroll
            for (int j = 0; j < 4; ++j) { const int key = 8 * j + (lane >> 3), pc = lane & 7;
                *(LAS v4u*)(kb + key * KSTR + pc * 16) = stk[j];
                const unsigned w[4] = {stv[j].x, stv[j].y, stv[j].z, stv[j].w}; unsigned o[8];
#pragma unroll
                for (int e = 0; e < 4; ++e) { typedef __bf16 bf2_t __attribute__((ext_vector_type(2))); o[2 * e] = __builtin_bit_cast(unsigned, (bf2_t)__builtin_amdgcn_cvt_scalef32_pk_bf16_fp8(w[e], 1.0f, false)); o[2 * e + 1] = __builtin_bit_cast(unsigned, (bf2_t)__builtin_amdgcn_cvt_scalef32_pk_bf16_fp8(w[e], 1.0f, true)); }
                *(LAS v4u*)(vb + key * VSTR + pc * 32) = (v4u){o[0], o[1], o[2], o[3]}; *(LAS v4u*)(vb + key * VSTR + pc * 32 + 16) = (v4u){o[4], o[5], o[6], o[7]}; }
            if (cc < 7) { DSA_LOAD(idc, cc + 1, kvbase) } else { *(LAS v4i*)(idn + lane * 4) = ivn; DSA_LOAD(idn, 0, kvbn) }
            long ka[2][4];
#pragma unroll
            for (int rb = 0; rb < 2; ++rb)
#pragma unroll
                for (int ks = 0; ks < 4; ++ks) ka[rb][ks] = *(const LAS long*)(kb + (16 * rb + hl) * KSTR + ks * 32 + 8 * Gq);
            __builtin_amdgcn_sched_barrier(0);
            f32x4 S[2];
#pragma unroll
            for (int rb = 0; rb < 2; ++rb) S[rb] = (f32x4){0.f, 0.f, 0.f, 0.f};
#pragma unroll
            for (int ks = 0; ks < 4; ++ks)
#pragma unroll
                for (int rb = 0; rb < 2; ++rb) S[rb] = __builtin_amdgcn_mfma_f32_16x16x32_fp8_fp8(ka[rb][ks], qf[ks], S[rb], 0, 0, 0);
            float l[2][4]; float cmax = -3.0e38f;
            if (((fastmask >> (8 * cc)) & 0xFFull) == 0xFFull) {
#pragma unroll
                for (int rb = 0; rb < 2; ++rb)
#pragma unroll
                    for (int i = 0; i < 4; ++i) { const float v = fmaf(S[rb][i], ATT_SCALE * (1.f / 256.f) * 1.4426950408889634f, bfar); l[rb][i] = v; cmax = fmaxf(cmax, v); }
            } else {
                const v4i sv0 = *(const LAS v4i*)(idc + cc * 32 + 4 * Gq), sv1 = *(const LAS v4i*)(idc + cc * 32 + 16 + 4 * Gq);
#pragma unroll
                for (int rb = 0; rb < 2; ++rb)
#pragma unroll
                    for (int i = 0; i < 4; ++i) { const int s_ = rb ? sv1[i] : sv0[i]; int rel = t - s_; rel = rel > 128 ? 128 : (rel < 0 ? 0 : rel);
                        const float v = (s_ >= 0) ? (S[rb][i] * (ATT_SCALE * (1.f / 256.f)) + tab[rel * 16 + hq]) * 1.4426950408889634f : -1.0e30f; l[rb][i] = v; cmax = fmaxf(cmax, v); }
            }
            cmax = bfly32_max(bfly16_max(cmax));
            const float mnew = fmaxf(mrun, cmax);
            if (__any(mnew > mrun)) {
                const float alpha = __builtin_amdgcn_exp2f(mrun - mnew); lsum *= alpha;
#pragma unroll
                for (int db = 0; db < 8; ++db) O[db] = O[db] * alpha;
            }
            mrun = mnew;
            float ps = 0.f;
#pragma unroll
            for (int rb = 0; rb < 2; ++rb)
#pragma unroll
                for (int i = 0; i < 4; ++i) { l[rb][i] = __builtin_amdgcn_exp2f(l[rb][i] - mnew); ps += l[rb][i]; }
            lsum += ps;
            v4u pu; pu.x = pkbf(l[0][0], l[0][1]); pu.y = pkbf(l[0][2], l[0][3]); pu.z = pkbf(l[1][0], l[1][1]); pu.w = pkbf(l[1][2], l[1][3]);
            const bf16x8 pa = __builtin_bit_cast(bf16x8, pu);
            s16x4 vt[8][2];
#pragma unroll
            for (int db = 0; db < 8; ++db) { vt[db][0] = vtr(vb + (4 * Gq + qrow) * VSTR + (16 * db + 4 * pcol) * 2); vt[db][1] = vtr(vb + (16 + 4 * Gq + qrow) * VSTR + (16 * db + 4 * pcol) * 2); }
            __builtin_amdgcn_sched_barrier(0);
#pragma unroll
            for (int db = 0; db < 8; ++db) { const s16x4 v0 = vt[db][0], v1 = vt[db][1];
                const bf16x8 a = (bf16x8){v0[0], v0[1], v0[2], v0[3], v1[0], v1[1], v1[2], v1[3]};
                O[db] = __builtin_amdgcn_mfma_f32_16x16x32_bf16(a, pa, O[db], 0, 0, 0); }
        }
#undef DSA_LOAD
#undef DSA_RSRC
#undef DSA_UNIT
        lsum = bfly32_sum(bfly16_sum(lsum));
        const float inv = 1.0f / (lsum * 16.0f);
        if (hl < 4) { GAS bf16* op = (GAS bf16*)(AO + tok * DM + (g * 4 + hl) * HDIM + 4 * Gq);
#pragma unroll
            for (int db = 0; db < 8; ++db) { const f32x4 o = O[db] * inv; v2u w; w.x = pkbf(o[0], o[1]); w.y = pkbf(o[2], o[3]); *(GAS v2u*)(op + 16 * db) = w; } }
    }
}

__device__ __forceinline__ void swa_attn_phase(LAS unsigned char* lds, const bf16* Q, const bf16* KV, bf16* AO, const float* rel_bias, const float* sinks, int c, int G, int tid, int wave, int lane) {
    LAS unsigned char* band = lds;
    LAS float* tab = (LAS float*)(lds + 272 * 528);
    LAS float* tabM = tab + TAB_ENTRIES;
    build_bias_tab(tab, rel_bias, tid);
    for (int i = tid; i < 16 * 528 / 4; i += NWAVES * 64) ((LAS unsigned*)(band + 256 * 528))[i] = 0u;
    const int hl = lane & 15, Gq = lane >> 4, qrow = hl >> 2, pcol = lane & 3;
    for (int uid = c; uid < 512; uid += G) {
        const int b = uid >> 8, nb = (uid & 255) >> 2, g = uid & 3, bg = b * 4 + g;
        __syncthreads();
        { const int piece = tid & 31;
#pragma unroll 4
          for (int i = 0; i < 16; ++i) { const int row = (tid >> 5) + 16 * i, ka = nb * 128 - 128 + row; v4u v = (v4u){0u, 0u, 0u, 0u};
              if (ka >= 0) v = *(const GAS v4u*)(KV + ((size_t)bg * SEQ + ka) * 256 + piece * 8);
              *(LAS v4u*)(band + row * 528 + piece * 16) = v; } }
        for (int e = tid; e < 4 * 176; e += NWAVES * 64) { const int r = e / 176, rel = e - r * 176 - 31; tabM[e] = (rel >= 0 && rel < 128) ? tab[rel * 16 + g * 4 + r] * 1.4426950408889634f : -1.0e30f; }
        __syncthreads();
        const int ql = 16 * wave + hl, t = nb * 128 + ql, cbase = 16 * wave; const size_t tok = (size_t)b * SEQ + t;
        bf16x8 qn[4];
        { const GAS bf16* qs = (const GAS bf16*)(Q + tok * DM + (g * 4) * HDIM + 8 * Gq);
#pragma unroll
          for (int ks = 0; ks < 4; ++ks) qn[ks] = *(const GAS bf16x8*)(qs + ks * 32); }
#pragma unroll 1
        for (int r = 0; r < 4; ++r) {
            const int hq = g * 4 + r;
            bf16x8 qf[4];
#pragma unroll
            for (int ks = 0; ks < 4; ++ks) qf[ks] = qn[ks];
            { const GAS bf16* qs = (const GAS bf16*)(Q + tok * DM + (g * 4 + (r < 3 ? r + 1 : 3)) * HDIM + 8 * Gq);
#pragma unroll
              for (int ks = 0; ks < 4; ++ks) qn[ks] = *(const GAS bf16x8*)(qs + ks * 32); }
            f32x4 S[10];
#pragma unroll
            for (int rh = 0; rh < 2; ++rh) {
                bf16x8 ka[5][4];
#pragma unroll
                for (int r5 = 0; r5 < 5; ++r5)
#pragma unroll
                    for (int ks = 0; ks < 4; ++ks) ka[r5][ks] = *(const LAS bf16x8*)(band + (cbase + 16 * (5 * rh + r5) + hl) * 528 + (ks * 32 + 8 * Gq) * 2);
                __builtin_amdgcn_sched_barrier(0);
#pragma unroll
                for (int r5 = 0; r5 < 5; ++r5) S[5 * rh + r5] = (f32x4){0.f, 0.f, 0.f, 0.f};
#pragma unroll
                for (int ks = 0; ks < 4; ++ks)
#pragma unroll
                    for (int r5 = 0; r5 < 5; ++r5) S[5 * rh + r5] = __builtin_amdgcn_mfma_f32_16x16x32_bf16(ka[r5][ks], qf[ks], S[5 * rh + r5], 0, 0, 0);
            }
            const float sink2 = sinks[hq] * 1.4426950408889634f; float mx = sink2;
            const LAS float* tlow = tabM + r * 176 + (hl - 4 * Gq + 12);
            float bv[10][4];
#pragma unroll
            for (int rb = 0; rb < 10; ++rb)
#pragma unroll
                for (int i = 0; i < 4; ++i) bv[rb][i] = tlow[147 - 16 * rb - i];
#pragma unroll
            for (int rb = 0; rb < 10; ++rb)
#pragma unroll
                for (int i = 0; i < 4; ++i) S[rb][i] = S[rb][i] * (ATT_SCALE * 1.4426950408889634f) + bv[rb][i];
            if (nb == 0) {
#pragma unroll
                for (int rb = 0; rb < 8; ++rb) if (rb < 8 - wave) S[rb] = (f32x4){-1.0e30f, -1.0e30f, -1.0e30f, -1.0e30f};
            }
#pragma unroll
            for (int rb = 0; rb < 10; ++rb) mx = fmaxf(mx, fmaxf(fmaxf(S[rb][0], S[rb][1]), fmaxf(S[rb][2], S[rb][3])));
            mx = bfly32_max(bfly16_max(mx));
            float sum = 0.f;
#pragma unroll
            for (int rb = 0; rb < 10; ++rb)
#pragma unroll
                for (int i = 0; i < 4; ++i) { const float p = __builtin_amdgcn_exp2f(S[rb][i] - mx); S[rb][i] = p; sum += p; }
            sum = bfly32_sum(bfly16_sum(sum)); sum += __builtin_amdgcn_exp2f(sink2 - mx);
            const float inv = 1.0f / sum;
            f32x4 O[8];
#pragma unroll
            for (int db = 0; db < 8; ++db) O[db] = (f32x4){0.f, 0.f, 0.f, 0.f};
#pragma unroll
            for (int ch = 0; ch < 5; ++ch) {
                v4u pu; pu.x = pkbf(S[2 * ch][0], S[2 * ch][1]); pu.y = pkbf(S[2 * ch][2], S[2 * ch][3]); pu.z = pkbf(S[2 * ch + 1][0], S[2 * ch + 1][1]); pu.w = pkbf(S[2 * ch + 1][2], S[2 * ch + 1][3]);
                const bf16x8 pa = __builtin_bit_cast(bf16x8, pu);
                s16x4 vt[8][2];
#pragma unroll
                for (int db = 0; db < 8; ++db) { vt[db][0] = vtr(band + (cbase + 32 * ch + 4 * Gq + qrow) * 528 + 256 + (16 * db + 4 * pcol) * 2); vt[db][1] = vtr(band + (cbase + 32 * ch + 16 + 4 * Gq + qrow) * 528 + 256 + (16 * db + 4 * pcol) * 2); }
                __builtin_amdgcn_sched_barrier(0);
#pragma unroll
                for (int db = 0; db < 8; ++db) { const s16x4 v0 = vt[db][0], v1 = vt[db][1];
                    const bf16x8 a = (bf16x8){v0[0], v0[1], v0[2], v0[3], v1[0], v1[1], v1[2], v1[3]};
                    O[db] = __builtin_amdgcn_mfma_f32_16x16x32_bf16(a, pa, O[db], 0, 0, 0); }
            }
            GAS bf16* op = (GAS bf16*)(AO + tok * DM + hq * HDIM + 4 * Gq);
#pragma unroll
            for (int db = 0; db < 8; ++db) { const f32x4 o = O[db] * inv; v2u w; w.x = pkbf(o[0], o[1]); w.y = pkbf(o[2], o[3]); *(GAS v2u*)(op + 16 * db) = w; }
        }
    }
}
#ifndef REPP
#define REPP 1
#endif
#ifndef REP0
#define REP0 1
#endif
#ifndef REP1
#define REP1 1
#endif
#ifndef REP2
#define REP2 1
#endif
#ifndef REP3D
#define REP3D 1
#endif
#ifndef REP3S
#define REP3S 1
#endif
#ifndef REP4
#define REP4 1
#endif
#ifndef REP5
#define REP5 1
#endif
#ifndef REP6
#define REP6 1
#endif
#ifndef REP7
#define REP7 1
#endif
#ifndef REP8
#define REP8 1
#endif
#ifndef REP9
#define REP9 1
#endif
#ifndef REP10
#define REP10 1
#endif
#ifndef REP11
#define REP11 1
#endif
#ifndef DEFER_CONV
#define DEFER_CONV 1
#endif
#ifndef CONV_GG
#define CONV_GG 224
#endif
#ifndef NOS1
#define NOS1 0
#endif
#ifndef NOS4
#define NOS4 0
#endif
#ifndef NOS6
#define NOS6 0
#endif
#ifndef NOS7
#define NOS7 0
#endif
#ifndef NOS8
#define NOS8 0
#endif
#ifndef NOS9
#define NOS9 0
#endif
#ifndef NOS11
#define NOS11 0
#endif

constexpr int PH_FINAL = 1 + 12 * DEPTH, PH_END = PH_FINAL + 1;
struct Args { const float* in[19]; float* out; unsigned char* ws; int ph_lo, ph_hi; };
__global__ void __launch_bounds__(NWAVES * 64, 2) yoco_fwd(Args args) {
    extern __shared__ __attribute__((aligned(16))) unsigned char lds_raw[];
    LAS unsigned char* lds = (LAS unsigned char*)lds_raw;
    volatile LAS unsigned* MISC = (volatile LAS unsigned*)(lds + MISC_OFF);
    const int tid = threadIdx.x, lane = tid & 63, wave = __builtin_amdgcn_readfirstlane(tid >> 6);
    const int G = gridDim.x, bx = blockIdx.x, vcu = (G % 8 == 0) ? (bx % 8) * (G / 8) + bx / 8 : bx;
    const int gw = vcu * NWAVES + wave, NGW = G * NWAVES;
    for (int u = tid; u < 64; u += NWAVES * 64) MISC[u] = 0u;
    __syncthreads();
    gu32* ctl = (gu32*)(args.ws + WS_CTL);
    XcdBarrier bar; bar.bar = (unsigned*)ctl + CW_BAR; bar.x = 0; bar.st = nullptr;
    if (!MK_PER_PHASE) bar = xcd_barrier_post((unsigned*)ctl + CW_BAR, MISC + 8);
#define GRID_BAR() do { if (!MK_PER_PHASE) xcd_barrier(bar); } while (0)
    const int lo = args.ph_lo, hi = args.ph_hi;
#define IN(k) (lo <= (k) && (k) < hi)
#define SITE() unsigned char* wsp = args.ws; float* Xp = args.out; int bxs = blockIdx.x, Gs = gridDim.x, tids = threadIdx.x; \
    asm volatile("" : "+s"(wsp), "+s"(Xp), "+s"(bxs), "+s"(Gs), "+v"(tids)); \
    const int lanes = tids & 63, waves = __builtin_amdgcn_readfirstlane(tids >> 6); \
    const int vcus = (Gs % 8 == 0) ? (bxs % 8) * (Gs / 8) + bxs / 8 : bxs, gws = vcus * NWAVES + waves, NGWs = Gs * NWAVES; (void)lanes; (void)gws; (void)NGWs; (void)Xp; (void)wsp
#define x_in (args.in[0])
#define X (Xp)
#define XN ((bf16*)(wsp + WS_XN))
#define Qb ((bf16*)(wsp + WS_Q))
#define AOb ((bf16*)(wsp + WS_AO))
#define QIb ((bf16*)(wsp + WS_QI))
#define KIWb ((bf16*)(wsp + WS_KIW))
#define IDXb ((int*)(wsp + WS_IDX))
#define KITb ((bf16*)(wsp + WS_KIT))
#define KVA ((bf16*)(wsp + WS_KVA))
#define KVB ((bf16*)(wsp + WS_KVB))
#define Ub ((bf16*)(wsp + WS_U))
#define PEb ((bf16*)(wsp + WS_PE))
#define PB ((bf16*)(wsp + WS_PB))
#define XNB2 ((bf16*)(wsp + WS_XNB))
#define SSQ(i) ((float*)(wsp + WS_SSP) + (size_t)(i) * M * 32)
#define RTAB ((LAS float*)(lds + RTAB_OFF))

#ifndef NO_PRO
    for (int rep = 0; rep < REPP; ++rep) if (IN(0)) { SITE();
        LAS float* scr = (LAS float*)(lds + waves * 16640);
        int rot = 0;
        for (int i = 0; i < N_A; ++i) conv_matrix(args.in[2] + (size_t)i * DM * A_IN, args.in[10] + (size_t)i * DM, DM, A_IN, (bf16*)(wsp + WS_WIN) + (size_t)i * A_INP * DM, 1, scr, gws, NGWs, lanes, rot);
        const bool defer = DEFER_CONV && Gs == 256;
        for (int i = 0; i < N_A; ++i) if (!(defer && i == 1)) conv_matrix(args.in[3] + (size_t)i * DM * DM, nullptr, DM, DM, (bf16*)(wsp + WS_WOA) + (size_t)i * DM * DM, 0, scr, gws, NGWs, lanes, rot);
        for (int i = 0; i < DEPTH - N_A; ++i) conv_matrix(args.in[4] + (size_t)i * DM * DM, args.in[10] + (size_t)(N_A + i) * DM, DM, DM, (bf16*)(wsp + WS_WQB) + (size_t)i * DM * DM, 0, scr, gws, NGWs, lanes, rot);
        for (int i = 0; i < DEPTH - N_A; ++i) conv_matrix(args.in[5] + (size_t)i * DM * DM, nullptr, DM, DM, (bf16*)(wsp + WS_WOB) + (size_t)i * DM * DM, 0, scr, gws, NGWs, lanes, rot);
        conv_matrix(args.in[8], args.in[7], DM, 1024, (bf16*)(wsp + WS_WKV), 2, scr, gws, NGWs, lanes, rot);
        for (int i = 0; i < DEPTH; ++i) if (!(defer && i == 1)) conv_matrix(args.in[17] + (size_t)i * DM * DM, args.in[15] + (size_t)i * DM, DM, DM, (bf16*)(wsp + WS_WPG) + (size_t)i * DM * DM, 0, scr, gws, NGWs, lanes, rot);
        for (int i = 0; i < DEPTH; ++i) conv_matrix(args.in[16] + (size_t)i * PLE * DM, nullptr, PLE, DM, (bf16*)(wsp + WS_WPE) + (size_t)i * DM * PLE, 0, scr, gws, NGWs, lanes, rot);
        for (int i = 0; i < DEPTH; ++i) if (!(defer && (i == 1 || i == 2))) conv_matrix(args.in[12] + (size_t)i * DM * DFF, args.in[11] + (size_t)i * DM, DM, DFF, (bf16*)(wsp + WS_W13) + (size_t)i * 2 * DFF * DM, 3, scr, gws, NGWs, lanes, rot);
        for (int i = 0; i < DEPTH; ++i) if (!(defer && (i == 1 || i == 2))) conv_matrix(args.in[13] + (size_t)i * DM * DFF, args.in[11] + (size_t)i * DM, DM, DFF, (bf16*)(wsp + WS_W13) + (size_t)i * 2 * DFF * DM, 4, scr, gws, NGWs, lanes, rot);
        for (int i = 0; i < DEPTH; ++i) if (!(defer && i == 2)) conv_matrix(args.in[14] + (size_t)i * DFF * DM, nullptr, DFF, DM, (bf16*)(wsp + WS_W2) + (size_t)i * DM * DFF, 0, scr, gws, NGWs, lanes, rot);
        const size_t gt = (size_t)vcus * (NWAVES * 64) + tids, NT = (size_t)Gs * (NWAVES * 64);
        for (int i = 0; i < N_A; ++i) { GAS v4u* z = (GAS v4u*)((bf16*)(wsp + WS_WIN) + ((size_t)i * A_INP + A_IN) * DM);
            for (size_t e = gt; e < (size_t)(A_INP - A_IN) * DM / 8; e += NT) z[e] = (v4u){0u, 0u, 0u, 0u}; }
        { const GAS f32x4* ps = (const GAS f32x4*)args.in[1]; GAS v4u* pd = (GAS v4u*)PB;
          for (size_t e = gt; e < (size_t)DEPTH * M * PLE / 8; e += 4 * NT) { f32x4 a[4], b[4];
#pragma unroll
              for (int u = 0; u < 4; ++u) { a[u] = ps[2 * (e + u * NT)]; b[u] = ps[2 * (e + u * NT) + 1]; }
#pragma unroll
              for (int u = 0; u < 4; ++u) { v4u o; o.x = pk2(a[u].x, a[u].y); o.y = pk2(a[u].z, a[u].w); o.z = pk2(b[u].x, b[u].y); o.w = pk2(b[u].z, b[u].w); pd[e + u * NT] = o; } } }
        xb_phase(x_in, XNB2, SSQ(12), gws, NGWs, lanes);
        GRID_BAR();
    }
#endif

    { constexpr int L = 0;
        const int pb = 1 + 12 * L; const bool dsa = L < N_A; const int Lb = L - N_A;
        for (int rep = 0; rep < REP1; ++rep) if (IN(pb + 1) && !NOS1) { SITE();
            const bf16* Bt = dsa ? (const bf16*)(wsp + WS_WIN) + (size_t)L * A_INP * DM : (const bf16*)(wsp + WS_WQB) + (size_t)Lb * DM * DM; const int N = dsa ? A_INP : DM;
            const bool part = DEFER_CONV && dsa && Gs == 256; const int Gg = part ? CONV_GG : Gs;
            pg8::Gemm g{XNB2, Bt, M, N, DM, 1}; pg8::StaticOrder S; S.init(M, N, Gg, bxs); if (part && bxs >= Gg) S.nwg = 0;
            pg8::rs_finalize(RTAB, S, SSQ(L == 0 ? 12 : 3 * (L - 1) + 2), tids);
            pg8::EpiBf16Map E{dsa ? 1 : 0, Qb, DM, KVA, QIb, KIWb, RTAB, KITb};
            pg8::gemm_phase<pg8::EpiBf16Map, pg8::StaticOrder, true, true>(lds, g, S, E);
            if (part && rep == 0 && bxs >= Gg) {
                __syncthreads();
                LAS float* scr = (LAS float*)(lds + waves * 16640); int rot = 0; const int gw2 = (bxs - Gg) * NWAVES + waves, NGW2 = (Gs - Gg) * NWAVES; const int Ld = L + 1;
                conv_matrix(args.in[12] + (size_t)Ld * DM * DFF, args.in[11] + (size_t)Ld * DM, DM, DFF, (bf16*)(wsp + WS_W13) + (size_t)Ld * 2 * DFF * DM, 3, scr, gw2, NGW2, lanes, rot);
                conv_matrix(args.in[13] + (size_t)Ld * DM * DFF, args.in[11] + (size_t)Ld * DM, DM, DFF, (bf16*)(wsp + WS_W13) + (size_t)Ld * 2 * DFF * DM, 4, scr, gw2, NGW2, lanes, rot);
                if (L == 0) { conv_matrix(args.in[17] + (size_t)1 * DM * DM, args.in[15] + (size_t)1 * DM, DM, DM, (bf16*)(wsp + WS_WPG) + (size_t)1 * DM * DM, 0, scr, gw2, NGW2, lanes, rot);
                              conv_matrix(args.in[3] + (size_t)1 * DM * DM, nullptr, DM, DM, (bf16*)(wsp + WS_WOA) + (size_t)1 * DM * DM, 0, scr, gw2, NGW2, lanes, rot); }
                else conv_matrix(args.in[14] + (size_t)2 * DFF * DM, nullptr, DFF, DM, (bf16*)(wsp + WS_W2) + (size_t)2 * DM * DFF, 0, scr, gw2, NGW2, lanes, rot);
            }
            GRID_BAR();
        }
#ifndef NO_IDX
        for (int rep = 0; rep < REP2; ++rep) if (dsa && IN(pb + 2)) { SITE(); indexer_phase(lds, QIb, KIWb, KITb, IDXb, bxs, Gs, tids, waves, lanes); GRID_BAR(); }
#endif
        for (int rep = 0; rep < (dsa ? REP3D : REP3S); ++rep) if (IN(pb + 3)) { SITE();
#ifndef NO_DSA
            if (dsa) dsa_attn_phase(lds, Qb, (const unsigned char*)KVA, IDXb, AOb, args.in[9], bxs, Gs, tids, waves, lanes);
#endif
#ifndef NO_SWA
            if (!dsa) swa_attn_phase(lds, Qb, KVB, AOb, args.in[9], args.in[6] + (size_t)Lb * NHEAD, bxs, Gs, tids, waves, lanes);
#endif
            GRID_BAR();
        }
        for (int rep = 0; rep < REP4; ++rep) if (IN(pb + 4) && !NOS4) { SITE();
            const bf16* Bt = dsa ? (const bf16*)(wsp + WS_WOA) + (size_t)L * DM * DM : (const bf16*)(wsp + WS_WOB) + (size_t)Lb * DM * DM;
            pg8::Gemm g{AOb, Bt, M, DM, DM}; pg8::StaticOrder S; S.init(M, DM, Gs, bxs);
            pg8::EpiResid E{XNB2, rep ? Qb : XN, rep ? (float*)(wsp + WS_QI) : SSQ(3 * L)};
            pg8::gemm_phase<pg8::EpiResid, pg8::StaticOrder, true, true>(lds, g, S, E);
            GRID_BAR();
        }
        for (int rep = 0; rep < REP6; ++rep) if (IN(pb + 6) && !NOS6) { SITE();
            pg8::Gemm g{XN, (const bf16*)(wsp + WS_W13) + (size_t)L * 2 * DFF * DM, M, 2 * DFF, DM, 1}; pg8::StaticOrder S; S.init(M, 2 * DFF, Gs, bxs);
            pg8::rs_finalize(RTAB, S, SSQ(3 * L), tids);
            pg8::EpiSwiglu E{Ub, RTAB};
            pg8::gemm_phase<pg8::EpiSwiglu, pg8::StaticOrder, true, true>(lds, g, S, E);
            GRID_BAR();
        }
        for (int rep = 0; rep < REP7; ++rep) if (IN(pb + 7) && !NOS7) { SITE();
            { pg8::Gemm g{Ub, (const bf16*)(wsp + WS_W2) + (size_t)L * DM * DFF, M, DM, DFF, 1}; pg8::StaticOrder S; S.init(M, DM, Gs, bxs);
              pg8::EpiResid E{XN, rep ? XNB2 : XN, rep ? SSQ(3 * L + 2) : SSQ(3 * L + 1)};
              pg8::gemm_phase<pg8::EpiResid, pg8::StaticOrder, true, true>(lds, g, S, E); }
            { pg8::Gemm g{PB + (size_t)L * M * PLE, (const bf16*)(wsp + WS_WPE) + (size_t)L * DM * PLE, M, DM, PLE}; pg8::StaticOrder S; S.init(M, DM, Gs, bxs);
              pg8::EpiBf16Map E{3, PEb, DM, nullptr, nullptr, nullptr, nullptr, nullptr};
              pg8::gemm_phase<pg8::EpiBf16Map, pg8::StaticOrder, true, true>(lds, g, S, E); }
            GRID_BAR();
        }
        for (int rep = 0; rep < REP9; ++rep) if (IN(pb + 9) && !NOS9) { SITE();
            pg8::Gemm g{XN, (const bf16*)(wsp + WS_WPG) + (size_t)L * DM * DM, M, DM, DM, 1}; pg8::StaticOrder S; S.init(M, DM, Gs, bxs);
            pg8::rs_finalize(RTAB, S, SSQ(3 * L + 1), tids);
            pg8::EpiGate E{XN, PEb, RTAB, rep ? Qb : XNB2, rep ? (float*)(wsp + WS_QI) : SSQ(3 * L + 2)};
            pg8::gemm_phase<pg8::EpiGate, pg8::StaticOrder, true, true>(lds, g, S, E);
            GRID_BAR();
        }
        if (L == N_A - 1) {
            for (int rep = 0; rep < REP11; ++rep) if (IN(pb + 11) && !NOS11) { SITE();
                pg8::Gemm g{XNB2, (const bf16*)(wsp + WS_WKV), M, 1024, DM, 1}; pg8::StaticOrder S; S.init(M, 1024, Gs, bxs);
                pg8::rs_finalize(RTAB, S, SSQ(3 * L + 2), tids);
                pg8::EpiBf16Map E{2, nullptr, 0, KVB, nullptr, nullptr, RTAB, nullptr};
                pg8::gemm_phase<pg8::EpiBf16Map, pg8::StaticOrder, true, true>(lds, g, S, E);
                GRID_BAR();
            }
        }
        }
    { constexpr int L = 1;
        const int pb = 1 + 12 * L; const bool dsa = L < N_A; const int Lb = L - N_A;
        for (int rep = 0; rep < REP1; ++rep) if (IN(pb + 1) && !NOS1) { SITE();
            const bf16* Bt = dsa ? (const bf16*)(wsp + WS_WIN) + (size_t)L * A_INP * DM : (const bf16*)(wsp + WS_WQB) + (size_t)Lb * DM * DM; const int N = dsa ? A_INP : DM;
            const bool part = DEFER_CONV && dsa && Gs == 256; const int Gg = part ? CONV_GG : Gs;
            pg8::Gemm g{XNB2, Bt, M, N, DM, 1}; pg8::StaticOrder S; S.init(M, N, Gg, bxs); if (part && bxs >= Gg) S.nwg = 0;
            pg8::rs_finalize(RTAB, S, SSQ(L == 0 ? 12 : 3 * (L - 1) + 2), tids);
            pg8::EpiBf16Map E{dsa ? 1 : 0, Qb, DM, KVA, QIb, KIWb, RTAB, KITb};
            pg8::gemm_phase<pg8::EpiBf16Map, pg8::StaticOrder, true, true>(lds, g, S, E);
            if (part && rep == 0 && bxs >= Gg) {
                __syncthreads();
                LAS float* scr = (LAS float*)(lds + waves * 16640); int rot = 0; const int gw2 = (bxs - Gg) * NWAVES + waves, NGW2 = (Gs - Gg) * NWAVES; const int Ld = L + 1;
                conv_matrix(args.in[12] + (size_t)Ld * DM * DFF, args.in[11] + (size_t)Ld * DM, DM, DFF, (bf16*)(wsp + WS_W13) + (size_t)Ld * 2 * DFF * DM, 3, scr, gw2, NGW2, lanes, rot);
                conv_matrix(args.in[13] + (size_t)Ld * DM * DFF, args.in[11] + (size_t)Ld * DM, DM, DFF, (bf16*)(wsp + WS_W13) + (size_t)Ld * 2 * DFF * DM, 4, scr, gw2, NGW2, lanes, rot);
                if (L == 0) { conv_matrix(args.in[17] + (size_t)1 * DM * DM, args.in[15] + (size_t)1 * DM, DM, DM, (bf16*)(wsp + WS_WPG) + (size_t)1 * DM * DM, 0, scr, gw2, NGW2, lanes, rot);
                              conv_matrix(args.in[3] + (size_t)1 * DM * DM, nullptr, DM, DM, (bf16*)(wsp + WS_WOA) + (size_t)1 * DM * DM, 0, scr, gw2, NGW2, lanes, rot); }
                else conv_matrix(args.in[14] + (size_t)2 * DFF * DM, nullptr, DFF, DM, (bf16*)(wsp + WS_W2) + (size_t)2 * DM * DFF, 0, scr, gw2, NGW2, lanes, rot);
            }
            GRID_BAR();
        }
#ifndef NO_IDX
        for (int rep = 0; rep < REP2; ++rep) if (dsa && IN(pb + 2)) { SITE(); indexer_phase(lds, QIb, KIWb, KITb, IDXb, bxs, Gs, tids, waves, lanes); GRID_BAR(); }
#endif
        for (int rep = 0; rep < (dsa ? REP3D : REP3S); ++rep) if (IN(pb + 3)) { SITE();
#ifndef NO_DSA
            if (dsa) dsa_attn_phase(lds, Qb, (const unsigned char*)KVA, IDXb, AOb, args.in[9], bxs, Gs, tids, waves, lanes);
#endif
#ifndef NO_SWA
            if (!dsa) swa_attn_phase(lds, Qb, KVB, AOb, args.in[9], args.in[6] + (size_t)Lb * NHEAD, bxs, Gs, tids, waves, lanes);
#endif
            GRID_BAR();
        }
        for (int rep = 0; rep < REP4; ++rep) if (IN(pb + 4) && !NOS4) { SITE();
            const bf16* Bt = dsa ? (const bf16*)(wsp + WS_WOA) + (size_t)L * DM * DM : (const bf16*)(wsp + WS_WOB) + (size_t)Lb * DM * DM;
            pg8::Gemm g{AOb, Bt, M, DM, DM}; pg8::StaticOrder S; S.init(M, DM, Gs, bxs);
            pg8::EpiResid E{XNB2, rep ? Qb : XN, rep ? (float*)(wsp + WS_QI) : SSQ(3 * L)};
            pg8::gemm_phase<pg8::EpiResid, pg8::StaticOrder, true, true>(lds, g, S, E);
            GRID_BAR();
        }
        for (int rep = 0; rep < REP6; ++rep) if (IN(pb + 6) && !NOS6) { SITE();
            pg8::Gemm g{XN, (const bf16*)(wsp + WS_W13) + (size_t)L * 2 * DFF * DM, M, 2 * DFF, DM, 1}; pg8::StaticOrder S; S.init(M, 2 * DFF, Gs, bxs);
            pg8::rs_finalize(RTAB, S, SSQ(3 * L), tids);
            pg8::EpiSwiglu E{Ub, RTAB};
            pg8::gemm_phase<pg8::EpiSwiglu, pg8::StaticOrder, true, true>(lds, g, S, E);
            GRID_BAR();
        }
        for (int rep = 0; rep < REP7; ++rep) if (IN(pb + 7) && !NOS7) { SITE();
            { pg8::Gemm g{Ub, (const bf16*)(wsp + WS_W2) + (size_t)L * DM * DFF, M, DM, DFF, 1}; pg8::StaticOrder S; S.init(M, DM, Gs, bxs);
              pg8::EpiResid E{XN, rep ? XNB2 : XN, rep ? SSQ(3 * L + 2) : SSQ(3 * L + 1)};
              pg8::gemm_phase<pg8::EpiResid, pg8::StaticOrder, true, true>(lds, g, S, E); }
            { pg8::Gemm g{PB + (size_t)L * M * PLE, (const bf16*)(wsp + WS_WPE) + (size_t)L * DM * PLE, M, DM, PLE}; pg8::StaticOrder S; S.init(M, DM, Gs, bxs);
              pg8::EpiBf16Map E{3, PEb, DM, nullptr, nullptr, nullptr, nullptr, nullptr};
              pg8::gemm_phase<pg8::EpiBf16Map, pg8::StaticOrder, true, true>(lds, g, S, E); }
            GRID_BAR();
        }
        for (int rep = 0; rep < REP9; ++rep) if (IN(pb + 9) && !NOS9) { SITE();
            pg8::Gemm g{XN, (const bf16*)(wsp + WS_WPG) + (size_t)L * DM * DM, M, DM, DM, 1}; pg8::StaticOrder S; S.init(M, DM, Gs, bxs);
            pg8::rs_finalize(RTAB, S, SSQ(3 * L + 1), tids);
            pg8::EpiGate E{XN, PEb, RTAB, rep ? Qb : XNB2, rep ? (float*)(wsp + WS_QI) : SSQ(3 * L + 2)};
            pg8::gemm_phase<pg8::EpiGate, pg8::StaticOrder, true, true>(lds, g, S, E);
            GRID_BAR();
        }
        if (L == N_A - 1) {
            for (int rep = 0; rep < REP11; ++rep) if (IN(pb + 11) && !NOS11) { SITE();
                pg8::Gemm g{XNB2, (const bf16*)(wsp + WS_WKV), M, 1024, DM, 1}; pg8::StaticOrder S; S.init(M, 1024, Gs, bxs);
                pg8::rs_finalize(RTAB, S, SSQ(3 * L + 2), tids);
                pg8::EpiBf16Map E{2, nullptr, 0, KVB, nullptr, nullptr, RTAB, nullptr};
                pg8::gemm_phase<pg8::EpiBf16Map, pg8::StaticOrder, true, true>(lds, g, S, E);
                GRID_BAR();
            }
        }
        }
    { constexpr int L = 2;
        const int pb = 1 + 12 * L; const bool dsa = L < N_A; const int Lb = L - N_A;
        for (int rep = 0; rep < REP1; ++rep) if (IN(pb + 1) && !NOS1) { SITE();
            const bf16* Bt = dsa ? (const bf16*)(wsp + WS_WIN) + (size_t)L * A_INP * DM : (const bf16*)(wsp + WS_WQB) + (size_t)Lb * DM * DM; const int N = dsa ? A_INP : DM;
            const bool part = DEFER_CONV && dsa && Gs == 256; const int Gg = part ? CONV_GG : Gs;
            pg8::Gemm g{XNB2, Bt, M, N, DM, 1}; pg8::StaticOrder S; S.init(M, N, Gg, bxs); if (part && bxs >= Gg) S.nwg = 0;
            pg8::rs_finalize(RTAB, S, SSQ(L == 0 ? 12 : 3 * (L - 1) + 2), tids);
            pg8::EpiBf16Map E{dsa ? 1 : 0, Qb, DM, KVA, QIb, KIWb, RTAB, KITb};
            pg8::gemm_phase<pg8::EpiBf16Map, pg8::StaticOrder, true, true>(lds, g, S, E);
            if (part && rep == 0 && bxs >= Gg) {
                __syncthreads();
                LAS float* scr = (LAS float*)(lds + waves * 16640); int rot = 0; const int gw2 = (bxs - Gg) * NWAVES + waves, NGW2 = (Gs - Gg) * NWAVES; const int Ld = L + 1;
                conv_matrix(args.in[12] + (size_t)Ld * DM * DFF, args.in[11] + (size_t)Ld * DM, DM, DFF, (bf16*)(wsp + WS_W13) + (size_t)Ld * 2 * DFF * DM, 3, scr, gw2, NGW2, lanes, rot);
                conv_matrix(args.in[13] + (size_t)Ld * DM * DFF, args.in[11] + (size_t)Ld * DM, DM, DFF, (bf16*)(wsp + WS_W13) + (size_t)Ld * 2 * DFF * DM, 4, scr, gw2, NGW2, lanes, rot);
                if (L == 0) { conv_matrix(args.in[17] + (size_t)1 * DM * DM, args.in[15] + (size_t)1 * DM, DM, DM, (bf16*)(wsp + WS_WPG) + (size_t)1 * DM * DM, 0, scr, gw2, NGW2, lanes, rot);
                              conv_matrix(args.in[3] + (size_t)1 * DM * DM, nullptr, DM, DM, (bf16*)(wsp + WS_WOA) + (size_t)1 * DM * DM, 0, scr, gw2, NGW2, lanes, rot); }
                else conv_matrix(args.in[14] + (size_t)2 * DFF * DM, nullptr, DFF, DM, (bf16*)(wsp + WS_W2) + (size_t)2 * DM * DFF, 0, scr, gw2, NGW2, lanes, rot);
            }
            GRID_BAR();
        }
#ifndef NO_IDX
        for (int rep = 0; rep < REP2; ++rep) if (dsa && IN(pb + 2)) { SITE(); indexer_phase(lds, QIb, KIWb, KITb, IDXb, bxs, Gs, tids, waves, lanes); GRID_BAR(); }
#endif
        for (int rep = 0; rep < (dsa ? REP3D : REP3S); ++rep) if (IN(pb + 3)) { SITE();
#ifndef NO_DSA
            if (dsa) dsa_attn_phase(lds, Qb, (const unsigned char*)KVA, IDXb, AOb, args.in[9], bxs, Gs, tids, waves, lanes);
#endif
#ifndef NO_SWA
            if (!dsa) swa_attn_phase(lds, Qb, KVB, AOb, args.in[9], args.in[6] + (size_t)Lb * NHEAD, bxs, Gs, tids, waves, lanes);
#endif
            GRID_BAR();
        }
        for (int rep = 0; rep < REP4; ++rep) if (IN(pb + 4) && !NOS4) { SITE();
            const bf16* Bt = dsa ? (const bf16*)(wsp + WS_WOA) + (size_t)L * DM * DM : (const bf16*)(wsp + WS_WOB) + (size_t)Lb * DM * DM;
            pg8::Gemm g{AOb, Bt, M, DM, DM}; pg8::StaticOrder S; S.init(M, DM, Gs, bxs);
            pg8::EpiResid E{XNB2, rep ? Qb : XN, rep ? (float*)(wsp + WS_QI) : SSQ(3 * L)};
            pg8::gemm_phase<pg8::EpiResid, pg8::StaticOrder, true, true>(lds, g, S, E);
            GRID_BAR();
        }
        for (int rep = 0; rep < REP6; ++rep) if (IN(pb + 6) && !NOS6) { SITE();
            pg8::Gemm g{XN, (const bf16*)(wsp + WS_W13) + (size_t)L * 2 * DFF * DM, M, 2 * DFF, DM, 1}; pg8::StaticOrder S; S.init(M, 2 * DFF, Gs, bxs);
            pg8::rs_finalize(RTAB, S, SSQ(3 * L), tids);
            pg8::EpiSwiglu E{Ub, RTAB};
            pg8::gemm_phase<pg8::EpiSwiglu, pg8::StaticOrder, true, true>(lds, g, S, E);
            GRID_BAR();
        }
        for (int rep = 0; rep < REP7; ++rep) if (IN(pb + 7) && !NOS7) { SITE();
            { pg8::Gemm g{Ub, (const bf16*)(wsp + WS_W2) + (size_t)L * DM * DFF, M, DM, DFF, 1}; pg8::StaticOrder S; S.init(M, DM, Gs, bxs);
              pg8::EpiResid E{XN, rep ? XNB2 : XN, rep ? SSQ(3 * L + 2) : SSQ(3 * L + 1)};
              pg8::gemm_phase<pg8::EpiResid, pg8::StaticOrder, true, true>(lds, g, S, E); }
            { pg8::Gemm g{PB + (size_t)L * M * PLE, (const bf16*)(wsp + WS_WPE) + (size_t)L * DM * PLE, M, DM, PLE}; pg8::StaticOrder S; S.init(M, DM, Gs, bxs);
              pg8::EpiBf16Map E{3, PEb, DM, nullptr, nullptr, nullptr, nullptr, nullptr};
              pg8::gemm_phase<pg8::EpiBf16Map, pg8::StaticOrder, true, true>(lds, g, S, E); }
            GRID_BAR();
        }
        for (int rep = 0; rep < REP9; ++rep) if (IN(pb + 9) && !NOS9) { SITE();
            pg8::Gemm g{XN, (const bf16*)(wsp + WS_WPG) + (size_t)L * DM * DM, M, DM, DM, 1}; pg8::StaticOrder S; S.init(M, DM, Gs, bxs);
            pg8::rs_finalize(RTAB, S, SSQ(3 * L + 1), tids);
            pg8::EpiGate E{XN, PEb, RTAB, rep ? Qb : XNB2, rep ? (float*)(wsp + WS_QI) : SSQ(3 * L + 2)};
            pg8::gemm_phase<pg8::EpiGate, pg8::StaticOrder, true, true>(lds, g, S, E);
            GRID_BAR();
        }
        if (L == N_A - 1) {
            for (int rep = 0; rep < REP11; ++rep) if (IN(pb + 11) && !NOS11) { SITE();
                pg8::Gemm g{XNB2, (const bf16*)(wsp + WS_WKV), M, 1024, DM, 1}; pg8::StaticOrder S; S.init(M, 1024, Gs, bxs);
                pg8::rs_finalize(RTAB, S, SSQ(3 * L + 2), tids);
                pg8::EpiBf16Map E{2, nullptr, 0, KVB, nullptr, nullptr, RTAB, nullptr};
                pg8::gemm_phase<pg8::EpiBf16Map, pg8::StaticOrder, true, true>(lds, g, S, E);
                GRID_BAR();
            }
        }
        }
    { constexpr int L = 3;
        const int pb = 1 + 12 * L; const bool dsa = L < N_A; const int Lb = L - N_A;
        for (int rep = 0; rep < REP1; ++rep) if (IN(pb + 1) && !NOS1) { SITE();
            const bf16* Bt = dsa ? (const bf16*)(wsp + WS_WIN) + (size_t)L * A_INP * DM : (const bf16*)(wsp + WS_WQB) + (size_t)Lb * DM * DM; const int N = dsa ? A_INP : DM;
            const bool part = DEFER_CONV && dsa && Gs == 256; const int Gg = part ? CONV_GG : Gs;
            pg8::Gemm g{XNB2, Bt, M, N, DM, 1}; pg8::StaticOrder S; S.init(M, N, Gg, bxs); if (part && bxs >= Gg) S.nwg = 0;
            pg8::rs_finalize(RTAB, S, SSQ(L == 0 ? 12 : 3 * (L - 1) + 2), tids);
            pg8::EpiBf16Map E{dsa ? 1 : 0, Qb, DM, KVA, QIb, KIWb, RTAB, KITb};
            pg8::gemm_phase<pg8::EpiBf16Map, pg8::StaticOrder, true, true>(lds, g, S, E);
            if (part && rep == 0 && bxs >= Gg) {
                __syncthreads();
                LAS float* scr = (LAS float*)(lds + waves * 16640); int rot = 0; const int gw2 = (bxs - Gg) * NWAVES + waves, NGW2 = (Gs - Gg) * NWAVES; const int Ld = L + 1;
                conv_matrix(args.in[12] + (size_t)Ld * DM * DFF, args.in[11] + (size_t)Ld * DM, DM, DFF, (bf16*)(wsp + WS_W13) + (size_t)Ld * 2 * DFF * DM, 3, scr, gw2, NGW2, lanes, rot);
                conv_matrix(args.in[13] + (size_t)Ld * DM * DFF, args.in[11] + (size_t)Ld * DM, DM, DFF, (bf16*)(wsp + WS_W13) + (size_t)Ld * 2 * DFF * DM, 4, scr, gw2, NGW2, lanes, rot);
                if (L == 0) { conv_matrix(args.in[17] + (size_t)1 * DM * DM, args.in[15] + (size_t)1 * DM, DM, DM, (bf16*)(wsp + WS_WPG) + (size_t)1 * DM * DM, 0, scr, gw2, NGW2, lanes, rot);
                              conv_matrix(args.in[3] + (size_t)1 * DM * DM, nullptr, DM, DM, (bf16*)(wsp + WS_WOA) + (size_t)1 * DM * DM, 0, scr, gw2, NGW2, lanes, rot); }
                else conv_matrix(args.in[14] + (size_t)2 * DFF * DM, nullptr, DFF, DM, (bf16*)(wsp + WS_W2) + (size_t)2 * DM * DFF, 0, scr, gw2, NGW2, lanes, rot);
            }
            GRID_BAR();
        }
#ifndef NO_IDX
        for (int rep = 0; rep < REP2; ++rep) if (dsa && IN(pb + 2)) { SITE(); indexer_phase(lds, QIb, KIWb, KITb, IDXb, bxs, Gs, tids, waves, lanes); GRID_BAR(); }
#endif
        for (int rep = 0; rep < (dsa ? REP3D : REP3S); ++rep) if (IN(pb + 3)) { SITE();
#ifndef NO_DSA
            if (dsa) dsa_attn_phase(lds, Qb, (const unsigned char*)KVA, IDXb, AOb, args.in[9], bxs, Gs, tids, waves, lanes);
#endif
#ifndef NO_SWA
            if (!dsa) swa_attn_phase(lds, Qb, KVB, AOb, args.in[9], args.in[6] + (size_t)Lb * NHEAD, bxs, Gs, tids, waves, lanes);
#endif
            GRID_BAR();
        }
        for (int rep = 0; rep < REP4; ++rep) if (IN(pb + 4) && !NOS4) { SITE();
            const bf16* Bt = dsa ? (const bf16*)(wsp + WS_WOA) + (size_t)L * DM * DM : (const bf16*)(wsp + WS_WOB) + (size_t)Lb * DM * DM;
            pg8::Gemm g{AOb, Bt, M, DM, DM}; pg8::StaticOrder S; S.init(M, DM, Gs, bxs);
            pg8::EpiResid E{XNB2, rep ? Qb : XN, rep ? (float*)(wsp + WS_QI) : SSQ(3 * L)};
            pg8::gemm_phase<pg8::EpiResid, pg8::StaticOrder, true, true>(lds, g, S, E);
            GRID_BAR();
        }
        for (int rep = 0; rep < REP6; ++rep) if (IN(pb + 6) && !NOS6) { SITE();
            pg8::Gemm g{XN, (const bf16*)(wsp + WS_W13) + (size_t)L * 2 * DFF * DM, M, 2 * DFF, DM, 1}; pg8::StaticOrder S; S.init(M, 2 * DFF, Gs, bxs);
            pg8::rs_finalize(RTAB, S, SSQ(3 * L), tids);
            pg8::EpiSwiglu E{Ub, RTAB};
            pg8::gemm_phase<pg8::EpiSwiglu, pg8::StaticOrder, true, true>(lds, g, S, E);
            GRID_BAR();
        }
        for (int rep = 0; rep < REP7; ++rep) if (IN(pb + 7) && !NOS7) { SITE();
            { pg8::Gemm g{Ub, (const bf16*)(wsp + WS_W2) + (size_t)L * DM * DFF, M, DM, DFF, 1}; pg8::StaticOrder S; S.init(M, DM, Gs, bxs);
              pg8::EpiResid E{XN, rep ? XNB2 : XN, rep ? SSQ(3 * L + 2) : SSQ(3 * L + 1)};
              pg8::gemm_phase<pg8::EpiResid, pg8::StaticOrder, true, true>(lds, g, S, E); }
            { pg8::Gemm g{PB + (size_t)L * M * PLE, (const bf16*)(wsp + WS_WPE) + (size_t)L * DM * PLE, M, DM, PLE}; pg8::StaticOrder S; S.init(M, DM, Gs, bxs);
              pg8::EpiBf16Map E{3, PEb, DM, nullptr, nullptr, nullptr, nullptr, nullptr};
              pg8::gemm_phase<pg8::EpiBf16Map, pg8::StaticOrder, true, true>(lds, g, S, E); }
            GRID_BAR();
        }
        for (int rep = 0; rep < REP9; ++rep) if (IN(pb + 9) && !NOS9) { SITE();
            pg8::Gemm g{XN, (const bf16*)(wsp + WS_WPG) + (size_t)L * DM * DM, M, DM, DM, 1}; pg8::StaticOrder S; S.init(M, DM, Gs, bxs);
            pg8::rs_finalize(RTAB, S, SSQ(3 * L + 1), tids);
            pg8::EpiGate E{XN, PEb, RTAB, rep ? Qb : XNB2, rep ? (float*)(wsp + WS_QI) : SSQ(3 * L + 2)};
            pg8::gemm_phase<pg8::EpiGate, pg8::StaticOrder, true, true>(lds, g, S, E);
            GRID_BAR();
        }
        if (L == N_A - 1) {
            for (int rep = 0; rep < REP11; ++rep) if (IN(pb + 11) && !NOS11) { SITE();
                pg8::Gemm g{XNB2, (const bf16*)(wsp + WS_WKV), M, 1024, DM, 1}; pg8::StaticOrder S; S.init(M, 1024, Gs, bxs);
                pg8::rs_finalize(RTAB, S, SSQ(3 * L + 2), tids);
                pg8::EpiBf16Map E{2, nullptr, 0, KVB, nullptr, nullptr, RTAB, nullptr};
                pg8::gemm_phase<pg8::EpiBf16Map, pg8::StaticOrder, true, true>(lds, g, S, E);
                GRID_BAR();
            }
        }
        }

    if (IN(PH_FINAL)) { SITE(); final_norm_phase(XNB2, args.in[18], X, gws, NGWs, lanes); }
#undef IN
#undef SITE
#undef GRID_BAR
#undef x_in
#undef X
#undef XN
#undef Qb
#undef AOb
#undef QIb
#undef KIWb
#undef IDXb
#undef KITb
#undef KVA
#undef KVB
#undef Ub
#undef PEb
#undef PB
#undef XNB2
#undef SSQ
#undef RTAB
}

static bool phase_exists(int p) {
    if (p == 0 || p == PH_FINAL) return true;
    if (p < 0 || p > PH_FINAL) return false;
    const int L = (p - 1) / 12, s = (p - 1) % 12;
    if (s == 0 || s == 5 || s == 8 || s == 10) return false;
    if (s == 2) return L < N_A;
    if (s == 11) return L == N_A - 1;
    return true;
}
extern "C" void kernel_launch(void* const* d_in, const int* in_sizes, int n_in, void* d_out, int out_size, void* d_ws, size_t ws_size, hipStream_t stream) {
    static int grid = 0;
    if (grid == 0) {
        if (n_in != 19 || in_sizes[0] != M * DM || out_size != M * DM || ws_size < WS_END) { fprintf(stderr, "kernel_launch: shape/workspace mismatch (n_in %d, in0 %d, out %d, ws %zu, need %zu); nothing launched\n", n_in, n_in > 0 ? in_sizes[0] : -1, out_size, ws_size, (size_t)WS_END); grid = -1; return; }
        int dev = 0, cus = 0, per_cu = 0;
        if (hipGetDevice(&dev) != hipSuccess || hipDeviceGetAttribute(&cus, hipDeviceAttributeMultiprocessorCount, dev) != hipSuccess) { fprintf(stderr, "kernel_launch: device query failed\n"); grid = -1; return; }
        if (hipFuncSetAttribute((const void*)yoco_fwd, hipFuncAttributeMaxDynamicSharedMemorySize, LDS_BYTES) != hipSuccess) { fprintf(stderr, "kernel_launch: hipFuncSetAttribute failed\n"); grid = -1; return; }
        if (hipOccupancyMaxActiveBlocksPerMultiprocessor(&per_cu, (const void*)yoco_fwd, NWAVES * 64, LDS_BYTES) != hipSuccess || per_cu < 1) fprintf(stderr, "kernel_launch: note: occupancy query reports %d workgroups per CU\n", per_cu);
        (void)hipGetLastError();
        grid = cus;
    }
    if (grid < 0) return;
    if (hipMemsetAsync((char*)d_ws + WS_CTL, 0, CTL_ZERO_BYTES, stream) != hipSuccess) { fprintf(stderr, "kernel_launch: memset failed\n"); return; }
    Args a{};
    for (int i = 0; i < 19; ++i) a.in[i] = (const float*)d_in[i];
    a.out = (float*)d_out; a.ws = (unsigned char*)d_ws;
#if MK_PER_PHASE
    for (int p = 0; p < PH_END; ++p) { if (!phase_exists(p)) continue; a.ph_lo = p; a.ph_hi = p + 1;
        hipLaunchKernelGGL(yoco_fwd, dim3(grid), dim3(NWAVES * 64), LDS_BYTES, stream, a); }
#else
    a.ph_lo = 0; a.ph_hi = PH_END;
    hipLaunchKernelGGL(yoco_fwd, dim3(grid), dim3(NWAVES * 64), LDS_BYTES, stream, a);
#endif
    const hipError_t le = hipPeekAtLastError();
    if (le != hipSuccess) fprintf(stderr, "kernel_launch: launch failed: %s\n", hipGetErrorName(le));
}
```

```cpp
#include <hip/hip_runtime.h>
#include <cstdio>
#include <cstdint>
#ifndef MK_PER_PHASE
#define MK_PER_PHASE 0
#endif
namespace pg8 {
#define PG8_LAS __attribute__((address_space(3)))
typedef unsigned short bf16_t;
typedef short bf16x8 __attribute__((ext_vector_type(8)));
typedef float f32x4 __attribute__((ext_vector_type(4)));
typedef unsigned u32x4 __attribute__((ext_vector_type(4)));
constexpr int BM = 256, BK = 64, HALF = 128, HTB = HALF * BK * 2  , STAGE_BYTES = 8 * HTB, NXCD = 8, WGM = 8;

__host__ __device__ __forceinline__ int lds_byte(int r, int c) { const int st = (r >> 4) * 2 + (c >> 5), rr = r & 15, cc = c & 31, ob = rr * 64 + cc * 2; return st * 1024 + (ob ^ (((ob >> 9) & 1) << 5)); }
__host__ __device__ __forceinline__ void stage_rc(int b, int& R, int& C) { const int st = b / 1024, sb = b % 1024, swz = sb ^ (((sb >> 9) & 1) << 5); R = (st >> 1) * 16 + swz / 64; C = (st & 1) * 32 + (swz % 64) / 2; }
__host__ __device__ __forceinline__ int perm32(int rho) { const int n = rho >> 4, i = rho & 15; return 8 * (i >> 2) + 4 * n + (i & 3); }

struct Unit { int pm, pn, ord; };
struct Gemm { const bf16_t* A; const bf16_t* Bt; int M, N, K; int tiledA; };

struct StaticOrder {
    int nM, nN, nwg, G, c;
    __host__ __device__ void init(int M, int N, int G_, int c_) { nM = M / BM; nN = N / BM; nwg = nM * nN; G = G_; c = c_; }
    __host__ __device__ bool next(int i, Unit& u) const {
        const long L = (long)i * G + c; if (L >= nwg) return false;
        int wgid = (int)L; { const int q = nwg / NXCD, r = nwg % NXCD, xcd = wgid % NXCD, off = wgid / NXCD; wgid = (xcd < r ? xcd * (q + 1) : r * (q + 1) + (xcd - r) * q) + off; }
        const int nig = WGM * nN, gid = wgid / nig, fm = gid * WGM, gsz = (nM - fm) < WGM ? (nM - fm) : WGM;
        u.pm = fm + ((wgid % nig) % gsz); u.pn = (wgid % nig) / gsz; u.ord = i; return true;
    }
    __device__ __forceinline__ void a_ready(const Unit&) const {}
    __device__ __forceinline__ void done(const Unit&) const {}
};

__device__ __forceinline__ unsigned cvt_pk_bf16(float lo, float hi) { unsigned r; asm volatile("v_cvt_pk_bf16_f32 %0, %1, %2" : "=v"(r) : "v"(lo), "v"(hi)); return r; }
#define PG8_GAS __attribute__((address_space(1)))

__device__ __forceinline__ float fast_sigmoid(float a) { return __builtin_amdgcn_rcpf(1.0f + __builtin_amdgcn_exp2f(-1.4426950408889634f * a)); }

__device__ __forceinline__ void row_scales(const PG8_LAS float* rtab, const Unit& u, int wr, int fr, float (&r)[2][4]) {
#pragma unroll
    for (int ai = 0; ai < 2; ++ai)
#pragma unroll
        for (int m = 0; m < 4; ++m) r[ai][m] = rtab ? rtab[u.ord * BM + ai * HALF + wr * 64 + m * 16 + fr] : 1.0f;
}
template <class Sched> __device__ __forceinline__ void rs_finalize(PG8_LAS float* rtab, const Sched& S, const float* ssp, int tid) {
    const int row = tid >> 1, h = tid & 1;
    for (int i0 = 0; ; i0 += 4) {
        Unit u[4]; bool ok[4]; f32x4 v[4][4];
#pragma unroll
        for (int j = 0; j < 4; ++j) { ok[j] = S.next(i0 + j, u[j]); if (!ok[j]) u[j].pm = 0; }
        if (!ok[0]) break;
#pragma unroll
        for (int j = 0; j < 4; ++j) { const PG8_GAS f32x4* p = (const PG8_GAS f32x4*)(ssp + ((size_t)(u[j].pm * BM + row)) * 32 + h * 16);
#pragma unroll
            for (int e = 0; e < 4; ++e) v[j][e] = p[e]; }
#pragma unroll
        for (int j = 0; j < 4; ++j) { const f32x4 a = v[j][0], b = v[j][1], c = v[j][2], d = v[j][3];
            const float s = (((a[0] + a[1]) + (a[2] + a[3])) + ((b[0] + b[1]) + (b[2] + b[3]))) + (((c[0] + c[1]) + (c[2] + c[3])) + ((d[0] + d[1]) + (d[2] + d[3])));
            const float o = __shfl_xor(s, 1); const float tot = h ? (o + s) : (s + o);
            if (h == 0 && ok[j]) rtab[(i0 + j) * BM + row] = __builtin_amdgcn_rsqf(tot * (1.0f / 2048.0f) + 1e-6f); }
    }
    __syncthreads();
}
struct EpiBf16Map {
    static constexpr bool PERM = true, AFTER_DRAIN = false;
    int kind; bf16_t* O; int ldc; bf16_t* KV; bf16_t* QI; bf16_t* KIW; const PG8_LAS float* rtab; bf16_t* KIT;
    __device__ __forceinline__ void operator()(const f32x4 (&acc)[2][2][4][2], const Unit& u, int wr, int wc, int fr, int fq) const {
        const int row0 = u.pm * BM + wr * 64 + fr; bf16_t* base; int ld;
        if (kind == 0) { base = O + u.pn * BM; ld = ldc; }
        else if (kind == 3) { base = O + ((size_t)(u.pm * 8 + u.pn) << 16) - (size_t)u.pm * BM * 256; ld = 256; }
        else if (kind == 1) {
            if (u.pn < 8) { base = O + u.pn * BM; ld = 2048; }
            else if (u.pn < 12) { const int b = u.pm >> 5, g = u.pn - 8; base = KV + ((size_t)(b * 4 + g) * 8192 - (size_t)b * 8192) * 256; ld = 256; }
            else if (u.pn < 16) { base = QI + (u.pn - 12) * BM; ld = 1024; }
            else { base = KIW; ld = 256; }
        } else { const int b = u.pm >> 5, g = u.pn; base = KV + ((size_t)(b * 4 + g) * 8192 - (size_t)b * 8192) * 256; ld = 256; }
        const int col0 = wc * 32 + 8 * fq; float rs[2][4]; row_scales(rtab, u, wr, fr, rs);
        if (kind == 1 && u.pn == 16) {
            if (wc < 2) {
#pragma unroll
                for (int ai = 0; ai < 2; ++ai)
#pragma unroll
                    for (int m = 0; m < 4; ++m) { const int row = row0 + ai * HALF + m * 16, d0 = wc * 32 + 8 * fq;
                        bf16_t* dst = QI  ; dst = KIT + ((size_t)((row >> 5) * 4 + (d0 >> 4)) * 64 + ((d0 >> 3) & 1) * 32 + (row & 31)) * 8;
                        const f32x4 v0 = acc[ai][0][m][0] * rs[ai][m], v1 = acc[ai][0][m][1] * rs[ai][m];
                        u32x4 w; w.x = cvt_pk_bf16(v0[0], v0[1]); w.y = cvt_pk_bf16(v0[2], v0[3]); w.z = cvt_pk_bf16(v1[0], v1[1]); w.w = cvt_pk_bf16(v1[2], v1[3]);
                        *(PG8_GAS u32x4*)dst = w; }
            } else if (wc == 2 && fq < 2) {
#pragma unroll
                for (int ai = 0; ai < 2; ++ai)
#pragma unroll
                    for (int m = 0; m < 4; ++m) { bf16_t* rowp = KIW + (size_t)(row0 + ai * HALF + m * 16) * 256 + col0;
                        const f32x4 v0 = acc[ai][0][m][0] * rs[ai][m], v1 = acc[ai][0][m][1] * rs[ai][m];
                        u32x4 w; w.x = cvt_pk_bf16(v0[0], v0[1]); w.y = cvt_pk_bf16(v0[2], v0[3]); w.z = cvt_pk_bf16(v1[0], v1[1]); w.w = cvt_pk_bf16(v1[2], v1[3]);
                        *(PG8_GAS u32x4*)rowp = w; }
            }
            return;
        }
        if (kind == 1 && u.pn >= 8 && u.pn < 12) {
            unsigned char* b8 = (unsigned char*)KV + ((size_t)((u.pm >> 5) * 4 + (u.pn - 8)) * 8192 - (size_t)(u.pm >> 5) * 8192) * 256 + col0;
#pragma unroll
            for (int ai = 0; ai < 2; ++ai)
#pragma unroll
                for (int m = 0; m < 4; ++m) { unsigned char* rowp = b8 + (size_t)(row0 + ai * HALF + m * 16) * 256; const float sc = rs[ai][m] * 16.0f;
#pragma unroll
                    for (int bj = 0; bj < 2; ++bj) { const f32x4 v0 = acc[ai][bj][m][0] * sc, v1 = acc[ai][bj][m][1] * sc; typedef unsigned u32x2 __attribute__((ext_vector_type(2)));
                        int w0 = __builtin_amdgcn_cvt_pk_fp8_f32(v0[0], v0[1], 0, false); w0 = __builtin_amdgcn_cvt_pk_fp8_f32(v0[2], v0[3], w0, true);
                        int w1 = __builtin_amdgcn_cvt_pk_fp8_f32(v1[0], v1[1], 0, false); w1 = __builtin_amdgcn_cvt_pk_fp8_f32(v1[2], v1[3], w1, true);
                        u32x2 w; w.x = (unsigned)w0; w.y = (unsigned)w1; *(PG8_GAS u32x2*)(rowp + bj * HALF) = w; } }
            return;
        }
#pragma unroll
        for (int ai = 0; ai < 2; ++ai)
#pragma unroll
            for (int m = 0; m < 4; ++m) { bf16_t* rowp = base + (size_t)(row0 + ai * HALF + m * 16) * ld + col0;
#pragma unroll
                for (int bj = 0; bj < 2; ++bj) { const f32x4 v0 = acc[ai][bj][m][0] * rs[ai][m], v1 = acc[ai][bj][m][1] * rs[ai][m];
                    u32x4 w; w.x = cvt_pk_bf16(v0[0], v0[1]); w.y = cvt_pk_bf16(v0[2], v0[3]); w.z = cvt_pk_bf16(v1[0], v1[1]); w.w = cvt_pk_bf16(v1[2], v1[3]);
                    *(PG8_GAS u32x4*)(rowp + bj * HALF) = w; } }
    }
};
__device__ __forceinline__ float bflo(unsigned w) { return __uint_as_float(w << 16); }
__device__ __forceinline__ float bfhi(unsigned w) { return __uint_as_float(w & 0xffff0000u); }
typedef float f32x2 __attribute__((ext_vector_type(2)));
__device__ __forceinline__ f32x2 bf2(unsigned w) { f32x2 r; r.x = bflo(w); r.y = bfhi(w); return r; }
#define PG8_LO2(v) __builtin_shufflevector(v, v, 0, 1)
#define PG8_HI2(v) __builtin_shufflevector(v, v, 2, 3)
__device__ __forceinline__ void sig8(f32x4& s0, f32x4& s1, const f32x4 a0, const f32x4 a1, float nrs) {
    f32x4 t0 = a0 * nrs, t1 = a1 * nrs;
    __builtin_amdgcn_sched_barrier(0);
#pragma unroll
    for (int e = 0; e < 4; ++e) { t0[e] = __builtin_amdgcn_exp2f(t0[e]); t1[e] = __builtin_amdgcn_exp2f(t1[e]); }
    __builtin_amdgcn_sched_barrier(0);
    t0 = t0 + 1.0f; t1 = t1 + 1.0f;
    __builtin_amdgcn_sched_barrier(0);
#pragma unroll
    for (int e = 0; e < 4; ++e) { t0[e] = __builtin_amdgcn_rcpf(t0[e]); t1[e] = __builtin_amdgcn_rcpf(t1[e]); }
    __builtin_amdgcn_sched_barrier(0);
    s0 = t0; s1 = t1;
}
struct EpiResid {
    static constexpr bool PERM = true, AFTER_DRAIN = false;
    const bf16_t* Xin; bf16_t* Xout; float* ssp;
    __device__ __forceinline__ void operator()(const f32x4 (&acc)[2][2][4][2], const Unit& u, int wr, int wc, int fr, int fq) const {
        const int row0 = u.pm * BM + wr * 64 + fr, rl0 = wr * 64 + fr, cl0 = wc * 32 + 8 * fq; const size_t tb = (size_t)(u.pm * 8 + u.pn) << 16;
        u32x4 xv[2][4][2];
#pragma unroll
        for (int ai = 0; ai < 2; ++ai)
#pragma unroll
            for (int m = 0; m < 4; ++m)
#pragma unroll
                for (int bj = 0; bj < 2; ++bj) xv[ai][m][bj] = *(const PG8_GAS u32x4*)(Xin + tb + (size_t)(rl0 + ai * HALF + m * 16) * 256 + cl0 + bj * HALF);
#pragma unroll
        for (int ai = 0; ai < 2; ++ai)
#pragma unroll
            for (int m = 0; m < 4; ++m) { float q; f32x2 qq = (f32x2){0.f, 0.f};
#pragma unroll
                for (int bj = 0; bj < 2; ++bj) { const u32x4 x = xv[ai][m][bj]; const f32x4 a0 = acc[ai][bj][m][0], a1 = acc[ai][bj][m][1];
                    const f32x2 o0 = bf2(x.x) + PG8_LO2(a0), o1 = bf2(x.y) + PG8_HI2(a0), o2 = bf2(x.z) + PG8_LO2(a1), o3 = bf2(x.w) + PG8_HI2(a1);
                    u32x4 w; w.x = cvt_pk_bf16(o0.x, o0.y); w.y = cvt_pk_bf16(o1.x, o1.y); w.z = cvt_pk_bf16(o2.x, o2.y); w.w = cvt_pk_bf16(o3.x, o3.y);
                    *(PG8_GAS u32x4*)(Xout + tb + (size_t)(rl0 + ai * HALF + m * 16) * 256 + cl0 + bj * HALF) = w;
                    const f32x2 w0 = bf2(w.x), w1 = bf2(w.y), w2 = bf2(w.z), w3 = bf2(w.w); qq = qq + w0 * w0; qq = qq + w1 * w1; qq = qq + w2 * w2; qq = qq + w3 * w3; }
                q = qq.x + qq.y;
                { auto r16_ = __builtin_amdgcn_permlane16_swap(__float_as_uint(q), __float_as_uint(q), false, false); q = __uint_as_float(r16_[0]) + __uint_as_float(r16_[1]); auto r32_ = __builtin_amdgcn_permlane32_swap(__float_as_uint(q), __float_as_uint(q), false, false); q = __uint_as_float(r32_[0]) + __uint_as_float(r32_[1]); }
                if (fq == 0) ((PG8_GAS float*)ssp)[(size_t)(row0 + ai * HALF + m * 16) * 32 + u.pn * 4 + wc] = q; }
    }
};
struct EpiSwiglu {
    static constexpr bool PERM = true, AFTER_DRAIN = false;
    bf16_t* U; const PG8_LAS float* rtab;
    __device__ __forceinline__ void operator()(const f32x4 (&acc)[2][2][4][2], const Unit& u, int wr, int wc, int fr, int fq) const {
        const int row0 = wr * 64 + fr; float rs[2][4]; row_scales(rtab, u, wr, fr, rs);
        bf16_t* const ub = U + ((size_t)(u.pm * 22 + (u.pn >> 1)) << 16) + (u.pn & 1) * HALF + wc * 32 + 8 * fq;
#ifndef EPI_SWIGLU_REP
#define EPI_SWIGLU_REP 1
#endif
        for (int er_ = 0; er_ < EPI_SWIGLU_REP; ++er_) { asm volatile("" ::: "memory");
#pragma unroll
        for (int ai = 0; ai < 2; ++ai)
#pragma unroll
            for (int m = 0; m < 4; ++m) { bf16_t* rowp = ub + (size_t)(row0 + ai * HALF + m * 16) * 256;
                f32x4 o[2]; const float rsv = rs[ai][m], rr = rsv * rsv;
                { f32x4 s0, s1; sig8(s0, s1, acc[ai][0][m][0], acc[ai][0][m][1], rsv * -1.4426950408889634f);
                  o[0] = (acc[ai][0][m][0] * acc[ai][1][m][0]) * (s0 * rr); o[1] = (acc[ai][0][m][1] * acc[ai][1][m][1]) * (s1 * rr); }
                u32x4 w; w.x = cvt_pk_bf16(o[0][0], o[0][1]); w.y = cvt_pk_bf16(o[0][2], o[0][3]); w.z = cvt_pk_bf16(o[1][0], o[1][1]); w.w = cvt_pk_bf16(o[1][2], o[1][3]);
                *(PG8_GAS u32x4*)rowp = w; }
        }
    }
};
struct EpiGate {
    static constexpr bool PERM = true, AFTER_DRAIN = false;
    const bf16_t* Xin; const bf16_t* PE; const PG8_LAS float* rtab; bf16_t* Xout; float* ssp;
    __device__ __forceinline__ void operator()(const f32x4 (&acc)[2][2][4][2], const Unit& u, int wr, int wc, int fr, int fq) const {
        const int row0 = u.pm * BM + wr * 64 + fr, rl0 = wr * 64 + fr, cl0 = wc * 32 + 8 * fq; const size_t tb = (size_t)(u.pm * 8 + u.pn) << 16;
#pragma unroll
        for (int ai = 0; ai < 2; ++ai) {
            u32x4 xv[4][2], pv[4][2];
#pragma unroll
            for (int m = 0; m < 4; ++m)
#pragma unroll
                for (int bj = 0; bj < 2; ++bj) { const size_t off = tb + (size_t)(rl0 + ai * HALF + m * 16) * 256 + cl0 + bj * HALF; xv[m][bj] = *(const PG8_GAS u32x4*)(Xin + off); pv[m][bj] = *(const PG8_GAS u32x4*)(PE + off); }
#pragma unroll
            for (int m = 0; m < 4; ++m) { float q; f32x2 qq = (f32x2){0.f, 0.f}; const float nr = rtab[u.ord * BM + ai * HALF + wr * 64 + m * 16 + fr] * -1.4426950408889634f;
#pragma unroll
                for (int bj = 0; bj < 2; ++bj) { const u32x4 x = xv[m][bj], p = pv[m][bj]; f32x4 s0, s1; sig8(s0, s1, acc[ai][bj][m][0], acc[ai][bj][m][1], nr);
                    const f32x2 o0 = bf2(x.x) + bf2(p.x) * PG8_LO2(s0), o1 = bf2(x.y) + bf2(p.y) * PG8_HI2(s0), o2 = bf2(x.z) + bf2(p.z) * PG8_LO2(s1), o3 = bf2(x.w) + bf2(p.w) * PG8_HI2(s1);
                    u32x4 w; w.x = cvt_pk_bf16(o0.x, o0.y); w.y = cvt_pk_bf16(o1.x, o1.y); w.z = cvt_pk_bf16(o2.x, o2.y); w.w = cvt_pk_bf16(o3.x, o3.y);
                    *(PG8_GAS u32x4*)(Xout + tb + (size_t)(rl0 + ai * HALF + m * 16) * 256 + cl0 + bj * HALF) = w;
                    const f32x2 w0 = bf2(w.x), w1 = bf2(w.y), w2 = bf2(w.z), w3 = bf2(w.w); qq = qq + w0 * w0; qq = qq + w1 * w1; qq = qq + w2 * w2; qq = qq + w3 * w3; }
                q = qq.x + qq.y;
                { auto r16_ = __builtin_amdgcn_permlane16_swap(__float_as_uint(q), __float_as_uint(q), false, false); q = __uint_as_float(r16_[0]) + __uint_as_float(r16_[1]); auto r32_ = __builtin_amdgcn_permlane32_swap(__float_as_uint(q), __float_as_uint(q), false, false); q = __uint_as_float(r32_[0]) + __uint_as_float(r32_[1]); }
                if (fq == 0) ((PG8_GAS float*)ssp)[(size_t)(row0 + ai * HALF + m * 16) * 32 + u.pn * 4 + wc] = q; }
            asm volatile("" ::: "memory"); }
    }
};
template <class Epi, class Sched, bool ALIGN_EPI = false, bool SP2 = false>
__device__ __forceinline__ void gemm_phase(PG8_LAS unsigned char* lds, const Gemm g, const Sched& S, const Epi& E) {
    int tid_l = threadIdx.x; asm volatile("" : "+v"(tid_l));
    const int tid = tid_l, wid = __builtin_amdgcn_readfirstlane(tid >> 6), lane = tid & 63, wr = wid >> 2, wc = wid & 3, fr = lane & 15, fq = lane >> 4;
    const int K = g.K, nt = K / BK;
    unsigned voffA[2], voffB[2];
#pragma unroll
    for (int i = 0; i < 2; ++i) { int R, C; stage_rc(tid * 16 + i * 8192, R, C); const int Rb = Epi::PERM ? ((R & ~31) + perm32(R & 31)) : R;
        voffA[i] = (unsigned)(R * (g.tiledA ? 256 : K) + C) * 2u; voffB[i] = (unsigned)(Rb * K + C) * 2u; }
    const unsigned kstep = (unsigned)(BK * 2);
    const unsigned hstep = (unsigned)HALF * K * 2;
    const unsigned tstep = 2 * hstep;
    const unsigned hstepA = g.tiledA ? 65536u : hstep;
#define PG8_KA(t_) (g.tiledA ? ((((unsigned)(t_)) >> 2) << 17) + ((((unsigned)(t_)) & 3u) << 7) : (unsigned)(t_) * kstep)
    const unsigned ldsw = (unsigned)wid * 1024u;
    const int aoff = lds_byte(wr * 64 + fr, fq * 8), boff = lds_byte(wc * 32 + fr, fq * 8);
#define PG8_SA(b, h) (((b) * 2 + (h)) * HTB)
#define PG8_SB(b, h) ((4 + (b) * 2 + (h)) * HTB)
    const unsigned long long pA_ = (unsigned long long)g.A, pB_ = (unsigned long long)g.Bt;
    void* const uA_ = (void*)(((unsigned long long)(unsigned)__builtin_amdgcn_readfirstlane((int)(unsigned)(pA_ >> 32)) << 32) | (unsigned)__builtin_amdgcn_readfirstlane((int)(unsigned)pA_));
    void* const uB_ = (void*)(((unsigned long long)(unsigned)__builtin_amdgcn_readfirstlane((int)(unsigned)(pB_ >> 32)) << 32) | (unsigned)__builtin_amdgcn_readfirstlane((int)(unsigned)pB_));
    const __amdgpu_buffer_rsrc_t rs_voffA = __builtin_amdgcn_make_buffer_rsrc(uA_, (short)0, __builtin_amdgcn_readfirstlane((int)((unsigned)g.M * (unsigned)K * 2u)), 0x00020000);
    const __amdgpu_buffer_rsrc_t rs_voffB = __builtin_amdgcn_make_buffer_rsrc(uB_, (short)0, __builtin_amdgcn_readfirstlane((int)((unsigned)g.N * (unsigned)K * 2u)), 0x00020000);
#define PG8_STAGE(bufoff, goff, voff) do { _Pragma("unroll") for (int _i = 0; _i < 2; ++_i) \
        __builtin_amdgcn_raw_ptr_buffer_load_lds(rs_##voff, (PG8_LAS void*)(lds + (bufoff) + ldsw + _i * 8192), 16, (int)(voff)[_i], (int)(goff), 0, 0); } while (0)
#define PG8_LDA(dst, b, h) do { _Pragma("unroll") for (int m = 0; m < 4; ++m) _Pragma("unroll") for (int k = 0; k < 2; ++k) dst[m][k] = *(const PG8_LAS bf16x8*)(lds + PG8_SA(b, h) + aoff + m * 2048 + k * 1024); } while (0)
#define PG8_LDB(dst, b, h) do { _Pragma("unroll") for (int n = 0; n < 2; ++n) _Pragma("unroll") for (int k = 0; k < 2; ++k) dst[n][k] = *(const PG8_LAS bf16x8*)(lds + PG8_SB(b, h) + boff + n * 2048 + k * 1024); } while (0)
#define PG8_MMA(ai, bj, At, Bt) do { __builtin_amdgcn_s_setprio(1); _Pragma("unroll") for (int m = 0; m < 4; ++m) _Pragma("unroll") for (int n = 0; n < 2; ++n) _Pragma("unroll") for (int k = 0; k < 2; ++k) \
        acc[ai][bj][m][n] = __builtin_amdgcn_mfma_f32_16x16x32_bf16(Bt[n][k], At[m][k], acc[ai][bj][m][n], 0, 0, 0); __builtin_amdgcn_s_setprio(0); } while (0)
#define PG8_WAIT_V(n) asm volatile("s_waitcnt vmcnt(" #n ")" ::: "memory")
#define PG8_WAIT_L(n) asm volatile("s_waitcnt lgkmcnt(" #n ")" ::: "memory")
#define PG8_BAR __builtin_amdgcn_s_barrier()
#define PG8_SCHED __builtin_amdgcn_sched_barrier(0)
    Unit cur, nxt; int ui = 0;
    if (!S.next(0, cur)) return;
    f32x4 acc[2][2][4][2];
#pragma unroll
    for (int a = 0; a < 2; ++a)
#pragma unroll
        for (int b = 0; b < 2; ++b)
#pragma unroll
            for (int m = 0; m < 4; ++m)
#pragma unroll
                for (int n = 0; n < 2; ++n) acc[a][b][m][n] = (f32x4){0.f, 0.f, 0.f, 0.f};
    bf16x8 At[4][2], B0[2][2], B1[2][2];
    unsigned cA = (unsigned)cur.pm * tstep, cB = (unsigned)cur.pn * tstep;
    S.a_ready(cur);
    if constexpr (SP2) {
        PG8_STAGE(PG8_SB(0, 0), cB, voffB); PG8_STAGE(PG8_SB(0, 1), cB + hstep, voffB); PG8_STAGE(PG8_SA(0, 0), cA, voffA); PG8_STAGE(PG8_SA(0, 1), cA + hstepA, voffA);
        if (wr == 1) PG8_BAR;
        PG8_WAIT_V(2); PG8_BAR;
        PG8_STAGE(PG8_SB(1, 0), cB + kstep, voffB); PG8_STAGE(PG8_SA(1, 0), cA + kstep, voffA); PG8_STAGE(PG8_SB(1, 1), cB + hstep + kstep, voffB);
        PG8_WAIT_V(6); PG8_BAR;
    } else {
        PG8_STAGE(PG8_SB(0, 0), cB, voffB); PG8_STAGE(PG8_SA(0, 0), cA, voffA); PG8_STAGE(PG8_SB(0, 1), cB + hstep, voffB); PG8_STAGE(PG8_SA(0, 1), cA + hstepA, voffA);
        if (wr == 1) PG8_BAR;
        PG8_WAIT_V(4); PG8_BAR;
        PG8_STAGE(PG8_SB(1, 0), cB + kstep, voffB); PG8_STAGE(PG8_SA(1, 0), cA + kstep, voffA); PG8_STAGE(PG8_SB(1, 1), cB + hstep + kstep, voffB);
        PG8_WAIT_V(6); PG8_BAR;
    }
    for (;;) {
        const bool has_next = S.next(ui + 1, nxt);
        const unsigned nA = has_next ? (unsigned)nxt.pm * tstep : cA, nB = has_next ? (unsigned)nxt.pn * tstep : cB;
        for (int t = 0; t < nt; t += 2) {
            const bool last = (t == nt - 2);
            const unsigned a1 = cA + PG8_KA(t + 1);
            const unsigned a2 = last ? nA : cA + PG8_KA(t + 2), b2 = last ? nB : cB + (unsigned)(t + 2) * kstep;
            const unsigned a3 = a2 + kstep, b3 = b2 + kstep;
            if (last && has_next) S.a_ready(nxt);
            if constexpr (SP2) {
            PG8_LDB(B0, 0, 0); PG8_LDB(B1, 0, 1); PG8_SCHED; PG8_LDA(At, 0, 0); PG8_STAGE(PG8_SA(1, 1), a1 + hstepA, voffA);
            PG8_WAIT_V(8); PG8_WAIT_L(0); PG8_BAR; PG8_MMA(0, 0, At, B0); PG8_MMA(0, 1, At, B1); PG8_BAR; PG8_SCHED;
            PG8_LDA(At, 0, 1); PG8_STAGE(PG8_SB(0, 0), b2, voffB); PG8_STAGE(PG8_SB(0, 1), b2 + hstep, voffB); PG8_STAGE(PG8_SA(0, 0), a2, voffA);
            PG8_WAIT_V(8); PG8_WAIT_L(0); PG8_BAR; PG8_MMA(1, 0, At, B0); PG8_MMA(1, 1, At, B1); PG8_BAR; PG8_SCHED;
            PG8_LDB(B0, 1, 0); PG8_LDB(B1, 1, 1); PG8_SCHED; PG8_LDA(At, 1, 0); PG8_STAGE(PG8_SA(0, 1), a2 + hstepA, voffA);
            PG8_WAIT_V(8); PG8_WAIT_L(0); PG8_BAR; PG8_MMA(0, 0, At, B0); PG8_MMA(0, 1, At, B1); PG8_BAR; PG8_SCHED;
            PG8_LDA(At, 1, 1); PG8_STAGE(PG8_SB(1, 0), b3, voffB); PG8_STAGE(PG8_SB(1, 1), b3 + hstep, voffB); PG8_STAGE(PG8_SA(1, 0), a3, voffA);
            PG8_WAIT_V(8); PG8_WAIT_L(0); PG8_BAR; PG8_MMA(1, 0, At, B0); PG8_MMA(1, 1, At, B1); PG8_BAR; PG8_SCHED;
            } else {
            PG8_LDB(B0, 0, 0); PG8_SCHED; PG8_LDA(At, 0, 0); PG8_STAGE(PG8_SA(1, 1), a1 + hstepA, voffA);
            PG8_WAIT_L(8); PG8_BAR; PG8_WAIT_L(0); PG8_MMA(0, 0, At, B0); PG8_BAR; PG8_SCHED;
            PG8_LDB(B1, 0, 1); PG8_STAGE(PG8_SB(0, 0), b2, voffB);
            PG8_BAR; PG8_WAIT_L(0); PG8_MMA(0, 1, At, B1); PG8_BAR;
            PG8_LDA(At, 0, 1); PG8_STAGE(PG8_SA(0, 0), a2, voffA);
            PG8_BAR; PG8_WAIT_L(0); PG8_MMA(1, 0, At, B0); PG8_BAR; PG8_SCHED;
            PG8_STAGE(PG8_SB(0, 1), b2 + hstep, voffB);
            PG8_WAIT_V(6); PG8_BAR; PG8_MMA(1, 1, At, B1); PG8_BAR;
            PG8_LDB(B0, 1, 0); PG8_SCHED; PG8_LDA(At, 1, 0); PG8_STAGE(PG8_SA(0, 1), a2 + hstepA, voffA);
            PG8_WAIT_L(8); PG8_BAR; PG8_WAIT_L(0); PG8_MMA(0, 0, At, B0); PG8_BAR; PG8_SCHED;
            PG8_LDB(B1, 1, 1); PG8_STAGE(PG8_SB(1, 0), b3, voffB);
            PG8_BAR; PG8_WAIT_L(0); PG8_MMA(0, 1, At, B1); PG8_BAR;
            PG8_LDA(At, 1, 1); PG8_STAGE(PG8_SA(1, 0), a3, voffA);
            PG8_BAR; PG8_WAIT_L(0); PG8_MMA(1, 0, At, B0); PG8_BAR; PG8_SCHED;
            PG8_STAGE(PG8_SB(1, 1), b3 + hstep, voffB);
            PG8_WAIT_V(6); PG8_BAR; PG8_MMA(1, 1, At, B1); PG8_BAR;
            }
        }
        if constexpr (ALIGN_EPI) { if (wr == 0) PG8_BAR; }
        if constexpr (!Epi::AFTER_DRAIN) { E(acc, cur, wr, wc, fr, fq); S.done(cur); }
        if (!has_next) break;
#pragma unroll
        for (int a = 0; a < 2; ++a)
#pragma unroll
            for (int b = 0; b < 2; ++b)
#pragma unroll
                for (int m = 0; m < 4; ++m)
#pragma unroll
                    for (int n = 0; n < 2; ++n) acc[a][b][m][n] = (f32x4){0.f, 0.f, 0.f, 0.f};
        cur = nxt; cA = nA; cB = nB; ++ui;
        if constexpr (ALIGN_EPI) { if (wr == 1) PG8_BAR; }
    }
    PG8_WAIT_V(0);
    if constexpr (!ALIGN_EPI) { if (wr == 0) PG8_BAR; }
    PG8_BAR;
    if constexpr (Epi::AFTER_DRAIN) { E.fused(acc, cur, wr, wc, fr, fq, lds, wid, lane); S.done(cur); }
#undef PG8_KA
#undef PG8_SA
#undef PG8_SB
#undef PG8_STAGE
#undef PG8_LDA
#undef PG8_LDB
#undef PG8_MMA
#undef PG8_WAIT_V
#undef PG8_WAIT_L
#undef PG8_BAR
#undef PG8_SCHED
}
}

constexpr int NWAVES = 8;
constexpr int BATCH = 2, SEQ = 8192, DM = 2048, DEPTH = 4, N_A = 2, NHEAD = 16, HDIM = 128, NKV = 4, GRP = 4, IHEAD = 16, IDIM = 64, TOPK = 256, DFF = 5632, PLE = 256;
constexpr int M = BATCH * SEQ;
constexpr int A_IN = 4176, A_INP = 4352;
constexpr float RMS_EPS = 1e-6f;

constexpr size_t MiB = 1u << 20;
constexpr size_t WS_CTL = 0, CTL_ZERO_BYTES = 32 * 1024;
constexpr size_t SZ_WIN = (size_t)A_INP * DM * 2, SZ_SQ = (size_t)DM * DM * 2, SZ_W13 = (size_t)2 * DFF * DM * 2, SZ_W2 = (size_t)DM * DFF * 2, SZ_WPE = (size_t)DM * PLE * 2, SZ_WKV = (size_t)1024 * DM * 2;
constexpr size_t WS_WIN = 1 * MiB;
constexpr size_t WS_WOA = WS_WIN + 2 * SZ_WIN;
constexpr size_t WS_WQB = WS_WOA + 2 * SZ_SQ;
constexpr size_t WS_WOB = WS_WQB + 2 * SZ_SQ;
constexpr size_t WS_WPG = WS_WOB + 2 * SZ_SQ;
constexpr size_t WS_W13 = WS_WPG + 4 * SZ_SQ;
constexpr size_t WS_W2 = WS_W13 + 4 * SZ_W13;
constexpr size_t WS_WPE = WS_W2 + 4 * SZ_W2;
constexpr size_t WS_WKV = WS_WPE + 4 * SZ_WPE;
constexpr size_t WS_PB = WS_WKV + SZ_WKV;
constexpr size_t WS_XN = WS_PB + (size_t)4 * M * PLE * 2;
constexpr size_t WS_KVA = WS_XN + (size_t)M * DM * 2;
constexpr size_t WS_KVB = WS_KVA + (size_t)8 * SEQ * 256 * 2;
constexpr size_t WS_R1 = WS_KVB + (size_t)8 * SEQ * 256 * 2;
constexpr size_t WS_Q = WS_R1;
constexpr size_t WS_AO = WS_Q + (size_t)M * DM * 2;
constexpr size_t WS_QI = WS_AO + (size_t)M * DM * 2;
constexpr size_t WS_KIW = WS_QI + (size_t)M * 1024 * 2;
constexpr size_t WS_IDX = WS_KIW + (size_t)M * 256 * 2;
constexpr size_t WS_KIT = WS_IDX + (size_t)M * 256 * 4;
constexpr size_t WS_R1_END = WS_KIT + (size_t)M * 64 * 2;
constexpr size_t WS_U = WS_R1;
static_assert(WS_U + (size_t)M * DFF * 2 <= WS_R1_END, "U fits the attention scratch region");
constexpr size_t WS_XNB = WS_R1_END;
constexpr size_t WS_PE = WS_XNB + (size_t)M * DM * 2;
constexpr size_t WS_SSP = WS_PE + (size_t)M * DM * 2;
constexpr size_t WS_END = WS_SSP + (size_t)13 * M * 32 * 4;
constexpr int RTAB_OFF = 131072;
constexpr int CW_BAR = 4096;

constexpr int LDS_BYTES = 163840;
constexpr int MISC_OFF = LDS_BYTES - 256;
constexpr int TAB_ENTRIES = 129 * 16;

#define GAS __attribute__((address_space(1)))
#define LAS __attribute__((address_space(3)))
typedef unsigned short bf16;
typedef unsigned v4u __attribute__((ext_vector_type(4)));
typedef unsigned v2u __attribute__((ext_vector_type(2)));
typedef float f32x4 __attribute__((ext_vector_type(4)));
typedef float f32x16 __attribute__((ext_vector_type(16)));
typedef short bf16x8 __attribute__((ext_vector_type(8)));
typedef short s16x4 __attribute__((ext_vector_type(4)));
typedef GAS unsigned gu32;
#define RLX_AGENT __ATOMIC_RELAXED, __HIP_MEMORY_SCOPE_AGENT
#define LDS_WAIT() asm volatile("s_waitcnt lgkmcnt(0)" ::: "memory")
__device__ __forceinline__ unsigned f2bf(float f) { unsigned u = __builtin_bit_cast(unsigned, f); return (u + 0x7fffu + ((u >> 16) & 1u)) >> 16; }
__device__ __forceinline__ unsigned pk2(float lo, float hi) { return pg8::cvt_pk_bf16(lo, hi); }
__device__ __forceinline__ float bf2f(unsigned short b) { return __uint_as_float(((unsigned)b) << 16); }
__device__ __forceinline__ s16x4 vtr(const LAS unsigned char* p) { typedef short v4i16_t __attribute__((ext_vector_type(4))); return __builtin_bit_cast(s16x4, __builtin_amdgcn_ds_read_tr16_b64_v4i16((LAS v4i16_t*)p)); }
__device__ __forceinline__ float bfly16_max(float v) { auto rr = __builtin_amdgcn_permlane16_swap(__float_as_uint(v), __float_as_uint(v), false, false); return fmaxf(__uint_as_float(rr[0]), __uint_as_float(rr[1])); }
__device__ __forceinline__ float bfly32_max(float v) { auto rr = __builtin_amdgcn_permlane32_swap(__float_as_uint(v), __float_as_uint(v), false, false); return fmaxf(__uint_as_float(rr[0]), __uint_as_float(rr[1])); }
__device__ __forceinline__ float bfly16_sum(float v) { auto rr = __builtin_amdgcn_permlane16_swap(__float_as_uint(v), __float_as_uint(v), false, false); return __uint_as_float(rr[0]) + __uint_as_float(rr[1]); }
__device__ __forceinline__ float bfly32_sum(float v) { auto rr = __builtin_amdgcn_permlane32_swap(__float_as_uint(v), __float_as_uint(v), false, false); return __uint_as_float(rr[0]) + __uint_as_float(rr[1]); }
__device__ __forceinline__ float wave_sum(float v) {
#pragma unroll
    for (int o = 1; o < 64; o <<= 1) v += __shfl_xor(v, o);
    return v;
}
#define XB_TMO      128
#define XB_XCNT(j)  (256  + 64 * (j))
#define XB_XSUB(j)  (1280 + 64 * (j))
#define XB_XGEN(j)  (2304 + 64 * (j))
#define XB_TOP      3328
#define XB_TOPGEN   3392
#define XCD_BAR_WORDS 3456
#define XB_SPIN_CAP (1u << 18)

__device__ __forceinline__ unsigned xb_ld(unsigned* p)              { return __hip_atomic_load(p, __ATOMIC_RELAXED, __HIP_MEMORY_SCOPE_AGENT); }
__device__ __forceinline__ unsigned xb_add(unsigned* p, unsigned v) { return __hip_atomic_fetch_add(p, v, __ATOMIC_RELAXED, __HIP_MEMORY_SCOPE_AGENT); }
__device__ __forceinline__ unsigned xb_xcc_id() { return (unsigned)__builtin_amdgcn_s_getreg((3 << 11) | 20) & 0xFu; }
#define XB_SPIN(cond, bar) do { unsigned _sp = 0; while (cond) { __builtin_amdgcn_s_sleep(1); \
    if ((++_sp & 255u) == 0u) { if (xb_ld(&(bar)[XB_TMO])) break; if (_sp > XB_SPIN_CAP) { atomicAdd(&(bar)[XB_TMO], 1u); break; } } } } while (0)

struct XcdBarrier {
    unsigned* bar; unsigned x;
    volatile LAS unsigned* st;
};

__device__ __forceinline__ XcdBarrier xcd_barrier_post(unsigned* bar, volatile LAS unsigned* st) {
    XcdBarrier b; b.bar = bar; b.x = xb_xcc_id(); b.st = st;
    if (threadIdx.x == 0) (void)xb_add(&bar[XB_XCNT(b.x)], 1u);
    return b;
}
__device__ __forceinline__ void xcd_barrier_complete(unsigned* bar, unsigned x, unsigned& nloc, unsigned& nx) {
    const unsigned G = gridDim.x * gridDim.y * gridDim.z;
    unsigned sum, cnt, mine, sp = 0u;
    for (;;) {
        sum = 0u; cnt = 0u; mine = 0u;
#pragma unroll
        for (unsigned j = 0; j < 16; ++j) { const unsigned c = xb_ld(&bar[XB_XCNT(j)]); sum += c; cnt += (c > 0u) ? 1u : 0u; mine = (j == x) ? c : mine; }
        if (sum == G) break;
        __builtin_amdgcn_s_sleep(1);
        if ((++sp & 255u) == 0u) { if (xb_ld(&bar[XB_TMO])) break; if (sp > XB_SPIN_CAP) { atomicAdd(&bar[XB_TMO], 1u); break; } }
    }
    nloc = mine > 0u ? mine : 1u; nx = cnt > 0u ? cnt : 1u;
}

__device__ __forceinline__ void xcd_barrier(const XcdBarrier& b) {
    asm volatile("s_waitcnt vmcnt(0)" ::: "memory");
    __syncthreads();
    if (threadIdx.x == 0) {
        unsigned* bar = b.bar;
        __builtin_amdgcn_s_waitcnt(0);
        unsigned nloc = b.st[0], nx = b.st[1];
        if (nloc == 0u) { xcd_barrier_complete(bar, b.x, nloc, nx); b.st[0] = nloc; b.st[1] = nx; }
        const unsigned old = xb_add(&bar[XB_XSUB(b.x)], 1u);
        const unsigned gen = old / nloc;
        if (old + 1u == (gen + 1u) * nloc) {
            __builtin_amdgcn_fence(__ATOMIC_RELEASE, "agent");
            asm volatile("s_waitcnt vmcnt(0)" ::: "memory");
            const unsigned og = xb_add(&bar[XB_TOP], 1u);
            const unsigned tg = og / nx;
            if (og + 1u == (tg + 1u) * nx) xb_add(&bar[XB_TOPGEN], 1u);
            else XB_SPIN(xb_ld(&bar[XB_TOPGEN]) == tg, bar);
            __builtin_amdgcn_fence(__ATOMIC_ACQUIRE, "agent");
            xb_add(&bar[XB_XGEN(b.x)], 1u);
            asm volatile("s_waitcnt vmcnt(0)" ::: "memory");
        } else {
            XB_SPIN(xb_ld(&bar[XB_XGEN(b.x)]) == gen, bar);
            __builtin_amdgcn_fence(__ATOMIC_ACQUIRE, "agent");
            asm volatile("s_waitcnt vmcnt(0)" ::: "memory");
        }
    }
    __syncthreads();
}

__device__ __forceinline__ void grp_barrier(unsigned* gw, volatile LAS unsigned* same, unsigned* barwords) {
    asm volatile("s_waitcnt vmcnt(0)" ::: "memory");
    __syncthreads();
    if (threadIdx.x == 0) {
        __builtin_amdgcn_s_waitcnt(0);
        unsigned sm = same[0];
        if (sm == 0u) { const unsigned a0 = xb_ld(gw + 8), a1 = xb_ld(gw + 9), a2 = xb_ld(gw + 10), a3 = xb_ld(gw + 11); sm = (a0 != 0u && a0 == a1 && a1 == a2 && a2 == a3) ? 1u : 2u; same[0] = sm; }
        if (sm != 1u) { __builtin_amdgcn_fence(__ATOMIC_RELEASE, "agent"); asm volatile("s_waitcnt vmcnt(0)" ::: "memory"); }
        const unsigned old = xb_add(gw, 1u), target = (old / 4u + 1u) * 4u;
        XB_SPIN(xb_ld(gw) < target, barwords);
        __builtin_amdgcn_fence(__ATOMIC_ACQUIRE, "agent");
        asm volatile("s_waitcnt vmcnt(0)" ::: "memory");
    }
    __syncthreads();
}


__device__ __forceinline__ void tr_load(const float* W, const float* gain, int N, int k0, int n0, f32x4 (&v)[16], f32x4 (&g)[2], int lane) {
    int nc = n0 + (lane & 15) * 4; nc = nc < N - 4 ? nc : N - 4; const int kr = lane >> 4;
    const GAS float* gp = (const GAS float*)(gain ? gain : W) + k0 + 8 * (lane & 7);
    g[0] = *(const GAS f32x4*)gp; g[1] = *(const GAS f32x4*)(gp + 4);
    const GAS float* src = (const GAS float*)W + (size_t)(k0 + kr) * N + nc;
#pragma unroll
    for (int i = 0; i < 16; ++i) v[i] = *(const GAS f32x4*)(src + (size_t)(4 * i) * N);
}
__device__ __forceinline__ void tr_store(bf16* WT, bool hg, int K, int N, int k0, int n0, int drow0, const f32x4 (&v)[16], const f32x4 (&g)[2], LAS float* scr, int lane) {
    const int c4 = (lane & 15) * 4, kr = lane >> 4;
#pragma unroll
    for (int i = 0; i < 16; ++i) { const int k = 4 * i + kr; scr[(c4 + 0) * 65 + k] = v[i].x; scr[(c4 + 1) * 65 + k] = v[i].y; scr[(c4 + 2) * 65 + k] = v[i].z; scr[(c4 + 3) * 65 + k] = v[i].w; }
    LDS_WAIT(); asm volatile("" ::: "memory");
    const int c = lane & 7;
    const float m0 = hg ? g[0].x : 1.f, m1 = hg ? g[0].y : 1.f, m2 = hg ? g[0].z : 1.f, m3 = hg ? g[0].w : 1.f, m4 = hg ? g[1].x : 1.f, m5 = hg ? g[1].y : 1.f, m6 = hg ? g[1].z : 1.f, m7 = hg ? g[1].w : 1.f;
#pragma unroll
    for (int j = 0; j < 8; ++j) { const int n = (lane >> 3) + 8 * j; const LAS float* s = scr + n * 65 + 8 * c;
        v4u o; o.x = pk2(s[0] * m0, s[1] * m1); o.y = pk2(s[2] * m2, s[3] * m3); o.z = pk2(s[4] * m4, s[5] * m5); o.w = pk2(s[6] * m6, s[7] * m7);
        if (n0 + n < N) *(GAS v4u*)(WT + (size_t)(drow0 + n) * K + k0 + 8 * c) = o; }
    LDS_WAIT(); asm volatile("" ::: "memory");
}
__device__ __forceinline__ int map_row(int mt, int n) {
    if (mt == 1) { if (n >= 2048 && n < 3072) { const int v = (n >= 2560) ? 1 : 0, nn = n - 2048 - v * 512; return 2048 + (nn >> 7) * 256 + v * 128 + (nn & 127); } return n; }
    if (mt == 2) { const int v = (n >= 512) ? 1 : 0, nn = n - v * 512; return (nn >> 7) * 256 + v * 128 + (nn & 127); }
    if (mt == 3) return (n >> 7) * 256 + (n & 127);
    if (mt == 4) return (n >> 7) * 256 + 128 + (n & 127);
    return n;
}
__device__ __forceinline__ void conv_matrix(const float* W, const float* gain, int K, int N, bf16* WT, int mt, LAS float* scr, int gw, int NGW, int lane, int& rot) {
    const int nblk = (N + 63) / 64, nitems = (K / 64) * nblk;
    int it = gw - rot; if (it < 0) it += NGW;
    rot = (rot + nitems) % NGW;
    f32x4 va[16], vb[16], ga[2], gb[2];
#define CONV_KB(i_) ((i_) / nblk)
#define CONV_LOAD(v_, g_, i_) tr_load(W, gain, N, 64 * CONV_KB(i_), 64 * ((i_) - CONV_KB(i_) * nblk), v_, g_, lane)
#define CONV_STORE(v_, g_, i_) tr_store(WT, gain != nullptr, K, N, 64 * CONV_KB(i_), 64 * ((i_) - CONV_KB(i_) * nblk), map_row(mt, 64 * ((i_) - CONV_KB(i_) * nblk)), v_, g_, scr, lane)
    if (it < nitems) CONV_LOAD(va, ga, it);
    while (it < nitems) {
        const int i1 = it + NGW; if (i1 < nitems) CONV_LOAD(vb, gb, i1);
        CONV_STORE(va, ga, it);
        if (i1 >= nitems) break;
        const int i2 = i1 + NGW; if (i2 < nitems) CONV_LOAD(va, ga, i2);
        CONV_STORE(vb, gb, i1);
        it = i2;
    }
#undef CONV_KB
#undef CONV_LOAD
#undef CONV_STORE
}

__device__ __forceinline__ float wave_sum_dpp(float v) {
#define FN_DPP(ctrl) v += __uint_as_float((unsigned)__builtin_amdgcn_update_dpp(0, (int)__float_as_uint(v), ctrl, 0xf, 0xf, false))
    FN_DPP(0xB1); FN_DPP(0x4E); FN_DPP(0x124); FN_DPP(0x128);
#undef FN_DPP
    return bfly32_sum(bfly16_sum(v));
}
__device__ __forceinline__ void xb_phase(const float* x, bf16* XB, float* ss, int gw, int NGW, int lane) {
    for (int m = gw; m < M; m += NGW) {
        const GAS f32x4* xr = (const GAS f32x4*)(x + (size_t)m * DM) + lane; f32x4 v[8]; float s = 0.f;
#pragma unroll
        for (int j = 0; j < 8; ++j) { v[j] = xr[64 * j]; s += (v[j].x * v[j].x + v[j].y * v[j].y) + (v[j].z * v[j].z + v[j].w * v[j].w); }
        s = wave_sum_dpp(s);
#pragma unroll
        for (int j = 0; j < 8; ++j) { const int c0 = 4 * (lane + 64 * j); v2u w; w.x = pk2(v[j].x, v[j].y); w.y = pk2(v[j].z, v[j].w);
            *(GAS v2u*)(XB + ((size_t)((m >> 8) * 8 + (c0 >> 8)) << 16) + (size_t)(m & 255) * 256 + (c0 & 255)) = w; }
        if (lane < 32) ((GAS float*)ss)[(size_t)m * 32 + lane] = lane == 0 ? s : 0.f;
    }
}
__device__ __forceinline__ void final_norm_phase(const bf16* xb, const float* g, float* out, int gw, int NGW, int lane) {
    f32x4 gg[4][2];
#pragma unroll
    for (int j = 0; j < 4; ++j) { const int c0 = (lane + 64 * j) * 8; gg[j][0] = *(const GAS f32x4*)(g + c0); gg[j][1] = *(const GAS f32x4*)(g + c0 + 4); }
    v4u v[4], vn[4];
#define FN_LOAD(dst, m_) do { _Pragma("unroll") for (int j = 0; j < 4; ++j) { const int c0 = 8 * (lane + 64 * j); dst[j] = *(const GAS v4u*)(xb + ((size_t)(((m_) >> 8) * 8 + (c0 >> 8)) << 16) + (size_t)((m_) & 255) * 256 + (c0 & 255)); } } while (0)
    if (gw < M) FN_LOAD(vn, gw);
    for (int m = gw; m < M; m += NGW) {
#pragma unroll
        for (int j = 0; j < 4; ++j) v[j] = vn[j];
        { const int mn = m + NGW < M ? m + NGW : m; FN_LOAD(vn, mn); }
        float s = 0.f;
#pragma unroll
        for (int j = 0; j < 4; ++j) { const unsigned w[4] = {v[j].x, v[j].y, v[j].z, v[j].w};
#pragma unroll
            for (int e = 0; e < 4; ++e) { const float lo = __uint_as_float(w[e] << 16), hi = __uint_as_float(w[e] & 0xffff0000u); s += lo * lo + hi * hi; } }
        const float r = 1.0f / sqrtf(wave_sum_dpp(s) * (1.f / DM) + RMS_EPS);
#pragma unroll
        for (int j = 0; j < 4; ++j) { const int c0 = (lane + 64 * j) * 8; const unsigned w[4] = {v[j].x, v[j].y, v[j].z, v[j].w};
            const f32x4 g0 = gg[j][0], g1 = gg[j][1];
            f32x4 o0, o1; o0.x = __uint_as_float(w[0] << 16) * r * g0.x; o0.y = __uint_as_float(w[0] & 0xffff0000u) * r * g0.y; o0.z = __uint_as_float(w[1] << 16) * r * g0.z; o0.w = __uint_as_float(w[1] & 0xffff0000u) * r * g0.w;
            o1.x = __uint_as_float(w[2] << 16) * r * g1.x; o1.y = __uint_as_float(w[2] & 0xffff0000u) * r * g1.y; o1.z = __uint_as_float(w[3] << 16) * r * g1.z; o1.w = __uint_as_float(w[3] & 0xffff0000u) * r * g1.w;
            GAS f32x4* op = (GAS f32x4*)(out + (size_t)m * DM + c0); op[0] = o0; op[1] = o1; }
    }
#undef FN_LOAD
}

__device__ __forceinline__ void build_bias_tab(LAS float* tab, const float* rel_bias, int tid) {
    for (int e = tid; e < TAB_ENTRIES; e += NWAVES * 64) { const int rel = e >> 4, h = e & 15; int bk;
        if (rel < 16) bk = rel; else if (rel >= 128) bk = 31; else { bk = 16 + (int)(logf((float)rel * (1.f / 16.f)) / logf(8.f) * 16.f); bk = bk > 31 ? 31 : bk; }
        tab[e] = rel_bias[bk * 16 + h]; }
}

__device__ __forceinline__ unsigned mono_key(float s) { const unsigned u = __float_as_uint(s); return (u & 0x80000000u) ? ~u : (u | 0x80000000u); }
__device__ __forceinline__ int mbcnt64(unsigned long long m) { return (int)__builtin_amdgcn_mbcnt_hi((unsigned)(m >> 32), __builtin_amdgcn_mbcnt_lo((unsigned)m, 0u)); }
constexpr int IDX_CAND = 512;
__device__ __forceinline__ void idx_scan(LAS unsigned* hrow, unsigned k_rem, int lane, unsigned& D, unsigned& above, unsigned& cD) {
    const int rl = 63 - lane;
    v4u w[4];
#pragma unroll
    for (int k = 0; k < 4; ++k) w[k] = *(const LAS v4u*)(hrow + 16 * rl + 4 * k);
    const unsigned wd[16] = {w[0].x, w[0].y, w[0].z, w[0].w, w[1].x, w[1].y, w[1].z, w[1].w, w[2].x, w[2].y, w[2].z, w[2].w, w[3].x, w[3].y, w[3].z, w[3].w};
    unsigned tot = 0u;
#pragma unroll
    for (int k = 0; k < 16; ++k) tot += (wd[k] & 0xffffu) + (wd[k] >> 16);
    unsigned v = tot;
#define IDX_DPP_ADD(ctrl, rmask, bmask) v += (unsigned)__builtin_amdgcn_update_dpp(0, (int)v, ctrl, rmask, bmask, false)
    IDX_DPP_ADD(0x111, 0xf, 0xf); IDX_DPP_ADD(0x112, 0xf, 0xf); IDX_DPP_ADD(0x114, 0xf, 0xe); IDX_DPP_ADD(0x118, 0xf, 0xc); IDX_DPP_ADD(0x142, 0xa, 0xf); IDX_DPP_ADD(0x143, 0xc, 0xf);
#undef IDX_DPP_ADD
    const unsigned sx = v - tot;
    const bool mine = (sx < k_rem) && (k_rem <= sx + tot);
    unsigned S = sx + tot, kw = 0u, alw = sx, xw = 0u;
#pragma unroll
    for (int k = 0; k < 16; ++k) { const unsigned wsk = (wd[k] & 0xffffu) + (wd[k] >> 16), Sn = S - wsk; const bool ge = S >= k_rem;
        xw = ge ? wd[k] : xw; alw = ge ? Sn : alw; kw = ge ? (unsigned)k : kw; S = Sn; }
    const unsigned chi = xw >> 16, clo = xw & 0xffffu;
    const bool inhi = alw + chi >= k_rem;
    const unsigned Dl = (unsigned)(32 * rl) + 2u * kw + (inhi ? 1u : 0u), al = inhi ? alw : alw + chi, cl = inhi ? chi : clo;
    const unsigned long long bal = __ballot(mine); const int Ls = bal ? (__ffsll((long long)bal) - 1) : 0;
    D = (unsigned)__builtin_amdgcn_readlane((int)Dl, Ls); above = (unsigned)__builtin_amdgcn_readlane((int)al, Ls); cD = (unsigned)__builtin_amdgcn_readlane((int)cl, Ls);
#pragma unroll
    for (int k = 0; k < 4; ++k) *(LAS v4u*)(hrow + 16 * rl + 4 * k) = (v4u){0u, 0u, 0u, 0u};
}
__device__ __forceinline__ void indexer_phase(LAS unsigned char* lds, const bf16* QI, const bf16* KIW, const bf16* KIT, int* IDX, int c, int G, int tid, int wave, int lane) {
    LAS unsigned* sc = (LAS unsigned*)lds;
    LAS unsigned* hist = (LAS unsigned*)(lds + 131072);
    LAS int* cand = (LAS int*)(lds + 131072 + 16384);
    volatile LAS unsigned* st = (volatile LAS unsigned*)(lds + 131072 + 16384 + 8192);
    for (int i = tid; i < 4096; i += NWAVES * 64) hist[i] = 0u;
    __syncthreads();
    const int q = wave >> 1, half = wave & 1;
    const int r32 = lane & 31, hf = lane >> 5;
    constexpr int NU = M / 4;
    for (int rnd = 0; rnd * G < NU; ++rnd) {
        const int L = rnd * G + ((rnd & 1) ? (G - 1 - c) : c);
        if (L >= NU) continue;
        const int b = L & 1, t0 = (L >> 1) * 4; const size_t tok0 = (size_t)b * SEQ;
        const int t = t0 + q, n = t + 1;
        GAS int* orow = (GAS int*)(IDX + (tok0 + t) * TOPK);
        if (t0 + 4 <= TOPK) {
#pragma unroll
            for (int j = 0; j < 2; ++j) { const int p = half * 128 + j * 64 + lane; orow[p] = p < n ? p : -1; }
            continue;
        }
#ifndef IDX_REP_SCORE
#define IDX_REP_SCORE 1
#endif
        for (int srep = 0; srep < IDX_REP_SCORE; ++srep) {
            const int ntiles = (t0 + 4 + 31) >> 5;
            const int nmine = (ntiles - wave + NWAVES - 1) / NWAVES;
            const GAS bf16* kbase = (const GAS bf16*)(KIT + (tok0 >> 5) * (4 * 64 * 8) + lane * 8);
            bf16x8 B0[4], B1[4], B2[4];
#define IDX_LOAD(Bx, i) do { const int ii_ = (i) < nmine ? (i) : nmine - 1; const GAS bf16* ks_ = kbase + (size_t)(wave + NWAVES * ii_) * (4 * 64 * 8); _Pragma("unroll") for (int ks = 0; ks < 4; ++ks) Bx[ks] = *(const GAS bf16x8*)(ks_ + ks * (64 * 8)); } while (0)
            IDX_LOAD(B0, 0); IDX_LOAD(B1, 1);
            bf16x8 A[2][4]; float wgt[2][16];
            const int ql = (r32 >> 2) & 1, h = (r32 & 3) + 4 * (r32 >> 3);
#pragma unroll
            for (int rb = 0; rb < 2; ++rb) { const GAS bf16* src = (const GAS bf16*)(QI + (tok0 + t0 + 2 * rb + ql) * 1024 + h * 64 + 8 * hf);
#pragma unroll
                for (int ks = 0; ks < 4; ++ks) A[rb][ks] = *(const GAS bf16x8*)(src + ks * 16); }
#pragma unroll
            for (int rb = 0; rb < 2; ++rb) { const GAS bf16* wsrc = (const GAS bf16*)(KIW + (tok0 + t0 + 2 * rb + hf) * 256 + 64);
                const v4u w0 = *(const GAS v4u*)wsrc, w1 = *(const GAS v4u*)(wsrc + 8);
                const unsigned ww[8] = {w0.x, w0.y, w0.z, w0.w, w1.x, w1.y, w1.z, w1.w};
#pragma unroll
                for (int i = 0; i < 8; ++i) { wgt[rb][2 * i] = __uint_as_float(ww[i] << 16) * (1.f / 32.f); wgt[rb][2 * i + 1] = __uint_as_float(ww[i] & 0xffff0000u) * (1.f / 32.f); } }
#define IDX_PROBE_ATOM
#define IDX_TILE(Bx, i) do { if ((i) < nmine) { const int j_ = wave + NWAVES * (i); \
                f32x16 acc0, acc1; _Pragma("unroll") for (int e = 0; e < 16; ++e) { acc0[e] = 0.f; acc1[e] = 0.f; } \
                _Pragma("unroll") for (int ks = 0; ks < 4; ++ks) { acc0 = __builtin_amdgcn_mfma_f32_32x32x16_bf16(A[0][ks], Bx[ks], acc0, 0, 0, 0); acc1 = __builtin_amdgcn_mfma_f32_32x32x16_bf16(A[1][ks], Bx[ks], acc1, 0, 0, 0); }     \
                _Pragma("unroll") for (int rb = 0; rb < 2; ++rb) { \
                    float sa_ = 0.f, sb_ = 0.f, sc_ = 0.f, sd_ = 0.f;                                                                   \
                    _Pragma("unroll") for (int e = 0; e < 4; ++e) { const float x0 = rb ? acc1[e] : acc0[e], x1 = rb ? acc1[e + 4] : acc0[e + 4], x2 = rb ? acc1[e + 8] : acc0[e + 8], x3 = rb ? acc1[e + 12] : acc0[e + 12]; \
                        sa_ = fmaf(wgt[rb][e], __int_as_float(max(__float_as_int(x0), 0)), sa_); sb_ = fmaf(wgt[rb][e + 4], __int_as_float(max(__float_as_int(x1), 0)), sb_); \
                        sc_ = fmaf(wgt[rb][e + 8], __int_as_float(max(__float_as_int(x2), 0)), sc_); sd_ = fmaf(wgt[rb][e + 12], __int_as_float(max(__float_as_int(x3), 0)), sd_); } \
                    const float s_ = (sa_ + sb_) + (sc_ + sd_); \
                    const int tq_ = t0 + 2 * rb + hf, key_ = j_ * 32 + r32; const bool ok_ = key_ <= tq_; const unsigned mk_ = ok_ ? mono_key(s_) : 0u; \
                    sc[(2 * rb + hf) * 8192 + key_] = mk_; \
                    if (ok_ && srep == 0) { __hip_atomic_fetch_add(hist + (2 * rb + hf) * 1024 + (mk_ >> 22), 1u << ((mk_ >> 17) & 16u), __ATOMIC_RELAXED, __HIP_MEMORY_SCOPE_WORKGROUP); IDX_PROBE_ATOM } } } } while (0)
#define IDX_TILE2(Bx, i) IDX_TILE(Bx, i)
#define IDX_LOAD2(Bx, i) IDX_LOAD(Bx, i)
#pragma unroll 1
            for (int i = 0; i < nmine; i += 3) {
                IDX_LOAD2(B2, i + 2); IDX_TILE2(B0, i);
                IDX_LOAD2(B0, i + 3); IDX_TILE2(B1, i + 1);
                IDX_LOAD2(B1, i + 4); IDX_TILE2(B2, i + 2);
            }
#undef IDX_TILE2
#undef IDX_LOAD2
#undef IDX_LOAD
#undef IDX_TILE
        }
        __syncthreads();
        LAS unsigned* srow = sc + q * 8192; LAS unsigned* hrow = hist + q * 1024; LAS int* crow = cand + q * IDX_CAND;
        if (half == 0) { unsigned D, above, cD; idx_scan(hrow, (unsigned)TOPK, lane, D, above, cD);
            if (lane == 0) { st[q * 4 + 0] = D << 21; st[q * 4 + 1] = (unsigned)TOPK - above; st[q * 4 + 2] = cD; } }
        __syncthreads();
        int shift = 21;
        while (shift > 0 && (st[2] > IDX_CAND || st[6] > IDX_CAND || st[10] > IDX_CAND || st[14] > IDX_CAND)) {
            const unsigned prefix = st[q * 4 + 0], k_rem = st[q * 4 + 1]; const int nshift = shift > 11 ? shift - 11 : 0; const unsigned dmask = (1u << (shift - nshift)) - 1u;
            const int nh_ = ((n >> 1) + 63) & ~63; const int lo_ = half ? nh_ : 0, hi_ = half ? n : (nh_ < n ? nh_ : n);
            __syncthreads();
            for (int i = lo_ + lane; i < hi_; i += 64) { const unsigned key = srow[i];
                if ((key >> shift) == (prefix >> shift)) { const unsigned d = (key >> nshift) & dmask; __hip_atomic_fetch_add(hrow + (d >> 1), 1u << (16 * (d & 1)), __ATOMIC_RELAXED, __HIP_MEMORY_SCOPE_WORKGROUP); } }
            __syncthreads();
            if (half == 0) { unsigned D, above, cD; idx_scan(hrow, k_rem, lane, D, above, cD);
                if (lane == 0) { st[q * 4 + 0] = prefix | (D << nshift); st[q * 4 + 1] = k_rem - above; st[q * 4 + 2] = cD; } }
            __syncthreads();
            shift = nshift;
        }
        const unsigned prefix = st[q * 4 + 0]; const int need = (int)st[q * 4 + 1], cD = (int)st[q * 4 + 2], c_gt = TOPK - need;
        const unsigned tp = prefix >> shift; const bool exact_dup = cD > IDX_CAND;
        const int nh = ((n >> 1) + 63) & ~63; const int lo = half ? nh : 0, hi = half ? n : (nh < n ? nh : n);
        if (exact_dup) {
          if (half == 0) {
            int cg = 0, ce = 0;
            for (int base = 0; base < n; base += 64) { const int i = base + lane; const unsigned kp = (i < n) ? srow[i] : 0u;
                const bool gt = (i < hi) && kp > tp, eq = (i < n) && kp == tp;
                const unsigned long long mg = __ballot(gt), me = __ballot(eq);
                const int pg = cg + mbcnt64(mg), pe = ce + mbcnt64(me);
                if (gt) orow[pg] = i;
                if (eq && pe < need) orow[c_gt + pe] = i;
                cg += __popcll(mg); ce += __popcll(me); }
          } else if (hi > lo) {
            int cg = 0;
            for (int base = lo + ((hi - 1 - lo) & ~63); base >= lo; base -= 64) { const int i = base + lane; const bool in = i < hi; const unsigned kp = in ? srow[i] : 0u;
                const bool gt = in && kp > tp; const unsigned long long mg = __ballot(gt);
                const int ag = __popcll(mg) - mbcnt64(mg) - (gt ? 1 : 0);
                if (gt) orow[c_gt - 1 - cg - ag] = i;
                cg += __popcll(mg); }
          }
        } else {
          LAS unsigned short* hl_ = (LAS unsigned short*)hrow + half * 1024;
          int nhit = 0;
          for (int base = lo; base < hi; base += 256) {
              const int i0 = base + 4 * lane; const v4u k4 = (i0 < hi) ? *(const LAS v4u*)(srow + i0) : (v4u){0u, 0u, 0u, 0u};
              const bool h0 = (i0 < hi) && (k4.x >> shift) >= tp, h1 = (i0 + 1 < hi) && (k4.y >> shift) >= tp, h2 = (i0 + 2 < hi) && (k4.z >> shift) >= tp, h3 = (i0 + 3 < hi) && (k4.w >> shift) >= tp;
              const int cnt = (int)h0 + (int)h1 + (int)h2 + (int)h3;
              int v = cnt;
#define IDX_DPP_ADD(ctrl, rmask, bmask) v += __builtin_amdgcn_update_dpp(0, v, ctrl, rmask, bmask, false)
              IDX_DPP_ADD(0x111, 0xf, 0xf); IDX_DPP_ADD(0x112, 0xf, 0xf); IDX_DPP_ADD(0x114, 0xf, 0xe); IDX_DPP_ADD(0x118, 0xf, 0xc); IDX_DPP_ADD(0x142, 0xa, 0xf); IDX_DPP_ADD(0x143, 0xc, 0xf);
#undef IDX_DPP_ADD
              int p = nhit + v - cnt;
              if (h0) { hl_[p] = (unsigned short)i0; ++p; }
              if (h1) { hl_[p] = (unsigned short)(i0 + 1); ++p; }
              if (h2) { hl_[p] = (unsigned short)(i0 + 2); ++p; }
              if (h3) { hl_[p] = (unsigned short)(i0 + 3); }
              nhit += __builtin_amdgcn_readlane(v, 63);
          }
          if (half == 0) {
            int cg = 0, ce = 0;
            for (int j0 = 0; j0 < nhit; j0 += 64) { const int j = j0 + lane; const bool in = j < nhit; const int i = in ? (int)hl_[j] : 0; const unsigned kp = in ? (srow[i] >> shift) : 0u;
                const bool gt = in && kp > tp, eq = in && kp == tp;
                const unsigned long long mg = __ballot(gt), me = __ballot(eq);
                const int pg = cg + mbcnt64(mg), pe = ce + mbcnt64(me);
                if (gt) orow[pg] = i;
                if (eq) crow[pe] = i;
                cg += __popcll(mg); ce += __popcll(me); }
          } else if (nhit > 0) {
            int cg = 0, ce = 0;
            for (int j0 = (nhit - 1) & ~63; j0 >= 0; j0 -= 64) { const int j = j0 + lane; const bool in = j < nhit; const int i = in ? (int)hl_[j] : 0; const unsigned kp = in ? (srow[i] >> shift) : 0u;
                const bool gt = in && kp > tp, eq = in && kp == tp;
                const unsigned long long mg = __ballot(gt), me = __ballot(eq);
                const int ag = __popcll(mg) - mbcnt64(mg) - (gt ? 1 : 0), ae = __popcll(me) - mbcnt64(me) - (eq ? 1 : 0);
                if (gt) orow[c_gt - 1 - cg - ag] = i;
                if (eq) crow[cD - 1 - ce - ae] = i;
                cg += __popcll(mg); ce += __popcll(me); }
          }
        }
        __syncthreads();
#ifndef IDX_REP_TAIL
#define IDX_REP_TAIL 1
#endif
        for (int trep = 0; trep < IDX_REP_TAIL; ++trep)
        if (half == 0 && !exact_dup) {
#pragma unroll
            for (int k = 0; k < 4; ++k) *(LAS v4u*)(hrow + 16 * lane + 4 * k) = (v4u){0u, 0u, 0u, 0u};
            unsigned pfx = prefix, k_rem = (unsigned)need; int sh = shift;
            int ci[8]; unsigned ck[8];
#pragma unroll
            for (int m = 0; m < 8; ++m) { const int j = lane + 64 * m; ci[m] = j < cD ? crow[j] : 0; }
            __builtin_amdgcn_sched_barrier(0);
#pragma unroll
            for (int m = 0; m < 8; ++m) { const int j = lane + 64 * m; ck[m] = j < cD ? srow[ci[m]] : 0u; }
            __builtin_amdgcn_sched_barrier(0);
            while (sh > 0) {
                const int nsh = sh > 11 ? sh - 11 : 0; const unsigned dmask = (1u << (sh - nsh)) - 1u;
#pragma unroll
                for (int m = 0; m < 8; ++m) { const int j = lane + 64 * m; const unsigned key = ck[m];
                    if (j < cD && (key >> sh) == (pfx >> sh)) { const unsigned d = (key >> nsh) & dmask; __hip_atomic_fetch_add(hrow + (d >> 1), 1u << (16 * (d & 1)), __ATOMIC_RELAXED, __HIP_MEMORY_SCOPE_WORKGROUP); } }
                unsigned D, above, cDn; idx_scan(hrow, k_rem, lane, D, above, cDn);
                pfx |= D << nsh; k_rem -= above; sh = nsh;
            }
            int cg = 0, ce = 0; const int n_gt = need - (int)k_rem;
#pragma unroll
            for (int m = 0; m < 8; ++m) { const int j = lane + 64 * m; const bool in = j < cD; const unsigned key = ck[m];
                const bool gt = in && key > pfx, eq = in && key == pfx;
                const unsigned long long mg = __ballot(gt), me = __ballot(eq);
                const int pg = cg + mbcnt64(mg), pe = ce + mbcnt64(me);
                if (gt) orow[c_gt + pg] = ci[m];
                if (eq && pe < (int)k_rem) orow[c_gt + n_gt + pe] = ci[m];
                cg += __popcll(mg); ce += __popcll(me); }
        }
        __syncthreads();
    }
}
constexpr float ATT_SCALE = 0.08838834764831845f;
__device__ __forceinline__ unsigned pkbf(float lo, float hi) { return pg8::cvt_pk_bf16(lo, hi); }
__device__ __forceinline__ void dsa_attn_phase(LAS unsigned char* lds, const bf16* Q, const unsigned char* KV8, const int* IDX, bf16* AO, const float* rel_bias, int c, int G, int tid, int wave, int lane) {
    typedef int v4i __attribute__((ext_vector_type(4))); typedef float f32x2 __attribute__((ext_vector_type(2)));
    constexpr int KSTR = 144, VSTR = 272, WBYTES = 32 * KSTR + 32 * VSTR;
    LAS unsigned char* kb = lds + wave * WBYTES; LAS unsigned char* vb = kb + 32 * KSTR;
    LAS int* idl = (LAS int*)(lds + NWAVES * WBYTES + wave * 2048);
    LAS float* tab = (LAS float*)(lds + NWAVES * WBYTES + NWAVES * 2048);
    build_bias_tab(tab, rel_bias, tid);
    __syncthreads();
    const int hl = lane & 15, Gq = lane >> 4, hsel = hl & 3, qrow = hl >> 2, pcol = lane & 3;
    const int NGW = G * NWAVES;
    const int uid0 = c * NWAVES + wave, nun = (8 * SEQ - uid0 + NGW - 1) / NGW;
    v4i ivn; v4u qraw[4];
#define DSA_UNIT(u_, k_, bg_, t_, tok_) const int u_ = uid0 + ((k_) < nun ? (k_) : nun - 1) * NGW; const int bg_ = (u_ >> 3) & 7, t_ = ((u_ >> 6) << 3) | (u_ & 7); const size_t tok_ = (size_t)(bg_ >> 2) * SEQ + t_
    { DSA_UNIT(ua_, 0, bg0, t0_, tok0); ivn = *(const GAS v4i*)(IDX + tok0 * TOPK + lane * 4);
      const GAS bf16* qs = (const GAS bf16*)(Q + tok0 * DM + ((bg0 & 3) * 4 + hsel) * HDIM + 8 * Gq);
#pragma unroll
      for (int ks = 0; ks < 4; ++ks) qraw[ks] = *(const GAS v4u*)(qs + ks * 32);
      *(LAS v4i*)(idl + lane * 4) = ivn; }
    v4u stk[4], stv[4];
#define DSA_RSRC(bg_) __builtin_amdgcn_make_buffer_rsrc((void*)(((unsigned long long)(unsigned)__builtin_amdgcn_readfirstlane((int)(unsigned)(((unsigned long long)(KV8 + (size_t)(bg_) * SEQ * 256)) >> 32)) << 32) | (unsigned)__builtin_amdgcn_readfirstlane((int)(unsigned)(unsigned long long)(KV8 + (size_t)(bg_) * SEQ * 256))), (short)0, SEQ * 256, 0x00020000)
#define DSA_LOAD(idp, cc, rs_) { int sj_[4]; _Pragma("unroll") for (int j = 0; j < 4; ++j) sj_[j] = (idp)[(cc) * 32 + 8 * j + (lane >> 3)]; __builtin_amdgcn_sched_barrier(0); \
        _Pragma("unroll") for (int j = 0; j < 4; ++j) { const int vo_ = (max(sj_[j], 0) << 8) + (lane & 7) * 16; stk[j] = __builtin_bit_cast(v4u, __builtin_amdgcn_raw_buffer_load_b128(rs_, vo_, 0, 0)); stv[j] = __builtin_bit_cast(v4u, __builtin_amdgcn_raw_buffer_load_b128(rs_, vo_ + 128, 0, 0)); } }
    { DSA_UNIT(ub_, 0, bg0, t0_, tok0); (void)t0_; (void)tok0; const __amdgpu_buffer_rsrc_t rs0 = DSA_RSRC(bg0); DSA_LOAD(idl, 0, rs0) }
    for (int k = 0; k < nun; ++k) {
        DSA_UNIT(uc_, k, bg, t, tok); const int b = bg >> 2, g = bg & 3; (void)b;
        LAS int* idc = idl + (k & 1) * 256; LAS int* idn = idl + ((k + 1) & 1) * 256;
        long qf[4];
#pragma unroll
        for (int ks = 0; ks < 4; ++ks) { const v4u v = qraw[ks];
            int w0 = __builtin_amdgcn_cvt_pk_fp8_f32(__uint_as_float(v.x << 16) * 16.f, __uint_as_float(v.x & 0xffff0000u) * 16.f, 0, false); w0 = __builtin_amdgcn_cvt_pk_fp8_f32(__uint_as_float(v.y << 16) * 16.f, __uint_as_float(v.y & 0xffff0000u) * 16.f, w0, true);
            int w1 = __builtin_amdgcn_cvt_pk_fp8_f32(__uint_as_float(v.z << 16) * 16.f, __uint_as_float(v.z & 0xffff0000u) * 16.f, 0, false); w1 = __builtin_amdgcn_cvt_pk_fp8_f32(__uint_as_float(v.w << 16) * 16.f, __uint_as_float(v.w & 0xffff0000u) * 16.f, w1, true);
            qf[ks] = hl < 4 ? (long)(((unsigned long long)(unsigned)w1 << 32) | (unsigned)w0) : 0L; }
        unsigned long long fastmask;
        { const int mn_ = min(min(ivn[0], ivn[1]), min(ivn[2], ivn[3])), mx_ = max(max(ivn[0], ivn[1]), max(ivn[2], ivn[3])); fastmask = __ballot(mn_ >= 0 && t - mx_ >= 128); }
        DSA_UNIT(un_, k + 1, bgn, tn, tokn); (void)tn;
        ivn = *(const GAS v4i*)(IDX + tokn * TOPK + lane * 4);
        { const GAS bf16* qs = (const GAS bf16*)(Q + tokn * DM + ((bgn & 3) * 4 + hsel) * HDIM + 8 * Gq);
#pragma unroll
          for (int ks = 0; ks < 4; ++ks) qraw[ks] = *(const GAS v4u*)(qs + ks * 32); }
        const __amdgpu_buffer_rsrc_t kvbn = DSA_RSRC(bgn), kvbase = DSA_RSRC(bg);
        const int hq = g * 4 + hsel; const float bfar = tab[128 * 16 + hq] * 1.4426950408889634f;
        float mrun = -3.0e38f, lsum = 0.f; f32x4 O[8];
#pragma unroll
        for (int db = 0; db < 8; ++db) O[db] = (f32x4){0.f, 0.f, 0.f, 0.f};
#pragma unroll 1
        for (int cc = 0; cc < 8; ++cc) {
#pragma unroll
            for (int j = 0; j < 4; ++j) { const int key = 8 * j + (lane >> 3), pc = lane & 7;
                *(LAS v4u*)(kb + key * KSTR + pc * 16) = stk[j];
                const unsigned w[4] = {stv[j].x, stv[j].y, stv[j].z, stv[j].w}; unsigned o[8];
#pragma unroll
                for (int e = 0; e < 4; ++e) { typedef __bf16 bf2_t __attribute__((ext_vector_type(2))); o[2 * e] = __builtin_bit_cast(unsigned, (bf2_t)__builtin_amdgcn_cvt_scalef32_pk_bf16_fp8(w[e], 1.0f, false)); o[2 * e + 1] = __builtin_bit_cast(unsigned, (bf2_t)__builtin_amdgcn_cvt_scalef32_pk_bf16_fp8(w[e], 1.0f, true)); }
                *(LAS v4u*)(vb + key * VSTR + pc * 32) = (v4u){o[0], o[1], o[2], o[3]}; *(LAS v4u*)(vb + key * VSTR + pc * 32 + 16) = (v4u){o[4], o[5], o[6], o[7]}; }
            if (cc < 7) { DSA_LOAD(idc, cc + 1, kvbase) } else { *(LAS v4i*)(idn + lane * 4) = ivn; DSA_LOAD(idn, 0, kvbn) }
            long ka[2][4];
#pragma unroll
            for (int rb = 0; rb < 2; ++rb)
#pragma unroll
                for (int ks = 0; ks < 4; ++ks) ka[rb][ks] = *(const LAS long*)(kb + (16 * rb + hl) * KSTR + ks * 32 + 8 * Gq);
            __builtin_amdgcn_sched_barrier(0);
            f32x4 S[2];
#pragma unroll
            for (int rb = 0; rb < 2; ++rb) S[rb] = (f32x4){0.f, 0.f, 0.f, 0.f};
#pragma unroll
            for (int ks = 0; ks < 4; ++ks)
#pragma unroll
                for (int rb = 0; rb < 2; ++rb) S[rb] = __builtin_amdgcn_mfma_f32_16x16x32_fp8_fp8(ka[rb][ks], qf[ks], S[rb], 0, 0, 0);
            float l[2][4]; float cmax = -3.0e38f;
            if (((fastmask >> (8 * cc)) & 0xFFull) == 0xFFull) {
#pragma unroll
                for (int rb = 0; rb < 2; ++rb)
#pragma unroll
                    for (int i = 0; i < 4; ++i) { const float v = fmaf(S[rb][i], ATT_SCALE * (1.f / 256.f) * 1.4426950408889634f, bfar); l[rb][i] = v; cmax = fmaxf(cmax, v); }
            } else {
                const v4i sv0 = *(const LAS v4i*)(idc + cc * 32 + 4 * Gq), sv1 = *(const LAS v4i*)(idc + cc * 32 + 16 + 4 * Gq);
#pragma unroll
                for (int rb = 0; rb < 2; ++rb)
#pragma unroll
                    for (int i = 0; i < 4; ++i) { const int s_ = rb ? sv1[i] : sv0[i]; int rel = t - s_; rel = rel > 128 ? 128 : (rel < 0 ? 0 : rel);
                        const float v = (s_ >= 0) ? (S[rb][i] * (ATT_SCALE * (1.f / 256.f)) + tab[rel * 16 + hq]) * 1.4426950408889634f : -1.0e30f; l[rb][i] = v; cmax = fmaxf(cmax, v); }
            }
            cmax = bfly32_max(bfly16_max(cmax));
            const float mnew = fmaxf(mrun, cmax);
            if (__any(mnew > mrun)) {
                const float alpha = __builtin_amdgcn_exp2f(mrun - mnew); lsum *= alpha;
#pragma unroll
                for (int db = 0; db < 8; ++db) O[db] = O[db] * alpha;
            }
            mrun = mnew;
            float ps = 0.f;
#pragma unroll
            for (int rb = 0; rb < 2; ++rb)
#pragma unroll
                for (int i = 0; i < 4; ++i) { l[rb][i] = __builtin_amdgcn_exp2f(l[rb][i] - mnew); ps += l[rb][i]; }
            lsum += ps;
            v4u pu; pu.x = pkbf(l[0][0], l[0][1]); pu.y = pkbf(l[0][2], l[0][3]); pu.z = pkbf(l[1][0], l[1][1]); pu.w = pkbf(l[1][2], l[1][3]);
            const bf16x8 pa = __builtin_bit_cast(bf16x8, pu);
            s16x4 vt[8][2];
#pragma unroll
            for (int db = 0; db < 8; ++db) { vt[db][0] = vtr(vb + (4 * Gq + qrow) * VSTR + (16 * db + 4 * pcol) * 2); vt[db][1] = vtr(vb + (16 + 4 * Gq + qrow) * VSTR + (16 * db + 4 * pcol) * 2); }
            __builtin_amdgcn_sched_barrier(0);
#pragma unroll
            for (int db = 0; db < 8; ++db) { const s16x4 v0 = vt[db][0], v1 = vt[db][1];
                const bf16x8 a = (bf16x8){v0[0], v0[1], v0[2], v0[3], v1[0], v1[1], v1[2], v1[3]};
                O[db] = __builtin_amdgcn_mfma_f32_16x16x32_bf16(a, pa, O[db], 0, 0, 0); }
        }
#undef DSA_LOAD
#undef DSA_RSRC
#undef DSA_UNIT
        lsum = bfly32_sum(bfly16_sum(lsum));
        const float inv = 1.0f / (lsum * 16.0f);
        if (hl < 4) { GAS bf16* op = (GAS bf16*)(AO + tok * DM + (g * 4 + hl) * HDIM + 4 * Gq);
#pragma unroll
            for (int db = 0; db < 8; ++db) { const f32x4 o = O[db] * inv; v2u w; w.x = pkbf(o[0], o[1]); w.y = pkbf(o[2], o[3]); *(GAS v2u*)(op + 16 * db) = w; } }
    }
}

__device__ __forceinline__ void swa_attn_phase(LAS unsigned char* lds, const bf16* Q, const bf16* KV, bf16* AO, const float* rel_bias, const float* sinks, int c, int G, int tid, int wave, int lane) {
    LAS unsigned char* band = lds;
    LAS float* tab = (LAS float*)(lds + 272 * 528);
    LAS float* tabM = tab + TAB_ENTRIES;
    build_bias_tab(tab, rel_bias, tid);
    for (int i = tid; i < 16 * 528 / 4; i += NWAVES * 64) ((LAS unsigned*)(band + 256 * 528))[i] = 0u;
    const int hl = lane & 15, Gq = lane >> 4, qrow = hl >> 2, pcol = lane & 3;
    for (int uid = c; uid < 512; uid += G) {
        const int b = uid >> 8, nb = (uid & 255) >> 2, g = uid & 3, bg = b * 4 + g;
        __syncthreads();
        { const int piece = tid & 31;
#pragma unroll 4
          for (int i = 0; i < 16; ++i) { const int row = (tid >> 5) + 16 * i, ka = nb * 128 - 128 + row; v4u v = (v4u){0u, 0u, 0u, 0u};
              if (ka >= 0) v = *(const GAS v4u*)(KV + ((size_t)bg * SEQ + ka) * 256 + piece * 8);
              *(LAS v4u*)(band + row * 528 + piece * 16) = v; } }
        for (int e = tid; e < 4 * 176; e += NWAVES * 64) { const int r = e / 176, rel = e - r * 176 - 31; tabM[e] = (rel >= 0 && rel < 128) ? tab[rel * 16 + g * 4 + r] * 1.4426950408889634f : -1.0e30f; }
        __syncthreads();
        const int ql = 16 * wave + hl, t = nb * 128 + ql, cbase = 16 * wave; const size_t tok = (size_t)b * SEQ + t;
        bf16x8 qn[4];
        { const GAS bf16* qs = (const GAS bf16*)(Q + tok * DM + (g * 4) * HDIM + 8 * Gq);
#pragma unroll
          for (int ks = 0; ks < 4; ++ks) qn[ks] = *(const GAS bf16x8*)(qs + ks * 32); }
#pragma unroll 1
        for (int r = 0; r < 4; ++r) {
            const int hq = g * 4 + r;
            bf16x8 qf[4];
#pragma unroll
            for (int ks = 0; ks < 4; ++ks) qf[ks] = qn[ks];
            { const GAS bf16* qs = (const GAS bf16*)(Q + tok * DM + (g * 4 + (r < 3 ? r + 1 : 3)) * HDIM + 8 * Gq);
#pragma unroll
              for (int ks = 0; ks < 4; ++ks) qn[ks] = *(const GAS bf16x8*)(qs + ks * 32); }
            f32x4 S[10];
#pragma unroll
            for (int rh = 0; rh < 2; ++rh) {
                bf16x8 ka[5][4];
#pragma unroll
                for (int r5 = 0; r5 < 5; ++r5)
#pragma unroll
                    for (int ks = 0; ks < 4; ++ks) ka[r5][ks] = *(const LAS bf16x8*)(band + (cbase + 16 * (5 * rh + r5) + hl) * 528 + (ks * 32 + 8 * Gq) * 2);
                __builtin_amdgcn_sched_barrier(0);
#pragma unroll
                for (int r5 = 0; r5 < 5; ++r5) S[5 * rh + r5] = (f32x4){0.f, 0.f, 0.f, 0.f};
#pragma unroll
                for (int ks = 0; ks < 4; ++ks)
#pragma unroll
                    for (int r5 = 0; r5 < 5; ++r5) S[5 * rh + r5] = __builtin_amdgcn_mfma_f32_16x16x32_bf16(ka[r5][ks], qf[ks], S[5 * rh + r5], 0, 0, 0);
            }
            const float sink2 = sinks[hq] * 1.4426950408889634f; float mx = sink2;
            const LAS float* tlow = tabM + r * 176 + (hl - 4 * Gq + 12);
            float bv[10][4];
#pragma unroll
            for (int rb = 0; rb < 10; ++rb)
#pragma unroll
                for (int i = 0; i < 4; ++i) bv[rb][i] = tlow[147 - 16 * rb - i];
#pragma unroll
            for (int rb = 0; rb < 10; ++rb)
#pragma unroll
                for (int i = 0; i < 4; ++i) S[rb][i] = S[rb][i] * (ATT_SCALE * 1.4426950408889634f) + bv[rb][i];
            if (nb == 0) {
#pragma unroll
                for (int rb = 0; rb < 8; ++rb) if (rb < 8 - wave) S[rb] = (f32x4){-1.0e30f, -1.0e30f, -1.0e30f, -1.0e30f};
            }
#pragma unroll
            for (int rb = 0; rb < 10; ++rb) mx = fmaxf(mx, fmaxf(fmaxf(S[rb][0], S[rb][1]), fmaxf(S[rb][2], S[rb][3])));
            mx = bfly32_max(bfly16_max(mx));
            float sum = 0.f;
#pragma unroll
            for (int rb = 0; rb < 10; ++rb)
#pragma unroll
                for (int i = 0; i < 4; ++i) { const float p = __builtin_amdgcn_exp2f(S[rb][i] - mx); S[rb][i] = p; sum += p; }
            sum = bfly32_sum(bfly16_sum(sum)); sum += __builtin_amdgcn_exp2f(sink2 - mx);
            const float inv = 1.0f / sum;
            f32x4 O[8];
#pragma unroll
            for (int db = 0; db < 8; ++db) O[db] = (f32x4){0.f, 0.f, 0.f, 0.f};
#pragma unroll
            for (int ch = 0; ch < 5; ++ch) {
                v4u pu; pu.x = pkbf(S[2 * ch][0], S[2 * ch][1]); pu.y = pkbf(S[2 * ch][2], S[2 * ch][3]); pu.z = pkbf(S[2 * ch + 1][0], S[2 * ch + 1][1]); pu.w = pkbf(S[2 * ch + 1][2], S[2 * ch + 1][3]);
                const bf16x8 pa = __builtin_bit_cast(bf16x8, pu);
                s16x4 vt[8][2];
#pragma unroll
                for (int db = 0; db < 8; ++db) { vt[db][0] = vtr(band + (cbase + 32 * ch + 4 * Gq + qrow) * 528 + 256 + (16 * db + 4 * pcol) * 2); vt[db][1] = vtr(band + (cbase + 32 * ch + 16 + 4 * Gq + qrow) * 528 + 256 + (16 * db + 4 * pcol) * 2); }
                __builtin_amdgcn_sched_barrier(0);
#pragma unroll
                for (int db = 0; db < 8; ++db) { const s16x4 v0 = vt[db][0], v1 = vt[db][1];
                    const bf16x8 a = (bf16x8){v0[0], v0[1], v0[2], v0[3], v1[0], v1[1], v1[2], v1[3]};
                    O[db] = __builtin_amdgcn_mfma_f32_16x16x32_bf16(a, pa, O[db], 0, 0, 0); }
            }
            GAS bf16* op = (GAS bf16*)(AO + tok * DM + hq * HDIM + 4 * Gq);
#pragma unroll
            for (int db = 0; db < 8; ++db) { const f32x4 o = O[db] * inv; v2u w; w.x = pkbf(o[0], o[1]); w.y = pkbf(o[2], o[3]); *(GAS v2u*)(op + 16 * db) = w; }
        }
    }
}
#ifndef REPP
#define REPP 1
#endif
#ifndef REP0
#define REP0 1
#endif
#ifndef REP1
#define REP1 1
#endif
#ifndef REP2
#define REP2 1
#endif
#ifndef REP3D
#define REP3D 1
#endif
#ifndef REP3S
#define REP3S 1
#endif
#ifndef REP4
#define REP4 1
#endif
#ifndef REP5
#define REP5 1
#endif
#ifndef REP6
#define REP6 1
#endif
#ifndef REP7
#define REP7 1
#endif
#ifndef REP8
#define REP8 1
#endif
#ifndef REP9
#define REP9 1
#endif
#ifndef REP10
#define REP10 1
#endif
#ifndef REP11
#define REP11 1
#endif
#ifndef DEFER_CONV
#define DEFER_CONV 1
#endif
#ifndef CONV_GG
#define CONV_GG 224
#endif
#ifndef GRP_BAR
#define GRP_BAR 1
#endif
#ifndef NOS1
#define NOS1 0
#endif
#ifndef NOS4
#define NOS4 0
#endif
#ifndef NOS6
#define NOS6 0
#endif
#ifndef NOS7
#define NOS7 0
#endif
#ifndef NOS8
#define NOS8 0
#endif
#ifndef NOS9
#define NOS9 0
#endif
#ifndef NOS11
#define NOS11 0
#endif

constexpr int PH_FINAL = 1 + 12 * DEPTH, PH_END = PH_FINAL + 1;
struct Args { const float* in[19]; float* out; unsigned char* ws; int ph_lo, ph_hi; };
__global__ void __launch_bounds__(NWAVES * 64, 2) yoco_fwd(Args args) {
    extern __shared__ __attribute__((aligned(16))) unsigned char lds_raw[];
    LAS unsigned char* lds = (LAS unsigned char*)lds_raw;
    volatile LAS unsigned* MISC = (volatile LAS unsigned*)(lds + MISC_OFF);
    const int tid = threadIdx.x, lane = tid & 63, wave = __builtin_amdgcn_readfirstlane(tid >> 6);
    const int G = gridDim.x, bx = blockIdx.x, vcu = (G % 8 == 0) ? (bx % 8) * (G / 8) + bx / 8 : bx;
    const int gw = vcu * NWAVES + wave, NGW = G * NWAVES;
    for (int u = tid; u < 64; u += NWAVES * 64) MISC[u] = 0u;
    __syncthreads();
    gu32* ctl = (gu32*)(args.ws + WS_CTL);
    XcdBarrier bar; bar.bar = (unsigned*)ctl + CW_BAR; bar.x = 0; bar.st = nullptr;
    if (!MK_PER_PHASE) bar = xcd_barrier_post((unsigned*)ctl + CW_BAR, MISC + 8);
#define GRID_BAR() do { if (!MK_PER_PHASE) xcd_barrier(bar); } while (0)
    unsigned* const grpw = (unsigned*)ctl + 64 * (8 * (bx % 8) + (bx / 8) % 8);
    if (!MK_PER_PHASE && G == 256 && tid == 0) __hip_atomic_store(grpw + 8 + (bx / 8) / 8, xb_xcc_id() + 1u, __ATOMIC_RELAXED, __HIP_MEMORY_SCOPE_AGENT);
#define GROUP_BAR() do { if (!MK_PER_PHASE) { if (GRP_BAR && gridDim.x == 256) grp_barrier(grpw, MISC + 10, bar.bar); else xcd_barrier(bar); } } while (0)
    const int lo = args.ph_lo, hi = args.ph_hi;
#define IN(k) (lo <= (k) && (k) < hi)
#define SITE() unsigned char* wsp = args.ws; float* Xp = args.out; int bxs = blockIdx.x, Gs = gridDim.x, tids = threadIdx.x; \
    asm volatile("" : "+s"(wsp), "+s"(Xp), "+s"(bxs), "+s"(Gs), "+v"(tids)); \
    const int lanes = tids & 63, waves = __builtin_amdgcn_readfirstlane(tids >> 6); \
    const int vcus = (Gs % 8 == 0) ? (bxs % 8) * (Gs / 8) + bxs / 8 : bxs, gws = vcus * NWAVES + waves, NGWs = Gs * NWAVES; (void)lanes; (void)gws; (void)NGWs; (void)Xp; (void)wsp
#define x_in (args.in[0])
#define X (Xp)
#define XN ((bf16*)(wsp + WS_XN))
#define Qb ((bf16*)(wsp + WS_Q))
#define AOb ((bf16*)(wsp + WS_AO))
#define QIb ((bf16*)(wsp + WS_QI))
#define KIWb ((bf16*)(wsp + WS_KIW))
#define IDXb ((int*)(wsp + WS_IDX))
#define KITb ((bf16*)(wsp + WS_KIT))
#define KVA ((bf16*)(wsp + WS_KVA))
#define KVB ((bf16*)(wsp + WS_KVB))
#define Ub ((bf16*)(wsp + WS_U))
#define PEb ((bf16*)(wsp + WS_PE))
#define PB ((bf16*)(wsp + WS_PB))
#define XNB2 ((bf16*)(wsp + WS_XNB))
#define SSQ(i) ((float*)(wsp + WS_SSP) + (size_t)(i) * M * 32)
#define RTAB ((LAS float*)(lds + RTAB_OFF))

#ifndef NO_PRO
    for (int rep = 0; rep < REPP; ++rep) if (IN(0)) { SITE();
        LAS float* scr = (LAS float*)(lds + waves * 16640);
        int rot = 0;
        for (int i = 0; i < N_A; ++i) conv_matrix(args.in[2] + (size_t)i * DM * A_IN, args.in[10] + (size_t)i * DM, DM, A_IN, (bf16*)(wsp + WS_WIN) + (size_t)i * A_INP * DM, 1, scr, gws, NGWs, lanes, rot);
        const bool defer = DEFER_CONV && Gs == 256;
        for (int i = 0; i < N_A; ++i) if (!(defer && i == 1)) conv_matrix(args.in[3] + (size_t)i * DM * DM, nullptr, DM, DM, (bf16*)(wsp + WS_WOA) + (size_t)i * DM * DM, 0, scr, gws, NGWs, lanes, rot);
        for (int i = 0; i < DEPTH - N_A; ++i) conv_matrix(args.in[4] + (size_t)i * DM * DM, args.in[10] + (size_t)(N_A + i) * DM, DM, DM, (bf16*)(wsp + WS_WQB) + (size_t)i * DM * DM, 0, scr, gws, NGWs, lanes, rot);
        for (int i = 0; i < DEPTH - N_A; ++i) conv_matrix(args.in[5] + (size_t)i * DM * DM, nullptr, DM, DM, (bf16*)(wsp + WS_WOB) + (size_t)i * DM * DM, 0, scr, gws, NGWs, lanes, rot);
        conv_matrix(args.in[8], args.in[7], DM, 1024, (bf16*)(wsp + WS_WKV), 2, scr, gws, NGWs, lanes, rot);
        for (int i = 0; i < DEPTH; ++i) if (!(defer && i == 1)) conv_matrix(args.in[17] + (size_t)i * DM * DM, args.in[15] + (size_t)i * DM, DM, DM, (bf16*)(wsp + WS_WPG) + (size_t)i * DM * DM, 0, scr, gws, NGWs, lanes, rot);
        for (int i = 0; i < DEPTH; ++i) conv_matrix(args.in[16] + (size_t)i * PLE * DM, nullptr, PLE, DM, (bf16*)(wsp + WS_WPE) + (size_t)i * DM * PLE, 0, scr, gws, NGWs, lanes, rot);
        for (int i = 0; i < DEPTH; ++i) if (!(defer && (i == 1 || i == 2))) conv_matrix(args.in[12] + (size_t)i * DM * DFF, args.in[11] + (size_t)i * DM, DM, DFF, (bf16*)(wsp + WS_W13) + (size_t)i * 2 * DFF * DM, 3, scr, gws, NGWs, lanes, rot);
        for (int i = 0; i < DEPTH; ++i) if (!(defer && (i == 1 || i == 2))) conv_matrix(args.in[13] + (size_t)i * DM * DFF, args.in[11] + (size_t)i * DM, DM, DFF, (bf16*)(wsp + WS_W13) + (size_t)i * 2 * DFF * DM, 4, scr, gws, NGWs, lanes, rot);
        for (int i = 0; i < DEPTH; ++i) if (!(defer && i == 2)) conv_matrix(args.in[14] + (size_t)i * DFF * DM, nullptr, DFF, DM, (bf16*)(wsp + WS_W2) + (size_t)i * DM * DFF, 0, scr, gws, NGWs, lanes, rot);
        const size_t gt = (size_t)vcus * (NWAVES * 64) + tids, NT = (size_t)Gs * (NWAVES * 64);
        for (int i = 0; i < N_A; ++i) { GAS v4u* z = (GAS v4u*)((bf16*)(wsp + WS_WIN) + ((size_t)i * A_INP + A_IN) * DM);
            for (size_t e = gt; e < (size_t)(A_INP - A_IN) * DM / 8; e += NT) z[e] = (v4u){0u, 0u, 0u, 0u}; }
        { const GAS f32x4* ps = (const GAS f32x4*)args.in[1]; GAS v4u* pd = (GAS v4u*)PB;
          for (size_t e = gt; e < (size_t)DEPTH * M * PLE / 8; e += 4 * NT) { f32x4 a[4], b[4];
#pragma unroll
              for (int u = 0; u < 4; ++u) { a[u] = ps[2 * (e + u * NT)]; b[u] = ps[2 * (e + u * NT) + 1]; }
#pragma unroll
              for (int u = 0; u < 4; ++u) { v4u o; o.x = pk2(a[u].x, a[u].y); o.y = pk2(a[u].z, a[u].w); o.z = pk2(b[u].x, b[u].y); o.w = pk2(b[u].z, b[u].w); pd[e + u * NT] = o; } } }
        xb_phase(x_in, XNB2, SSQ(12), gws, NGWs, lanes);
        GRID_BAR();
    }
#endif

    { constexpr int L = 0;
        const int pb = 1 + 12 * L; const bool dsa = L < N_A; const int Lb = L - N_A;
        for (int rep = 0; rep < REP1; ++rep) if (IN(pb + 1) && !NOS1) { SITE();
            const bf16* Bt = dsa ? (const bf16*)(wsp + WS_WIN) + (size_t)L * A_INP * DM : (const bf16*)(wsp + WS_WQB) + (size_t)Lb * DM * DM; const int N = dsa ? A_INP : DM;
            const bool part = DEFER_CONV && dsa && Gs == 256; const int Gg = part ? CONV_GG : Gs;
            pg8::Gemm g{XNB2, Bt, M, N, DM, 1}; pg8::StaticOrder S; S.init(M, N, Gg, bxs); if (part && bxs >= Gg) S.nwg = 0;
            pg8::rs_finalize(RTAB, S, SSQ(L == 0 ? 12 : 3 * (L - 1) + 2), tids);
            pg8::EpiBf16Map E{dsa ? 1 : 0, Qb, DM, KVA, QIb, KIWb, RTAB, KITb};
            pg8::gemm_phase<pg8::EpiBf16Map, pg8::StaticOrder, true, true>(lds, g, S, E);
            if (part && rep == 0 && bxs >= Gg) {
                __syncthreads();
                LAS float* scr = (LAS float*)(lds + waves * 16640); int rot = 0; const int gw2 = (bxs - Gg) * NWAVES + waves, NGW2 = (Gs - Gg) * NWAVES; const int Ld = L + 1;
                conv_matrix(args.in[12] + (size_t)Ld * DM * DFF, args.in[11] + (size_t)Ld * DM, DM, DFF, (bf16*)(wsp + WS_W13) + (size_t)Ld * 2 * DFF * DM, 3, scr, gw2, NGW2, lanes, rot);
                conv_matrix(args.in[13] + (size_t)Ld * DM * DFF, args.in[11] + (size_t)Ld * DM, DM, DFF, (bf16*)(wsp + WS_W13) + (size_t)Ld * 2 * DFF * DM, 4, scr, gw2, NGW2, lanes, rot);
                if (L == 0) { conv_matrix(args.in[17] + (size_t)1 * DM * DM, args.in[15] + (size_t)1 * DM, DM, DM, (bf16*)(wsp + WS_WPG) + (size_t)1 * DM * DM, 0, scr, gw2, NGW2, lanes, rot);
                              conv_matrix(args.in[3] + (size_t)1 * DM * DM, nullptr, DM, DM, (bf16*)(wsp + WS_WOA) + (size_t)1 * DM * DM, 0, scr, gw2, NGW2, lanes, rot); }
                else conv_matrix(args.in[14] + (size_t)2 * DFF * DM, nullptr, DFF, DM, (bf16*)(wsp + WS_W2) + (size_t)2 * DM * DFF, 0, scr, gw2, NGW2, lanes, rot);
            }
            GRID_BAR();
        }
#ifndef NO_IDX
        for (int rep = 0; rep < REP2; ++rep) if (dsa && IN(pb + 2)) { SITE(); indexer_phase(lds, QIb, KIWb, KITb, IDXb, bxs, Gs, tids, waves, lanes); GRID_BAR(); }
#endif
        for (int rep = 0; rep < (dsa ? REP3D : REP3S); ++rep) if (IN(pb + 3)) { SITE();
#ifndef NO_DSA
            if (dsa) dsa_attn_phase(lds, Qb, (const unsigned char*)KVA, IDXb, AOb, args.in[9], bxs, Gs, tids, waves, lanes);
#endif
#ifndef NO_SWA
            if (!dsa) swa_attn_phase(lds, Qb, KVB, AOb, args.in[9], args.in[6] + (size_t)Lb * NHEAD, bxs, Gs, tids, waves, lanes);
#endif
            GRID_BAR();
        }
        for (int rep = 0; rep < REP4; ++rep) if (IN(pb + 4) && !NOS4) { SITE();
            const bf16* Bt = dsa ? (const bf16*)(wsp + WS_WOA) + (size_t)L * DM * DM : (const bf16*)(wsp + WS_WOB) + (size_t)Lb * DM * DM;
            pg8::Gemm g{AOb, Bt, M, DM, DM}; pg8::StaticOrder S; S.init(M, DM, Gs, bxs);
            pg8::EpiResid E{XNB2, rep ? Qb : XN, rep ? (float*)(wsp + WS_QI) : SSQ(3 * L)};
            pg8::gemm_phase<pg8::EpiResid, pg8::StaticOrder, true, true>(lds, g, S, E);
            GRID_BAR();
        }
        for (int rep = 0; rep < REP6; ++rep) if (IN(pb + 6) && !NOS6) { SITE();
            pg8::Gemm g{XN, (const bf16*)(wsp + WS_W13) + (size_t)L * 2 * DFF * DM, M, 2 * DFF, DM, 1}; pg8::StaticOrder S; S.init(M, 2 * DFF, Gs, bxs);
            pg8::rs_finalize(RTAB, S, SSQ(3 * L), tids);
            pg8::EpiSwiglu E{Ub, RTAB};
            pg8::gemm_phase<pg8::EpiSwiglu, pg8::StaticOrder, true, true>(lds, g, S, E);
            GROUP_BAR();
        }
        for (int rep = 0; rep < REP7; ++rep) if (IN(pb + 7) && !NOS7) { SITE();
            { pg8::Gemm g{Ub, (const bf16*)(wsp + WS_W2) + (size_t)L * DM * DFF, M, DM, DFF, 1}; pg8::StaticOrder S; S.init(M, DM, Gs, bxs);
              pg8::EpiResid E{XN, rep ? XNB2 : XN, rep ? SSQ(3 * L + 2) : SSQ(3 * L + 1)};
              pg8::gemm_phase<pg8::EpiResid, pg8::StaticOrder, true, true>(lds, g, S, E); }
            { pg8::Gemm g{PB + (size_t)L * M * PLE, (const bf16*)(wsp + WS_WPE) + (size_t)L * DM * PLE, M, DM, PLE}; pg8::StaticOrder S; S.init(M, DM, Gs, bxs);
              pg8::EpiBf16Map E{3, PEb, DM, nullptr, nullptr, nullptr, nullptr, nullptr};
              pg8::gemm_phase<pg8::EpiBf16Map, pg8::StaticOrder, true, true>(lds, g, S, E); }
            GROUP_BAR();
        }
        for (int rep = 0; rep < REP9; ++rep) if (IN(pb + 9) && !NOS9) { SITE();
            pg8::Gemm g{XN, (const bf16*)(wsp + WS_WPG) + (size_t)L * DM * DM, M, DM, DM, 1}; pg8::StaticOrder S; S.init(M, DM, Gs, bxs);
            pg8::rs_finalize(RTAB, S, SSQ(3 * L + 1), tids);
            pg8::EpiGate E{XN, PEb, RTAB, rep ? Qb : XNB2, rep ? (float*)(wsp + WS_QI) : SSQ(3 * L + 2)};
            pg8::gemm_phase<pg8::EpiGate, pg8::StaticOrder, true, true>(lds, g, S, E);
            GRID_BAR();
        }
        if (L == N_A - 1) {
            for (int rep = 0; rep < REP11; ++rep) if (IN(pb + 11) && !NOS11) { SITE();
                pg8::Gemm g{XNB2, (const bf16*)(wsp + WS_WKV), M, 1024, DM, 1}; pg8::StaticOrder S; S.init(M, 1024, Gs, bxs);
                pg8::rs_finalize(RTAB, S, SSQ(3 * L + 2), tids);
                pg8::EpiBf16Map E{2, nullptr, 0, KVB, nullptr, nullptr, RTAB, nullptr};
                pg8::gemm_phase<pg8::EpiBf16Map, pg8::StaticOrder, true, true>(lds, g, S, E);
                GRID_BAR();
            }
        }
        }
    { constexpr int L = 1;
        const int pb = 1 + 12 * L; const bool dsa = L < N_A; const int Lb = L - N_A;
        for (int rep = 0; rep < REP1; ++rep) if (IN(pb + 1) && !NOS1) { SITE();
            const bf16* Bt = dsa ? (const bf16*)(wsp + WS_WIN) + (size_t)L * A_INP * DM : (const bf16*)(wsp + WS_WQB) + (size_t)Lb * DM * DM; const int N = dsa ? A_INP : DM;
            const bool part = DEFER_CONV && dsa && Gs == 256; const int Gg = part ? CONV_GG : Gs;
            pg8::Gemm g{XNB2, Bt, M, N, DM, 1}; pg8::StaticOrder S; S.init(M, N, Gg, bxs); if (part && bxs >= Gg) S.nwg = 0;
            pg8::rs_finalize(RTAB, S, SSQ(L == 0 ? 12 : 3 * (L - 1) + 2), tids);
            pg8::EpiBf16Map E{dsa ? 1 : 0, Qb, DM, KVA, QIb, KIWb, RTAB, KITb};
            pg8::gemm_phase<pg8::EpiBf16Map, pg8::StaticOrder, true, true>(lds, g, S, E);
            if (part && rep == 0 && bxs >= Gg) {
                __syncthreads();
                LAS float* scr = (LAS float*)(lds + waves * 16640); int rot = 0; const int gw2 = (bxs - Gg) * NWAVES + waves, NGW2 = (Gs - Gg) * NWAVES; const int Ld = L + 1;
                conv_matrix(args.in[12] + (size_t)Ld * DM * DFF, args.in[11] + (size_t)Ld * DM, DM, DFF, (bf16*)(wsp + WS_W13) + (size_t)Ld * 2 * DFF * DM, 3, scr, gw2, NGW2, lanes, rot);
                conv_matrix(args.in[13] + (size_t)Ld * DM * DFF, args.in[11] + (size_t)Ld * DM, DM, DFF, (bf16*)(wsp + WS_W13) + (size_t)Ld * 2 * DFF * DM, 4, scr, gw2, NGW2, lanes, rot);
                if (L == 0) { conv_matrix(args.in[17] + (size_t)1 * DM * DM, args.in[15] + (size_t)1 * DM, DM, DM, (bf16*)(wsp + WS_WPG) + (size_t)1 * DM * DM, 0, scr, gw2, NGW2, lanes, rot);
                              conv_matrix(args.in[3] + (size_t)1 * DM * DM, nullptr, DM, DM, (bf16*)(wsp + WS_WOA) + (size_t)1 * DM * DM, 0, scr, gw2, NGW2, lanes, rot); }
                else conv_matrix(args.in[14] + (size_t)2 * DFF * DM, nullptr, DFF, DM, (bf16*)(wsp + WS_W2) + (size_t)2 * DM * DFF, 0, scr, gw2, NGW2, lanes, rot);
            }
            GRID_BAR();
        }
#ifndef NO_IDX
        for (int rep = 0; rep < REP2; ++rep) if (dsa && IN(pb + 2)) { SITE(); indexer_phase(lds, QIb, KIWb, KITb, IDXb, bxs, Gs, tids, waves, lanes); GRID_BAR(); }
#endif
        for (int rep = 0; rep < (dsa ? REP3D : REP3S); ++rep) if (IN(pb + 3)) { SITE();
#ifndef NO_DSA
            if (dsa) dsa_attn_phase(lds, Qb, (const unsigned char*)KVA, IDXb, AOb, args.in[9], bxs, Gs, tids, waves, lanes);
#endif
#ifndef NO_SWA
            if (!dsa) swa_attn_phase(lds, Qb, KVB, AOb, args.in[9], args.in[6] + (size_t)Lb * NHEAD, bxs, Gs, tids, waves, lanes);
#endif
            GRID_BAR();
        }
        for (int rep = 0; rep < REP4; ++rep) if (IN(pb + 4) && !NOS4) { SITE();
            const bf16* Bt = dsa ? (const bf16*)(wsp + WS_WOA) + (size_t)L * DM * DM : (const bf16*)(wsp + WS_WOB) + (size_t)Lb * DM * DM;
            pg8::Gemm g{AOb, Bt, M, DM, DM}; pg8::StaticOrder S; S.init(M, DM, Gs, bxs);
            pg8::EpiResid E{XNB2, rep ? Qb : XN, rep ? (float*)(wsp + WS_QI) : SSQ(3 * L)};
            pg8::gemm_phase<pg8::EpiResid, pg8::StaticOrder, true, true>(lds, g, S, E);
            GRID_BAR();
        }
        for (int rep = 0; rep < REP6; ++rep) if (IN(pb + 6) && !NOS6) { SITE();
            pg8::Gemm g{XN, (const bf16*)(wsp + WS_W13) + (size_t)L * 2 * DFF * DM, M, 2 * DFF, DM, 1}; pg8::StaticOrder S; S.init(M, 2 * DFF, Gs, bxs);
            pg8::rs_finalize(RTAB, S, SSQ(3 * L), tids);
            pg8::EpiSwiglu E{Ub, RTAB};
            pg8::gemm_phase<pg8::EpiSwiglu, pg8::StaticOrder, true, true>(lds, g, S, E);
            GROUP_BAR();
        }
        for (int rep = 0; rep < REP7; ++rep) if (IN(pb + 7) && !NOS7) { SITE();
            { pg8::Gemm g{Ub, (const bf16*)(wsp + WS_W2) + (size_t)L * DM * DFF, M, DM, DFF, 1}; pg8::StaticOrder S; S.init(M, DM, Gs, bxs);
              pg8::EpiResid E{XN, rep ? XNB2 : XN, rep ? SSQ(3 * L + 2) : SSQ(3 * L + 1)};
              pg8::gemm_phase<pg8::EpiResid, pg8::StaticOrder, true, true>(lds, g, S, E); }
            { pg8::Gemm g{PB + (size_t)L * M * PLE, (const bf16*)(wsp + WS_WPE) + (size_t)L * DM * PLE, M, DM, PLE}; pg8::StaticOrder S; S.init(M, DM, Gs, bxs);
              pg8::EpiBf16Map E{3, PEb, DM, nullptr, nullptr, nullptr, nullptr, nullptr};
              pg8::gemm_phase<pg8::EpiBf16Map, pg8::StaticOrder, true, true>(lds, g, S, E); }
            GROUP_BAR();
        }
        for (int rep = 0; rep < REP9; ++rep) if (IN(pb + 9) && !NOS9) { SITE();
            pg8::Gemm g{XN, (const bf16*)(wsp + WS_WPG) + (size_t)L * DM * DM, M, DM, DM, 1}; pg8::StaticOrder S; S.init(M, DM, Gs, bxs);
            pg8::rs_finalize(RTAB, S, SSQ(3 * L + 1), tids);
            pg8::EpiGate E{XN, PEb, RTAB, rep ? Qb : XNB2, rep ? (float*)(wsp + WS_QI) : SSQ(3 * L + 2)};
            pg8::gemm_phase<pg8::EpiGate, pg8::StaticOrder, true, true>(lds, g, S, E);
            GRID_BAR();
        }
        if (L == N_A - 1) {
            for (int rep = 0; rep < REP11; ++rep) if (IN(pb + 11) && !NOS11) { SITE();
                pg8::Gemm g{XNB2, (const bf16*)(wsp + WS_WKV), M, 1024, DM, 1}; pg8::StaticOrder S; S.init(M, 1024, Gs, bxs);
                pg8::rs_finalize(RTAB, S, SSQ(3 * L + 2), tids);
                pg8::EpiBf16Map E{2, nullptr, 0, KVB, nullptr, nullptr, RTAB, nullptr};
                pg8::gemm_phase<pg8::EpiBf16Map, pg8::StaticOrder, true, true>(lds, g, S, E);
                GRID_BAR();
            }
        }
        }
    { constexpr int L = 2;
        const int pb = 1 + 12 * L; const bool dsa = L < N_A; const int Lb = L - N_A;
        for (int rep = 0; rep < REP1; ++rep) if (IN(pb + 1) && !NOS1) { SITE();
            const bf16* Bt = dsa ? (const bf16*)(wsp + WS_WIN) + (size_t)L * A_INP * DM : (const bf16*)(wsp + WS_WQB) + (size_t)Lb * DM * DM; const int N = dsa ? A_INP : DM;
            const bool part = DEFER_CONV && dsa && Gs == 256; const int Gg = part ? CONV_GG : Gs;
            pg8::Gemm g{XNB2, Bt, M, N, DM, 1}; pg8::StaticOrder S; S.init(M, N, Gg, bxs); if (part && bxs >= Gg) S.nwg = 0;
            pg8::rs_finalize(RTAB, S, SSQ(L == 0 ? 12 : 3 * (L - 1) + 2), tids);
            pg8::EpiBf16Map E{dsa ? 1 : 0, Qb, DM, KVA, QIb, KIWb, RTAB, KITb};
            pg8::gemm_phase<pg8::EpiBf16Map, pg8::StaticOrder, true, true>(lds, g, S, E);
            if (part && rep == 0 && bxs >= Gg) {
                __syncthreads();
                LAS float* scr = (LAS float*)(lds + waves * 16640); int rot = 0; const int gw2 = (bxs - Gg) * NWAVES + waves, NGW2 = (Gs - Gg) * NWAVES; const int Ld = L + 1;
                conv_matrix(args.in[12] + (size_t)Ld * DM * DFF, args.in[11] + (size_t)Ld * DM, DM, DFF, (bf16*)(wsp + WS_W13) + (size_t)Ld * 2 * DFF * DM, 3, scr, gw2, NGW2, lanes, rot);
                conv_matrix(args.in[13] + (size_t)Ld * DM * DFF, args.in[11] + (size_t)Ld * DM, DM, DFF, (bf16*)(wsp + WS_W13) + (size_t)Ld * 2 * DFF * DM, 4, scr, gw2, NGW2, lanes, rot);
                if (L == 0) { conv_matrix(args.in[17] + (size_t)1 * DM * DM, args.in[15] + (size_t)1 * DM, DM, DM, (bf16*)(wsp + WS_WPG) + (size_t)1 * DM * DM, 0, scr, gw2, NGW2, lanes, rot);
                              conv_matrix(args.in[3] + (size_t)1 * DM * DM, nullptr, DM, DM, (bf16*)(wsp + WS_WOA) + (size_t)1 * DM * DM, 0, scr, gw2, NGW2, lanes, rot); }
                else conv_matrix(args.in[14] + (size_t)2 * DFF * DM, nullptr, DFF, DM, (bf16*)(wsp + WS_W2) + (size_t)2 * DM * DFF, 0, scr, gw2, NGW2, lanes, rot);
            }
            GRID_BAR();
        }
#ifndef NO_IDX
        for (int rep = 0; rep < REP2; ++rep) if (dsa && IN(pb + 2)) { SITE(); indexer_phase(lds, QIb, KIWb, KITb, IDXb, bxs, Gs, tids, waves, lanes); GRID_BAR(); }
#endif
        for (int rep = 0; rep < (dsa ? REP3D : REP3S); ++rep) if (IN(pb + 3)) { SITE();
#ifndef NO_DSA
            if (dsa) dsa_attn_phase(lds, Qb, (const unsigned char*)KVA, IDXb, AOb, args.in[9], bxs, Gs, tids, waves, lanes);
#endif
#ifndef NO_SWA
            if (!dsa) swa_attn_phase(lds, Qb, KVB, AOb, args.in[9], args.in[6] + (size_t)Lb * NHEAD, bxs, Gs, tids, waves, lanes);
#endif
            GRID_BAR();
        }
        for (int rep = 0; rep < REP4; ++rep) if (IN(pb + 4) && !NOS4) { SITE();
            const bf16* Bt = dsa ? (const bf16*)(wsp + WS_WOA) + (size_t)L * DM * DM : (const bf16*)(wsp + WS_WOB) + (size_t)Lb * DM * DM;
            pg8::Gemm g{AOb, Bt, M, DM, DM}; pg8::StaticOrder S; S.init(M, DM, Gs, bxs);
            pg8::EpiResid E{XNB2, rep ? Qb : XN, rep ? (float*)(wsp + WS_QI) : SSQ(3 * L)};
            pg8::gemm_phase<pg8::EpiResid, pg8::StaticOrder, true, true>(lds, g, S, E);
            GRID_BAR();
        }
        for (int rep = 0; rep < REP6; ++rep) if (IN(pb + 6) && !NOS6) { SITE();
            pg8::Gemm g{XN, (const bf16*)(wsp + WS_W13) + (size_t)L * 2 * DFF * DM, M, 2 * DFF, DM, 1}; pg8::StaticOrder S; S.init(M, 2 * DFF, Gs, bxs);
            pg8::rs_finalize(RTAB, S, SSQ(3 * L), tids);
            pg8::EpiSwiglu E{Ub, RTAB};
            pg8::gemm_phase<pg8::EpiSwiglu, pg8::StaticOrder, true, true>(lds, g, S, E);
            GROUP_BAR();
        }
        for (int rep = 0; rep < REP7; ++rep) if (IN(pb + 7) && !NOS7) { SITE();
            { pg8::Gemm g{Ub, (const bf16*)(wsp + WS_W2) + (size_t)L * DM * DFF, M, DM, DFF, 1}; pg8::StaticOrder S; S.init(M, DM, Gs, bxs);
              pg8::EpiResid E{XN, rep ? XNB2 : XN, rep ? SSQ(3 * L + 2) : SSQ(3 * L + 1)};
              pg8::gemm_phase<pg8::EpiResid, pg8::StaticOrder, true, true>(lds, g, S, E); }
            { pg8::Gemm g{PB + (size_t)L * M * PLE, (const bf16*)(wsp + WS_WPE) + (size_t)L * DM * PLE, M, DM, PLE}; pg8::StaticOrder S; S.init(M, DM, Gs, bxs);
              pg8::EpiBf16Map E{3, PEb, DM, nullptr, nullptr, nullptr, nullptr, nullptr};
              pg8::gemm_phase<pg8::EpiBf16Map, pg8::StaticOrder, true, true>(lds, g, S, E); }
            GROUP_BAR();
        }
        for (int rep = 0; rep < REP9; ++rep) if (IN(pb + 9) && !NOS9) { SITE();
            pg8::Gemm g{XN, (const bf16*)(wsp + WS_WPG) + (size_t)L * DM * DM, M, DM, DM, 1}; pg8::StaticOrder S; S.init(M, DM, Gs, bxs);
            pg8::rs_finalize(RTAB, S, SSQ(3 * L + 1), tids);
            pg8::EpiGate E{XN, PEb, RTAB, rep ? Qb : XNB2, rep ? (float*)(wsp + WS_QI) : SSQ(3 * L + 2)};
            pg8::gemm_phase<pg8::EpiGate, pg8::StaticOrder, true, true>(lds, g, S, E);
            GRID_BAR();
        }
        if (L == N_A - 1) {
            for (int rep = 0; rep < REP11; ++rep) if (IN(pb + 11) && !NOS11) { SITE();
                pg8::Gemm g{XNB2, (const bf16*)(wsp + WS_WKV), M, 1024, DM, 1}; pg8::StaticOrder S; S.init(M, 1024, Gs, bxs);
                pg8::rs_finalize(RTAB, S, SSQ(3 * L + 2), tids);
                pg8::EpiBf16Map E{2, nullptr, 0, KVB, nullptr, nullptr, RTAB, nullptr};
                pg8::gemm_phase<pg8::EpiBf16Map, pg8::StaticOrder, true, true>(lds, g, S, E);
                GRID_BAR();
            }
        }
        }
    { constexpr int L = 3;
        const int pb = 1 + 12 * L; const bool dsa = L < N_A; const int Lb = L - N_A;
        for (int rep = 0; rep < REP1; ++rep) if (IN(pb + 1) && !NOS1) { SITE();
            const bf16* Bt = dsa ? (const bf16*)(wsp + WS_WIN) + (size_t)L * A_INP * DM : (const bf16*)(wsp + WS_WQB) + (size_t)Lb * DM * DM; const int N = dsa ? A_INP : DM;
            const bool part = DEFER_CONV && dsa && Gs == 256; const int Gg = part ? CONV_GG : Gs;
            pg8::Gemm g{XNB2, Bt, M, N, DM, 1}; pg8::StaticOrder S; S.init(M, N, Gg, bxs); if (part && bxs >= Gg) S.nwg = 0;
            pg8::rs_finalize(RTAB, S, SSQ(L == 0 ? 12 : 3 * (L - 1) + 2), tids);
            pg8::EpiBf16Map E{dsa ? 1 : 0, Qb, DM, KVA, QIb, KIWb, RTAB, KITb};
            pg8::gemm_phase<pg8::EpiBf16Map, pg8::StaticOrder, true, true>(lds, g, S, E);
            if (part && rep == 0 && bxs >= Gg) {
                __syncthreads();
                LAS float* scr = (LAS float*)(lds + waves * 16640); int rot = 0; const int gw2 = (bxs - Gg) * NWAVES + waves, NGW2 = (Gs - Gg) * NWAVES; const int Ld = L + 1;
                conv_matrix(args.in[12] + (size_t)Ld * DM * DFF, args.in[11] + (size_t)Ld * DM, DM, DFF, (bf16*)(wsp + WS_W13) + (size_t)Ld * 2 * DFF * DM, 3, scr, gw2, NGW2, lanes, rot);
                conv_matrix(args.in[13] + (size_t)Ld * DM * DFF, args.in[11] + (size_t)Ld * DM, DM, DFF, (bf16*)(wsp + WS_W13) + (size_t)Ld * 2 * DFF * DM, 4, scr, gw2, NGW2, lanes, rot);
                if (L == 0) { conv_matrix(args.in[17] + (size_t)1 * DM * DM, args.in[15] + (size_t)1 * DM, DM, DM, (bf16*)(wsp + WS_WPG) + (size_t)1 * DM * DM, 0, scr, gw2, NGW2, lanes, rot);
                              conv_matrix(args.in[3] + (size_t)1 * DM * DM, nullptr, DM, DM, (bf16*)(wsp + WS_WOA) + (size_t)1 * DM * DM, 0, scr, gw2, NGW2, lanes, rot); }
                else conv_matrix(args.in[14] + (size_t)2 * DFF * DM, nullptr, DFF, DM, (bf16*)(wsp + WS_W2) + (size_t)2 * DM * DFF, 0, scr, gw2, NGW2, lanes, rot);
            }
            GRID_BAR();
        }
#ifndef NO_IDX
        for (int rep = 0; rep < REP2; ++rep) if (dsa && IN(pb + 2)) { SITE(); indexer_phase(lds, QIb, KIWb, KITb, IDXb, bxs, Gs, tids, waves, lanes); GRID_BAR(); }
#endif
        for (int rep = 0; rep < (dsa ? REP3D : REP3S); ++rep) if (IN(pb + 3)) { SITE();
#ifndef NO_DSA
            if (dsa) dsa_attn_phase(lds, Qb, (const unsigned char*)KVA, IDXb, AOb, args.in[9], bxs, Gs, tids, waves, lanes);
#endif
#ifndef NO_SWA
            if (!dsa) swa_attn_phase(lds, Qb, KVB, AOb, args.in[9], args.in[6] + (size_t)Lb * NHEAD, bxs, Gs, tids, waves, lanes);
#endif
            GRID_BAR();
        }
        for (int rep = 0; rep < REP4; ++rep) if (IN(pb + 4) && !NOS4) { SITE();
            const bf16* Bt = dsa ? (const bf16*)(wsp + WS_WOA) + (size_t)L * DM * DM : (const bf16*)(wsp + WS_WOB) + (size_t)Lb * DM * DM;
            pg8::Gemm g{AOb, Bt, M, DM, DM}; pg8::StaticOrder S; S.init(M, DM, Gs, bxs);
            pg8::EpiResid E{XNB2, rep ? Qb : XN, rep ? (float*)(wsp + WS_QI) : SSQ(3 * L)};
            pg8::gemm_phase<pg8::EpiResid, pg8::StaticOrder, true, true>(lds, g, S, E);
            GRID_BAR();
        }
        for (int rep = 0; rep < REP6; ++rep) if (IN(pb + 6) && !NOS6) { SITE();
            pg8::Gemm g{XN, (const bf16*)(wsp + WS_W13) + (size_t)L * 2 * DFF * DM, M, 2 * DFF, DM, 1}; pg8::StaticOrder S; S.init(M, 2 * DFF, Gs, bxs);
            pg8::rs_finalize(RTAB, S, SSQ(3 * L), tids);
            pg8::EpiSwiglu E{Ub, RTAB};
            pg8::gemm_phase<pg8::EpiSwiglu, pg8::StaticOrder, true, true>(lds, g, S, E);
            GROUP_BAR();
        }
        for (int rep = 0; rep < REP7; ++rep) if (IN(pb + 7) && !NOS7) { SITE();
            { pg8::Gemm g{Ub, (const bf16*)(wsp + WS_W2) + (size_t)L * DM * DFF, M, DM, DFF, 1}; pg8::StaticOrder S; S.init(M, DM, Gs, bxs);
              pg8::EpiResid E{XN, rep ? XNB2 : XN, rep ? SSQ(3 * L + 2) : SSQ(3 * L + 1)};
              pg8::gemm_phase<pg8::EpiResid, pg8::StaticOrder, true, true>(lds, g, S, E); }
            { pg8::Gemm g{PB + (size_t)L * M * PLE, (const bf16*)(wsp + WS_WPE) + (size_t)L * DM * PLE, M, DM, PLE}; pg8::StaticOrder S; S.init(M, DM, Gs, bxs);
              pg8::EpiBf16Map E{3, PEb, DM, nullptr, nullptr, nullptr, nullptr, nullptr};
              pg8::gemm_phase<pg8::EpiBf16Map, pg8::StaticOrder, true, true>(lds, g, S, E); }
            GROUP_BAR();
        }
        for (int rep = 0; rep < REP9; ++rep) if (IN(pb + 9) && !NOS9) { SITE();
            pg8::Gemm g{XN, (const bf16*)(wsp + WS_WPG) + (size_t)L * DM * DM, M, DM, DM, 1}; pg8::StaticOrder S; S.init(M, DM, Gs, bxs);
            pg8::rs_finalize(RTAB, S, SSQ(3 * L + 1), tids);
            pg8::EpiGate E{XN, PEb, RTAB, rep ? Qb : XNB2, rep ? (float*)(wsp + WS_QI) : SSQ(3 * L + 2)};
            pg8::gemm_phase<pg8::EpiGate, pg8::StaticOrder, true, true>(lds, g, S, E);
            GRID_BAR();
        }
        if (L == N_A - 1) {
            for (int rep = 0; rep < REP11; ++rep) if (IN(pb + 11) && !NOS11) { SITE();
                pg8::Gemm g{XNB2, (const bf16*)(wsp + WS_WKV), M, 1024, DM, 1}; pg8::StaticOrder S; S.init(M, 1024, Gs, bxs);
                pg8::rs_finalize(RTAB, S, SSQ(3 * L + 2), tids);
                pg8::EpiBf16Map E{2, nullptr, 0, KVB, nullptr, nullptr, RTAB, nullptr};
                pg8::gemm_phase<pg8::EpiBf16Map, pg8::StaticOrder, true, true>(lds, g, S, E);
                GRID_BAR();
            }
        }
        }

    if (IN(PH_FINAL)) { SITE(); final_norm_phase(XNB2, args.in[18], X, gws, NGWs, lanes); }
#undef IN
#undef SITE
#undef GRID_BAR
#undef GROUP_BAR
#undef x_in
#undef X
#undef XN
#undef Qb
#undef AOb
#undef QIb
#undef KIWb
#undef IDXb
#undef KITb
#undef KVA
#undef KVB
#undef Ub
#undef PEb
#undef PB
#undef XNB2
#undef SSQ
#undef RTAB
}

static bool phase_exists(int p) {
    if (p == 0 || p == PH_FINAL) return true;
    if (p < 0 || p > PH_FINAL) return false;
    const int L = (p - 1) / 12, s = (p - 1) % 12;
    if (s == 0 || s == 5 || s == 8 || s == 10) return false;
    if (s == 2) return L < N_A;
    if (s == 11) return L == N_A - 1;
    return true;
}
extern "C" void kernel_launch(void* const* d_in, const int* in_sizes, int n_in, void* d_out, int out_size, void* d_ws, size_t ws_size, hipStream_t stream) {
    static int grid = 0;
    if (grid == 0) {
        if (n_in != 19 || in_sizes[0] != M * DM || out_size != M * DM || ws_size < WS_END) { fprintf(stderr, "kernel_launch: shape/workspace mismatch (n_in %d, in0 %d, out %d, ws %zu, need %zu); nothing launched\n", n_in, n_in > 0 ? in_sizes[0] : -1, out_size, ws_size, (size_t)WS_END); grid = -1; return; }
        int dev = 0, cus = 0, per_cu = 0;
        if (hipGetDevice(&dev) != hipSuccess || hipDeviceGetAttribute(&cus, hipDeviceAttributeMultiprocessorCount, dev) != hipSuccess) { fprintf(stderr, "kernel_launch: device query failed\n"); grid = -1; return; }
        if (hipFuncSetAttribute((const void*)yoco_fwd, hipFuncAttributeMaxDynamicSharedMemorySize, LDS_BYTES) != hipSuccess) { fprintf(stderr, "kernel_launch: hipFuncSetAttribute failed\n"); grid = -1; return; }
        if (hipOccupancyMaxActiveBlocksPerMultiprocessor(&per_cu, (const void*)yoco_fwd, NWAVES * 64, LDS_BYTES) != hipSuccess || per_cu < 1) fprintf(stderr, "kernel_launch: note: occupancy query reports %d workgroups per CU\n", per_cu);
        (void)hipGetLastError();
        grid = cus;
    }
    if (grid < 0) return;
    if (hipMemsetAsync((char*)d_ws + WS_CTL, 0, CTL_ZERO_BYTES, stream) != hipSuccess) { fprintf(stderr, "kernel_launch: memset failed\n"); return; }
    Args a{};
    for (int i = 0; i < 19; ++i) a.in[i] = (const float*)d_in[i];
    a.out = (float*)d_out; a.ws = (unsigned char*)d_ws;
#if MK_PER_PHASE
    for (int p = 0; p < PH_END; ++p) { if (!phase_exists(p)) continue; a.ph_lo = p; a.ph_hi = p + 1;
        hipLaunchKernelGGL(yoco_fwd, dim3(grid), dim3(NWAVES * 64), LDS_BYTES, stream, a); }
#else
    a.ph_lo = 0; a.ph_hi = PH_END;
    hipLaunchKernelGGL(yoco_fwd, dim3(grid), dim3(NWAVES * 64), LDS_BYTES, stream, a);
#endif
    const hipError_t le = hipPeekAtLastError();
    if (le != hipSuccess) fprintf(stderr, "kernel_launch: launch failed: %s\n", hipGetErrorName(le));
}
```

```cpp
#include <hip/hip_runtime.h>
#include <cstdio>
#include <cstdint>
#ifndef MK_PER_PHASE
#define MK_PER_PHASE 0
#endif
namespace pg8 {
#define PG8_LAS __attribute__((address_space(3)))
typedef unsigned short bf16_t;
typedef short bf16x8 __attribute__((ext_vector_type(8)));
typedef float f32x4 __attribute__((ext_vector_type(4)));
typedef unsigned u32x4 __attribute__((ext_vector_type(4)));
constexpr int BM = 256, BK = 64, HALF = 128, HTB = HALF * BK * 2  , STAGE_BYTES = 8 * HTB, NXCD = 8, WGM = 8;

__host__ __device__ __forceinline__ int lds_byte(int r, int c) { const int st = (r >> 4) * 2 + (c >> 5), rr = r & 15, cc = c & 31, ob = rr * 64 + cc * 2; return st * 1024 + (ob ^ (((ob >> 9) & 1) << 5)); }
__host__ __device__ __forceinline__ void stage_rc(int b, int& R, int& C) { const int st = b / 1024, sb = b % 1024, swz = sb ^ (((sb >> 9) & 1) << 5); R = (st >> 1) * 16 + swz / 64; C = (st & 1) * 32 + (swz % 64) / 2; }
__host__ __device__ __forceinline__ int perm32(int rho) { const int n = rho >> 4, i = rho & 15; return 8 * (i >> 2) + 4 * n + (i & 3); }

struct Unit { int pm, pn, ord; };
struct Gemm { const bf16_t* A; const bf16_t* Bt; int M, N, K; int tiledA; };

struct StaticOrder {
    int nM, nN, nwg, G, c;
    __host__ __device__ void init(int M, int N, int G_, int c_) { nM = M / BM; nN = N / BM; nwg = nM * nN; G = G_; c = c_; }
    __host__ __device__ bool next(int i, Unit& u) const {
        const long L = (long)i * G + c; if (L >= nwg) return false;
        int wgid = (int)L; { const int q = nwg / NXCD, r = nwg % NXCD, xcd = wgid % NXCD, off = wgid / NXCD; wgid = (xcd < r ? xcd * (q + 1) : r * (q + 1) + (xcd - r) * q) + off; }
        const int nig = WGM * nN, gid = wgid / nig, fm = gid * WGM, gsz = (nM - fm) < WGM ? (nM - fm) : WGM;
        u.pm = fm + ((wgid % nig) % gsz); u.pn = (wgid % nig) / gsz; u.ord = i; return true;
    }
    __device__ __forceinline__ void a_ready(const Unit&) const {}
    __device__ __forceinline__ void done(const Unit&) const {}
};

__device__ __forceinline__ unsigned cvt_pk_bf16(float lo, float hi) { unsigned r; asm volatile("v_cvt_pk_bf16_f32 %0, %1, %2" : "=v"(r) : "v"(lo), "v"(hi)); return r; }
#define PG8_GAS __attribute__((address_space(1)))

__device__ __forceinline__ float fast_sigmoid(float a) { return __builtin_amdgcn_rcpf(1.0f + __builtin_amdgcn_exp2f(-1.4426950408889634f * a)); }

__device__ __forceinline__ void row_scales(const PG8_LAS float* rtab, const Unit& u, int wr, int fr, float (&r)[2][4]) {
#pragma unroll
    for (int ai = 0; ai < 2; ++ai)
#pragma unroll
        for (int m = 0; m < 4; ++m) r[ai][m] = rtab ? rtab[u.ord * BM + ai * HALF + wr * 64 + m * 16 + fr] : 1.0f;
}
template <class Sched> __device__ __forceinline__ void rs_finalize(PG8_LAS float* rtab, const Sched& S, const float* ssp, int tid) {
    const int row = tid >> 1, h = tid & 1;
    for (int i0 = 0; ; i0 += 4) {
        Unit u[4]; bool ok[4]; f32x4 v[4][4];
#pragma unroll
        for (int j = 0; j < 4; ++j) { ok[j] = S.next(i0 + j, u[j]); if (!ok[j]) u[j].pm = 0; }
        if (!ok[0]) break;
#pragma unroll
        for (int j = 0; j < 4; ++j) { const PG8_GAS f32x4* p = (const PG8_GAS f32x4*)(ssp + ((size_t)(u[j].pm * BM + row)) * 32 + h * 16);
#pragma unroll
            for (int e = 0; e < 4; ++e) v[j][e] = p[e]; }
#pragma unroll
        for (int j = 0; j < 4; ++j) { const f32x4 a = v[j][0], b = v[j][1], c = v[j][2], d = v[j][3];
            const float s = (((a[0] + a[1]) + (a[2] + a[3])) + ((b[0] + b[1]) + (b[2] + b[3]))) + (((c[0] + c[1]) + (c[2] + c[3])) + ((d[0] + d[1]) + (d[2] + d[3])));
            const float o = __shfl_xor(s, 1); const float tot = h ? (o + s) : (s + o);
            if (h == 0 && ok[j]) rtab[(i0 + j) * BM + row] = __builtin_amdgcn_rsqf(tot * (1.0f / 2048.0f) + 1e-6f); }
    }
    __syncthreads();
}
struct EpiBf16Map {
    static constexpr bool PERM = true, AFTER_DRAIN = false;
    int kind; bf16_t* O; int ldc; bf16_t* KV; bf16_t* QI; bf16_t* KIW; const PG8_LAS float* rtab; bf16_t* KIT;
    __device__ __forceinline__ void operator()(const f32x4 (&acc)[2][2][4][2], const Unit& u, int wr, int wc, int fr, int fq) const {
        const int row0 = u.pm * BM + wr * 64 + fr; bf16_t* base; int ld;
        if (kind == 0) { base = O + u.pn * BM; ld = ldc; }
        else if (kind == 3) { base = O + ((size_t)(u.pm * 8 + u.pn) << 16) - (size_t)u.pm * BM * 256; ld = 256; }
        else if (kind == 1) {
            if (u.pn < 8) { base = O + u.pn * BM; ld = 2048; }
            else if (u.pn < 12) { const int b = u.pm >> 5, g = u.pn - 8; base = KV + ((size_t)(b * 4 + g) * 8192 - (size_t)b * 8192) * 256; ld = 256; }
            else if (u.pn < 16) { base = QI + (u.pn - 12) * BM; ld = 1024; }
            else { base = KIW; ld = 256; }
        } else { const int b = u.pm >> 5, g = u.pn; base = KV + ((size_t)(b * 4 + g) * 8192 - (size_t)b * 8192) * 256; ld = 256; }
        const int col0 = wc * 32 + 8 * fq; float rs[2][4]; row_scales(rtab, u, wr, fr, rs);
        if (kind == 1 && u.pn == 16) {
            if (wc < 2) {
#pragma unroll
                for (int ai = 0; ai < 2; ++ai)
#pragma unroll
                    for (int m = 0; m < 4; ++m) { const int row = row0 + ai * HALF + m * 16, d0 = wc * 32 + 8 * fq;
                        bf16_t* dst = QI  ; dst = KIT + ((size_t)((row >> 5) * 4 + (d0 >> 4)) * 64 + ((d0 >> 3) & 1) * 32 + (row & 31)) * 8;
                        const f32x4 v0 = acc[ai][0][m][0] * rs[ai][m], v1 = acc[ai][0][m][1] * rs[ai][m];
                        u32x4 w; w.x = cvt_pk_bf16(v0[0], v0[1]); w.y = cvt_pk_bf16(v0[2], v0[3]); w.z = cvt_pk_bf16(v1[0], v1[1]); w.w = cvt_pk_bf16(v1[2], v1[3]);
                        *(PG8_GAS u32x4*)dst = w; }
            } else if (wc == 2 && fq < 2) {
#pragma unroll
                for (int ai = 0; ai < 2; ++ai)
#pragma unroll
                    for (int m = 0; m < 4; ++m) { bf16_t* rowp = KIW + (size_t)(row0 + ai * HALF + m * 16) * 256 + col0;
                        const f32x4 v0 = acc[ai][0][m][0] * rs[ai][m], v1 = acc[ai][0][m][1] * rs[ai][m];
                        u32x4 w; w.x = cvt_pk_bf16(v0[0], v0[1]); w.y = cvt_pk_bf16(v0[2], v0[3]); w.z = cvt_pk_bf16(v1[0], v1[1]); w.w = cvt_pk_bf16(v1[2], v1[3]);
                        *(PG8_GAS u32x4*)rowp = w; }
            }
            return;
        }
        if (kind == 1 && u.pn >= 8 && u.pn < 12) {
            unsigned char* b8 = (unsigned char*)KV + ((size_t)((u.pm >> 5) * 4 + (u.pn - 8)) * 8192 - (size_t)(u.pm >> 5) * 8192) * 256 + col0;
#pragma unroll
            for (int ai = 0; ai < 2; ++ai)
#pragma unroll
                for (int m = 0; m < 4; ++m) { unsigned char* rowp = b8 + (size_t)(row0 + ai * HALF + m * 16) * 256; const float sc = rs[ai][m] * 16.0f;
#pragma unroll
                    for (int bj = 0; bj < 2; ++bj) { const f32x4 v0 = acc[ai][bj][m][0] * sc, v1 = acc[ai][bj][m][1] * sc; typedef unsigned u32x2 __attribute__((ext_vector_type(2)));
                        int w0 = __builtin_amdgcn_cvt_pk_fp8_f32(v0[0], v0[1], 0, false); w0 = __builtin_amdgcn_cvt_pk_fp8_f32(v0[2], v0[3], w0, true);
                        int w1 = __builtin_amdgcn_cvt_pk_fp8_f32(v1[0], v1[1], 0, false); w1 = __builtin_amdgcn_cvt_pk_fp8_f32(v1[2], v1[3], w1, true);
                        u32x2 w; w.x = (unsigned)w0; w.y = (unsigned)w1; *(PG8_GAS u32x2*)(rowp + bj * HALF) = w; } }
            return;
        }
#pragma unroll
        for (int ai = 0; ai < 2; ++ai)
#pragma unroll
            for (int m = 0; m < 4; ++m) { bf16_t* rowp = base + (size_t)(row0 + ai * HALF + m * 16) * ld + col0;
#pragma unroll
                for (int bj = 0; bj < 2; ++bj) { const f32x4 v0 = acc[ai][bj][m][0] * rs[ai][m], v1 = acc[ai][bj][m][1] * rs[ai][m];
                    u32x4 w; w.x = cvt_pk_bf16(v0[0], v0[1]); w.y = cvt_pk_bf16(v0[2], v0[3]); w.z = cvt_pk_bf16(v1[0], v1[1]); w.w = cvt_pk_bf16(v1[2], v1[3]);
                    *(PG8_GAS u32x4*)(rowp + bj * HALF) = w; } }
    }
};
__device__ __forceinline__ float bflo(unsigned w) { return __uint_as_float(w << 16); }
__device__ __forceinline__ float bfhi(unsigned w) { return __uint_as_float(w & 0xffff0000u); }
typedef float f32x2 __attribute__((ext_vector_type(2)));
__device__ __forceinline__ f32x2 bf2(unsigned w) { f32x2 r; r.x = bflo(w); r.y = bfhi(w); return r; }
#define PG8_LO2(v) __builtin_shufflevector(v, v, 0, 1)
#define PG8_HI2(v) __builtin_shufflevector(v, v, 2, 3)
__device__ __forceinline__ void sig8(f32x4& s0, f32x4& s1, const f32x4 a0, const f32x4 a1, float nrs) {
    f32x4 t0 = a0 * nrs, t1 = a1 * nrs;
    __builtin_amdgcn_sched_barrier(0);
#pragma unroll
    for (int e = 0; e < 4; ++e) { t0[e] = __builtin_amdgcn_exp2f(t0[e]); t1[e] = __builtin_amdgcn_exp2f(t1[e]); }
    __builtin_amdgcn_sched_barrier(0);
    t0 = t0 + 1.0f; t1 = t1 + 1.0f;
    __builtin_amdgcn_sched_barrier(0);
#pragma unroll
    for (int e = 0; e < 4; ++e) { t0[e] = __builtin_amdgcn_rcpf(t0[e]); t1[e] = __builtin_amdgcn_rcpf(t1[e]); }
    __builtin_amdgcn_sched_barrier(0);
    s0 = t0; s1 = t1;
}
struct EpiResid {
    static constexpr bool PERM = true, AFTER_DRAIN = false;
    const bf16_t* Xin; bf16_t* Xout; float* ssp;
    __device__ __forceinline__ void operator()(const f32x4 (&acc)[2][2][4][2], const Unit& u, int wr, int wc, int fr, int fq) const {
        const int row0 = u.pm * BM + wr * 64 + fr, rl0 = wr * 64 + fr, cl0 = wc * 32 + 8 * fq; const size_t tb = (size_t)(u.pm * 8 + u.pn) << 16;
        u32x4 xv[2][4][2];
#pragma unroll
        for (int ai = 0; ai < 2; ++ai)
#pragma unroll
            for (int m = 0; m < 4; ++m)
#pragma unroll
                for (int bj = 0; bj < 2; ++bj) xv[ai][m][bj] = *(const PG8_GAS u32x4*)(Xin + tb + (size_t)(rl0 + ai * HALF + m * 16) * 256 + cl0 + bj * HALF);
#pragma unroll
        for (int ai = 0; ai < 2; ++ai)
#pragma unroll
            for (int m = 0; m < 4; ++m) { float q; f32x2 qq = (f32x2){0.f, 0.f};
#pragma unroll
                for (int bj = 0; bj < 2; ++bj) { const u32x4 x = xv[ai][m][bj]; const f32x4 a0 = acc[ai][bj][m][0], a1 = acc[ai][bj][m][1];
                    const f32x2 o0 = bf2(x.x) + PG8_LO2(a0), o1 = bf2(x.y) + PG8_HI2(a0), o2 = bf2(x.z) + PG8_LO2(a1), o3 = bf2(x.w) + PG8_HI2(a1);
                    u32x4 w; w.x = cvt_pk_bf16(o0.x, o0.y); w.y = cvt_pk_bf16(o1.x, o1.y); w.z = cvt_pk_bf16(o2.x, o2.y); w.w = cvt_pk_bf16(o3.x, o3.y);
                    *(PG8_GAS u32x4*)(Xout + tb + (size_t)(rl0 + ai * HALF + m * 16) * 256 + cl0 + bj * HALF) = w;
                    const f32x2 w0 = bf2(w.x), w1 = bf2(w.y), w2 = bf2(w.z), w3 = bf2(w.w); qq = qq + w0 * w0; qq = qq + w1 * w1; qq = qq + w2 * w2; qq = qq + w3 * w3; }
                q = qq.x + qq.y;
                { auto r16_ = __builtin_amdgcn_permlane16_swap(__float_as_uint(q), __float_as_uint(q), false, false); q = __uint_as_float(r16_[0]) + __uint_as_float(r16_[1]); auto r32_ = __builtin_amdgcn_permlane32_swap(__float_as_uint(q), __float_as_uint(q), false, false); q = __uint_as_float(r32_[0]) + __uint_as_float(r32_[1]); }
                if (fq == 0) ((PG8_GAS float*)ssp)[(size_t)(row0 + ai * HALF + m * 16) * 32 + u.pn * 4 + wc] = q; }
    }
};
struct EpiSwiglu {
    static constexpr bool PERM = true, AFTER_DRAIN = false;
    bf16_t* U; const PG8_LAS float* rtab;
    __device__ __forceinline__ void operator()(const f32x4 (&acc)[2][2][4][2], const Unit& u, int wr, int wc, int fr, int fq) const {
        const int row0 = wr * 64 + fr; float rs[2][4]; row_scales(rtab, u, wr, fr, rs);
        bf16_t* const ub = U + ((size_t)(u.pm * 22 + (u.pn >> 1)) << 16) + (u.pn & 1) * HALF + wc * 32 + 8 * fq;
#ifndef EPI_SWIGLU_REP
#define EPI_SWIGLU_REP 1
#endif
        for (int er_ = 0; er_ < EPI_SWIGLU_REP; ++er_) { asm volatile("" ::: "memory");
#pragma unroll
        for (int ai = 0; ai < 2; ++ai)
#pragma unroll
            for (int m = 0; m < 4; ++m) { bf16_t* rowp = ub + (size_t)(row0 + ai * HALF + m * 16) * 256;
                f32x4 o[2]; const float rsv = rs[ai][m], rr = rsv * rsv;
                { f32x4 s0, s1; sig8(s0, s1, acc[ai][0][m][0], acc[ai][0][m][1], rsv * -1.4426950408889634f);
                  o[0] = (acc[ai][0][m][0] * acc[ai][1][m][0]) * (s0 * rr); o[1] = (acc[ai][0][m][1] * acc[ai][1][m][1]) * (s1 * rr); }
                u32x4 w; w.x = cvt_pk_bf16(o[0][0], o[0][1]); w.y = cvt_pk_bf16(o[0][2], o[0][3]); w.z = cvt_pk_bf16(o[1][0], o[1][1]); w.w = cvt_pk_bf16(o[1][2], o[1][3]);
                *(PG8_GAS u32x4*)rowp = w; }
        }
    }
};
struct EpiGate {
    static constexpr bool PERM = true, AFTER_DRAIN = false;
    const bf16_t* Xin; const bf16_t* PE; const PG8_LAS float* rtab; bf16_t* Xout; float* ssp;
    __device__ __forceinline__ void operator()(const f32x4 (&acc)[2][2][4][2], const Unit& u, int wr, int wc, int fr, int fq) const {
        const int row0 = u.pm * BM + wr * 64 + fr, rl0 = wr * 64 + fr, cl0 = wc * 32 + 8 * fq; const size_t tb = (size_t)(u.pm * 8 + u.pn) << 16;
#pragma unroll
        for (int ai = 0; ai < 2; ++ai) {
            u32x4 xv[4][2], pv[4][2];
#pragma unroll
            for (int m = 0; m < 4; ++m)
#pragma unroll
                for (int bj = 0; bj < 2; ++bj) { const size_t off = tb + (size_t)(rl0 + ai * HALF + m * 16) * 256 + cl0 + bj * HALF; xv[m][bj] = *(const PG8_GAS u32x4*)(Xin + off); pv[m][bj] = *(const PG8_GAS u32x4*)(PE + off); }
#pragma unroll
            for (int m = 0; m < 4; ++m) { float q; f32x2 qq = (f32x2){0.f, 0.f}; const float nr = rtab[u.ord * BM + ai * HALF + wr * 64 + m * 16 + fr] * -1.4426950408889634f;
#pragma unroll
                for (int bj = 0; bj < 2; ++bj) { const u32x4 x = xv[m][bj], p = pv[m][bj]; f32x4 s0, s1; sig8(s0, s1, acc[ai][bj][m][0], acc[ai][bj][m][1], nr);
                    const f32x2 o0 = bf2(x.x) + bf2(p.x) * PG8_LO2(s0), o1 = bf2(x.y) + bf2(p.y) * PG8_HI2(s0), o2 = bf2(x.z) + bf2(p.z) * PG8_LO2(s1), o3 = bf2(x.w) + bf2(p.w) * PG8_HI2(s1);
                    u32x4 w; w.x = cvt_pk_bf16(o0.x, o0.y); w.y = cvt_pk_bf16(o1.x, o1.y); w.z = cvt_pk_bf16(o2.x, o2.y); w.w = cvt_pk_bf16(o3.x, o3.y);
                    *(PG8_GAS u32x4*)(Xout + tb + (size_t)(rl0 + ai * HALF + m * 16) * 256 + cl0 + bj * HALF) = w;
                    const f32x2 w0 = bf2(w.x), w1 = bf2(w.y), w2 = bf2(w.z), w3 = bf2(w.w); qq = qq + w0 * w0; qq = qq + w1 * w1; qq = qq + w2 * w2; qq = qq + w3 * w3; }
                q = qq.x + qq.y;
                { auto r16_ = __builtin_amdgcn_permlane16_swap(__float_as_uint(q), __float_as_uint(q), false, false); q = __uint_as_float(r16_[0]) + __uint_as_float(r16_[1]); auto r32_ = __builtin_amdgcn_permlane32_swap(__float_as_uint(q), __float_as_uint(q), false, false); q = __uint_as_float(r32_[0]) + __uint_as_float(r32_[1]); }
                if (fq == 0) ((PG8_GAS float*)ssp)[(size_t)(row0 + ai * HALF + m * 16) * 32 + u.pn * 4 + wc] = q; }
            asm volatile("" ::: "memory"); }
    }
};
template <class Epi, class Sched, bool ALIGN_EPI = false, bool SP2 = false>
__device__ __forceinline__ void gemm_phase(PG8_LAS unsigned char* lds, const Gemm g, const Sched& S, const Epi& E) {
    int tid_l = threadIdx.x; asm volatile("" : "+v"(tid_l));
    const int tid = tid_l, wid = __builtin_amdgcn_readfirstlane(tid >> 6), lane = tid & 63, wr = wid >> 2, wc = wid & 3, fr = lane & 15, fq = lane >> 4;
    const int K = g.K, nt = K / BK;
    unsigned voffA[2], voffB[2];
#pragma unroll
    for (int i = 0; i < 2; ++i) { int R, C; stage_rc(tid * 16 + i * 8192, R, C); const int Rb = Epi::PERM ? ((R & ~31) + perm32(R & 31)) : R;
        voffA[i] = (unsigned)(R * (g.tiledA ? 256 : K) + C) * 2u; voffB[i] = (unsigned)(Rb * K + C) * 2u; }
    const unsigned kstep = (unsigned)(BK * 2);
    const unsigned hstep = (unsigned)HALF * K * 2;
    const unsigned tstep = 2 * hstep;
    const unsigned hstepA = g.tiledA ? 65536u : hstep;
#define PG8_KA(t_) (g.tiledA ? ((((unsigned)(t_)) >> 2) << 17) + ((((unsigned)(t_)) & 3u) << 7) : (unsigned)(t_) * kstep)
    const unsigned ldsw = (unsigned)wid * 1024u;
    const int aoff = lds_byte(wr * 64 + fr, fq * 8), boff = lds_byte(wc * 32 + fr, fq * 8);
#define PG8_SA(b, h) (((b) * 2 + (h)) * HTB)
#define PG8_SB(b, h) ((4 + (b) * 2 + (h)) * HTB)
    const unsigned long long pA_ = (unsigned long long)g.A, pB_ = (unsigned long long)g.Bt;
    void* const uA_ = (void*)(((unsigned long long)(unsigned)__builtin_amdgcn_readfirstlane((int)(unsigned)(pA_ >> 32)) << 32) | (unsigned)__builtin_amdgcn_readfirstlane((int)(unsigned)pA_));
    void* const uB_ = (void*)(((unsigned long long)(unsigned)__builtin_amdgcn_readfirstlane((int)(unsigned)(pB_ >> 32)) << 32) | (unsigned)__builtin_amdgcn_readfirstlane((int)(unsigned)pB_));
    const __amdgpu_buffer_rsrc_t rs_voffA = __builtin_amdgcn_make_buffer_rsrc(uA_, (short)0, __builtin_amdgcn_readfirstlane((int)((unsigned)g.M * (unsigned)K * 2u)), 0x00020000);
    const __amdgpu_buffer_rsrc_t rs_voffB = __builtin_amdgcn_make_buffer_rsrc(uB_, (short)0, __builtin_amdgcn_readfirstlane((int)((unsigned)g.N * (unsigned)K * 2u)), 0x00020000);
#define PG8_STAGE(bufoff, goff, voff) do { _Pragma("unroll") for (int _i = 0; _i < 2; ++_i) \
        __builtin_amdgcn_raw_ptr_buffer_load_lds(rs_##voff, (PG8_LAS void*)(lds + (bufoff) + ldsw + _i * 8192), 16, (int)(voff)[_i], (int)(goff), 0, 0); } while (0)
#define PG8_LDA(dst, b, h) do { _Pragma("unroll") for (int m = 0; m < 4; ++m) _Pragma("unroll") for (int k = 0; k < 2; ++k) dst[m][k] = *(const PG8_LAS bf16x8*)(lds + PG8_SA(b, h) + aoff + m * 2048 + k * 1024); } while (0)
#define PG8_LDB(dst, b, h) do { _Pragma("unroll") for (int n = 0; n < 2; ++n) _Pragma("unroll") for (int k = 0; k < 2; ++k) dst[n][k] = *(const PG8_LAS bf16x8*)(lds + PG8_SB(b, h) + boff + n * 2048 + k * 1024); } while (0)
#define PG8_MMA(ai, bj, At, Bt) do { __builtin_amdgcn_s_setprio(1); _Pragma("unroll") for (int m = 0; m < 4; ++m) _Pragma("unroll") for (int n = 0; n < 2; ++n) _Pragma("unroll") for (int k = 0; k < 2; ++k) \
        acc[ai][bj][m][n] = __builtin_amdgcn_mfma_f32_16x16x32_bf16(Bt[n][k], At[m][k], acc[ai][bj][m][n], 0, 0, 0); __builtin_amdgcn_s_setprio(0); } while (0)
#define PG8_WAIT_V(n) asm volatile("s_waitcnt vmcnt(" #n ")" ::: "memory")
#define PG8_WAIT_L(n) asm volatile("s_waitcnt lgkmcnt(" #n ")" ::: "memory")
#define PG8_BAR __builtin_amdgcn_s_barrier()
#define PG8_SCHED __builtin_amdgcn_sched_barrier(0)
    Unit cur, nxt; int ui = 0;
    if (!S.next(0, cur)) return;
    f32x4 acc[2][2][4][2];
#pragma unroll
    for (int a = 0; a < 2; ++a)
#pragma unroll
        for (int b = 0; b < 2; ++b)
#pragma unroll
            for (int m = 0; m < 4; ++m)
#pragma unroll
                for (int n = 0; n < 2; ++n) acc[a][b][m][n] = (f32x4){0.f, 0.f, 0.f, 0.f};
    bf16x8 At[4][2], B0[2][2], B1[2][2];
    unsigned cA = (unsigned)cur.pm * tstep, cB = (unsigned)cur.pn * tstep;
    S.a_ready(cur);
    if constexpr (SP2) {
        PG8_STAGE(PG8_SB(0, 0), cB, voffB); PG8_STAGE(PG8_SB(0, 1), cB + hstep, voffB); PG8_STAGE(PG8_SA(0, 0), cA, voffA); PG8_STAGE(PG8_SA(0, 1), cA + hstepA, voffA);
        if (wr == 1) PG8_BAR;
        PG8_WAIT_V(2); PG8_BAR;
        PG8_STAGE(PG8_SB(1, 0), cB + kstep, voffB); PG8_STAGE(PG8_SA(1, 0), cA + kstep, voffA); PG8_STAGE(PG8_SB(1, 1), cB + hstep + kstep, voffB);
        PG8_WAIT_V(6); PG8_BAR;
    } else {
        PG8_STAGE(PG8_SB(0, 0), cB, voffB); PG8_STAGE(PG8_SA(0, 0), cA, voffA); PG8_STAGE(PG8_SB(0, 1), cB + hstep, voffB); PG8_STAGE(PG8_SA(0, 1), cA + hstepA, voffA);
        if (wr == 1) PG8_BAR;
        PG8_WAIT_V(4); PG8_BAR;
        PG8_STAGE(PG8_SB(1, 0), cB + kstep, voffB); PG8_STAGE(PG8_SA(1, 0), cA + kstep, voffA); PG8_STAGE(PG8_SB(1, 1), cB + hstep + kstep, voffB);
        PG8_WAIT_V(6); PG8_BAR;
    }
    for (;;) {
        const bool has_next = S.next(ui + 1, nxt);
        const unsigned nA = has_next ? (unsigned)nxt.pm * tstep : cA, nB = has_next ? (unsigned)nxt.pn * tstep : cB;
        for (int t = 0; t < nt; t += 2) {
            const bool last = (t == nt - 2);
            const unsigned a1 = cA + PG8_KA(t + 1);
            const unsigned a2 = last ? nA : cA + PG8_KA(t + 2), b2 = last ? nB : cB + (unsigned)(t + 2) * kstep;
            const unsigned a3 = a2 + kstep, b3 = b2 + kstep;
            if (last && has_next) S.a_ready(nxt);
            if constexpr (SP2) {
            PG8_LDB(B0, 0, 0); PG8_LDB(B1, 0, 1); PG8_SCHED; PG8_LDA(At, 0, 0); PG8_STAGE(PG8_SA(1, 1), a1 + hstepA, voffA);
            PG8_WAIT_V(8); PG8_WAIT_L(0); PG8_BAR; PG8_MMA(0, 0, At, B0); PG8_MMA(0, 1, At, B1); PG8_BAR; PG8_SCHED;
            PG8_LDA(At, 0, 1); PG8_STAGE(PG8_SB(0, 0), b2, voffB); PG8_STAGE(PG8_SB(0, 1), b2 + hstep, voffB); PG8_STAGE(PG8_SA(0, 0), a2, voffA);
            PG8_WAIT_V(8); PG8_WAIT_L(0); PG8_BAR; PG8_MMA(1, 0, At, B0); PG8_MMA(1, 1, At, B1); PG8_BAR; PG8_SCHED;
            PG8_LDB(B0, 1, 0); PG8_LDB(B1, 1, 1); PG8_SCHED; PG8_LDA(At, 1, 0); PG8_STAGE(PG8_SA(0, 1), a2 + hstepA, voffA);
            PG8_WAIT_V(8); PG8_WAIT_L(0); PG8_BAR; PG8_MMA(0, 0, At, B0); PG8_MMA(0, 1, At, B1); PG8_BAR; PG8_SCHED;
            PG8_LDA(At, 1, 1); PG8_STAGE(PG8_SB(1, 0), b3, voffB); PG8_STAGE(PG8_SB(1, 1), b3 + hstep, voffB); PG8_STAGE(PG8_SA(1, 0), a3, voffA);
            PG8_WAIT_V(8); PG8_WAIT_L(0); PG8_BAR; PG8_MMA(1, 0, At, B0); PG8_MMA(1, 1, At, B1); PG8_BAR; PG8_SCHED;
            } else {
            PG8_LDB(B0, 0, 0); PG8_SCHED; PG8_LDA(At, 0, 0); PG8_STAGE(PG8_SA(1, 1), a1 + hstepA, voffA);
            PG8_WAIT_L(8); PG8_BAR; PG8_WAIT_L(0); PG8_MMA(0, 0, At, B0); PG8_BAR; PG8_SCHED;
            PG8_LDB(B1, 0, 1); PG8_STAGE(PG8_SB(0, 0), b2, voffB);
            PG8_BAR; PG8_WAIT_L(0); PG8_MMA(0, 1, At, B1); PG8_BAR;
            PG8_LDA(At, 0, 1); PG8_STAGE(PG8_SA(0, 0), a2, voffA);
            PG8_BAR; PG8_WAIT_L(0); PG8_MMA(1, 0, At, B0); PG8_BAR; PG8_SCHED;
            PG8_STAGE(PG8_SB(0, 1), b2 + hstep, voffB);
            PG8_WAIT_V(6); PG8_BAR; PG8_MMA(1, 1, At, B1); PG8_BAR;
            PG8_LDB(B0, 1, 0); PG8_SCHED; PG8_LDA(At, 1, 0); PG8_STAGE(PG8_SA(0, 1), a2 + hstepA, voffA);
            PG8_WAIT_L(8); PG8_BAR; PG8_WAIT_L(0); PG8_MMA(0, 0, At, B0); PG8_BAR; PG8_SCHED;
            PG8_LDB(B1, 1, 1); PG8_STAGE(PG8_SB(1, 0), b3, voffB);
            PG8_BAR; PG8_WAIT_L(0); PG8_MMA(0, 1, At, B1); PG8_BAR;
            PG8_LDA(At, 1, 1); PG8_STAGE(PG8_SA(1, 0), a3, voffA);
            PG8_BAR; PG8_WAIT_L(0); PG8_MMA(1, 0, At, B0); PG8_BAR; PG8_SCHED;
            PG8_STAGE(PG8_SB(1, 1), b3 + hstep, voffB);
            PG8_WAIT_V(6); PG8_BAR; PG8_MMA(1, 1, At, B1); PG8_BAR;
            }
        }
        if constexpr (ALIGN_EPI) { if (wr == 0) PG8_BAR; }
        if constexpr (!Epi::AFTER_DRAIN) { E(acc, cur, wr, wc, fr, fq); S.done(cur); }
        if (!has_next) break;
#pragma unroll
        for (int a = 0; a < 2; ++a)
#pragma unroll
            for (int b = 0; b < 2; ++b)
#pragma unroll
                for (int m = 0; m < 4; ++m)
#pragma unroll
                    for (int n = 0; n < 2; ++n) acc[a][b][m][n] = (f32x4){0.f, 0.f, 0.f, 0.f};
        cur = nxt; cA = nA; cB = nB; ++ui;
        if constexpr (ALIGN_EPI) { if (wr == 1) PG8_BAR; }
    }
    PG8_WAIT_V(0);
    if constexpr (!ALIGN_EPI) { if (wr == 0) PG8_BAR; }
    PG8_BAR;
    if constexpr (Epi::AFTER_DRAIN) { E.fused(acc, cur, wr, wc, fr, fq, lds, wid, lane); S.done(cur); }
#undef PG8_KA
#undef PG8_SA
#undef PG8_SB
#undef PG8_STAGE
#undef PG8_LDA
#undef PG8_LDB
#undef PG8_MMA
#undef PG8_WAIT_V
#undef PG8_WAIT_L
#undef PG8_BAR
#undef PG8_SCHED
}
}

constexpr int NWAVES = 8;
constexpr int BATCH = 2, SEQ = 8192, DM = 2048, DEPTH = 4, N_A = 2, NHEAD = 16, HDIM = 128, NKV = 4, GRP = 4, IHEAD = 16, IDIM = 64, TOPK = 256, DFF = 5632, PLE = 256;
constexpr int M = BATCH * SEQ;
constexpr int A_IN = 4176, A_INP = 4352;
constexpr float RMS_EPS = 1e-6f;

constexpr size_t MiB = 1u << 20;
constexpr size_t WS_CTL = 0, CTL_ZERO_BYTES = 32 * 1024;
constexpr size_t SZ_WIN = (size_t)A_INP * DM * 2, SZ_SQ = (size_t)DM * DM * 2, SZ_W13 = (size_t)2 * DFF * DM * 2, SZ_W2 = (size_t)DM * DFF * 2, SZ_WPE = (size_t)DM * PLE * 2, SZ_WKV = (size_t)1024 * DM * 2;
constexpr size_t WS_WIN = 1 * MiB;
constexpr size_t WS_WOA = WS_WIN + 2 * SZ_WIN;
constexpr size_t WS_WQB = WS_WOA + 2 * SZ_SQ;
constexpr size_t WS_WOB = WS_WQB + 2 * SZ_SQ;
constexpr size_t WS_WPG = WS_WOB + 2 * SZ_SQ;
constexpr size_t WS_W13 = WS_WPG + 4 * SZ_SQ;
constexpr size_t WS_W2 = WS_W13 + 4 * SZ_W13;
constexpr size_t WS_WPE = WS_W2 + 4 * SZ_W2;
constexpr size_t WS_WKV = WS_WPE + 4 * SZ_WPE;
constexpr size_t WS_PB = WS_WKV + SZ_WKV;
constexpr size_t WS_XN = WS_PB + (size_t)4 * M * PLE * 2;
constexpr size_t WS_KVA = WS_XN + (size_t)M * DM * 2;
constexpr size_t WS_KVB = WS_KVA + (size_t)8 * SEQ * 256 * 2;
constexpr size_t WS_R1 = WS_KVB + (size_t)8 * SEQ * 256 * 2;
constexpr size_t WS_Q = WS_R1;
constexpr size_t WS_QI = WS_Q + (size_t)2 * M * DM * 2;
constexpr size_t WS_KIW = WS_QI + (size_t)M * 1024 * 2;
constexpr size_t WS_IDX = WS_KIW + (size_t)M * 256 * 2;
constexpr size_t WS_KIT = WS_IDX + (size_t)M * 256 * 4;
constexpr size_t WS_R1_END = WS_KIT + (size_t)M * 64 * 2;
constexpr size_t WS_U = WS_R1;
static_assert(WS_U + (size_t)M * DFF * 2 <= WS_R1_END, "U fits the attention scratch region");
constexpr size_t WS_XNB = WS_R1_END;
constexpr size_t WS_PE = WS_XNB + (size_t)M * DM * 2;
constexpr size_t WS_SSP = WS_PE + (size_t)M * DM * 2;
constexpr size_t WS_AO = WS_SSP + (size_t)13 * M * 32 * 4;
constexpr size_t WS_END = WS_AO + (size_t)M * DM * 2;
constexpr int RTAB_OFF = 131072;
constexpr int CW_BAR = 4096;

constexpr int LDS_BYTES = 163840;
constexpr int MISC_OFF = LDS_BYTES - 256;
constexpr int TAB_ENTRIES = 129 * 16;

#define GAS __attribute__((address_space(1)))
#define LAS __attribute__((address_space(3)))
typedef unsigned short bf16;
typedef unsigned v4u __attribute__((ext_vector_type(4)));
typedef unsigned v2u __attribute__((ext_vector_type(2)));
typedef float f32x4 __attribute__((ext_vector_type(4)));
typedef float f32x16 __attribute__((ext_vector_type(16)));
typedef short bf16x8 __attribute__((ext_vector_type(8)));
typedef short s16x4 __attribute__((ext_vector_type(4)));
typedef GAS unsigned gu32;
#define RLX_AGENT __ATOMIC_RELAXED, __HIP_MEMORY_SCOPE_AGENT
#define LDS_WAIT() asm volatile("s_waitcnt lgkmcnt(0)" ::: "memory")
__device__ __forceinline__ unsigned f2bf(float f) { unsigned u = __builtin_bit_cast(unsigned, f); return (u + 0x7fffu + ((u >> 16) & 1u)) >> 16; }
__device__ __forceinline__ unsigned pk2(float lo, float hi) { return pg8::cvt_pk_bf16(lo, hi); }
__device__ __forceinline__ float bf2f(unsigned short b) { return __uint_as_float(((unsigned)b) << 16); }
__device__ __forceinline__ s16x4 vtr(const LAS unsigned char* p) { typedef short v4i16_t __attribute__((ext_vector_type(4))); return __builtin_bit_cast(s16x4, __builtin_amdgcn_ds_read_tr16_b64_v4i16((LAS v4i16_t*)p)); }
__device__ __forceinline__ float bfly16_max(float v) { auto rr = __builtin_amdgcn_permlane16_swap(__float_as_uint(v), __float_as_uint(v), false, false); return fmaxf(__uint_as_float(rr[0]), __uint_as_float(rr[1])); }
__device__ __forceinline__ float bfly32_max(float v) { auto rr = __builtin_amdgcn_permlane32_swap(__float_as_uint(v), __float_as_uint(v), false, false); return fmaxf(__uint_as_float(rr[0]), __uint_as_float(rr[1])); }
__device__ __forceinline__ float bfly16_sum(float v) { auto rr = __builtin_amdgcn_permlane16_swap(__float_as_uint(v), __float_as_uint(v), false, false); return __uint_as_float(rr[0]) + __uint_as_float(rr[1]); }
__device__ __forceinline__ float bfly32_sum(float v) { auto rr = __builtin_amdgcn_permlane32_swap(__float_as_uint(v), __float_as_uint(v), false, false); return __uint_as_float(rr[0]) + __uint_as_float(rr[1]); }
__device__ __forceinline__ float wave_sum(float v) {
#pragma unroll
    for (int o = 1; o < 64; o <<= 1) v += __shfl_xor(v, o);
    return v;
}
#define XB_TMO      128
#define XB_XCNT(j)  (256  + 64 * (j))
#define XB_XSUB(j)  (1280 + 64 * (j))
#define XB_XGEN(j)  (2304 + 64 * (j))
#define XB_TOP      3328
#define XB_TOPGEN   3392
#define XCD_BAR_WORDS 3456
#define XB_SPIN_CAP (1u << 18)

__device__ __forceinline__ unsigned xb_ld(unsigned* p)              { return __hip_atomic_load(p, __ATOMIC_RELAXED, __HIP_MEMORY_SCOPE_AGENT); }
__device__ __forceinline__ unsigned xb_add(unsigned* p, unsigned v) { return __hip_atomic_fetch_add(p, v, __ATOMIC_RELAXED, __HIP_MEMORY_SCOPE_AGENT); }
__device__ __forceinline__ unsigned xb_xcc_id() { return (unsigned)__builtin_amdgcn_s_getreg((3 << 11) | 20) & 0xFu; }
#define XB_SPIN(cond, bar) do { unsigned _sp = 0; while (cond) { __builtin_amdgcn_s_sleep(1); \
    if ((++_sp & 255u) == 0u) { if (xb_ld(&(bar)[XB_TMO])) break; if (_sp > XB_SPIN_CAP) { atomicAdd(&(bar)[XB_TMO], 1u); break; } } } } while (0)

struct XcdBarrier {
    unsigned* bar; unsigned x;
    volatile LAS unsigned* st;
};

__device__ __forceinline__ XcdBarrier xcd_barrier_post(unsigned* bar, volatile LAS unsigned* st) {
    XcdBarrier b; b.bar = bar; b.x = xb_xcc_id(); b.st = st;
    if (threadIdx.x == 0) (void)xb_add(&bar[XB_XCNT(b.x)], 1u);
    return b;
}
__device__ __forceinline__ void xcd_barrier_complete(unsigned* bar, unsigned x, unsigned& nloc, unsigned& nx) {
    const unsigned G = gridDim.x * gridDim.y * gridDim.z;
    unsigned sum, cnt, mine, sp = 0u;
    for (;;) {
        sum = 0u; cnt = 0u; mine = 0u;
#pragma unroll
        for (unsigned j = 0; j < 16; ++j) { const unsigned c = xb_ld(&bar[XB_XCNT(j)]); sum += c; cnt += (c > 0u) ? 1u : 0u; mine = (j == x) ? c : mine; }
        if (sum == G) break;
        __builtin_amdgcn_s_sleep(1);
        if ((++sp & 255u) == 0u) { if (xb_ld(&bar[XB_TMO])) break; if (sp > XB_SPIN_CAP) { atomicAdd(&bar[XB_TMO], 1u); break; } }
    }
    nloc = mine > 0u ? mine : 1u; nx = cnt > 0u ? cnt : 1u;
}

__device__ __forceinline__ void xcd_barrier(const XcdBarrier& b) {
    asm volatile("s_waitcnt vmcnt(0)" ::: "memory");
    __syncthreads();
    if (threadIdx.x == 0) {
        unsigned* bar = b.bar;
        __builtin_amdgcn_s_waitcnt(0);
        unsigned nloc = b.st[0], nx = b.st[1];
        if (nloc == 0u) { xcd_barrier_complete(bar, b.x, nloc, nx); b.st[0] = nloc; b.st[1] = nx; }
        const unsigned old = xb_add(&bar[XB_XSUB(b.x)], 1u);
        const unsigned gen = old / nloc;
        if (old + 1u == (gen + 1u) * nloc) {
            __builtin_amdgcn_fence(__ATOMIC_RELEASE, "agent");
            asm volatile("s_waitcnt vmcnt(0)" ::: "memory");
            const unsigned og = xb_add(&bar[XB_TOP], 1u);
            const unsigned tg = og / nx;
            if (og + 1u == (tg + 1u) * nx) xb_add(&bar[XB_TOPGEN], 1u);
            else XB_SPIN(xb_ld(&bar[XB_TOPGEN]) == tg, bar);
            __builtin_amdgcn_fence(__ATOMIC_ACQUIRE, "agent");
            xb_add(&bar[XB_XGEN(b.x)], 1u);
            asm volatile("s_waitcnt vmcnt(0)" ::: "memory");
        } else {
            XB_SPIN(xb_ld(&bar[XB_XGEN(b.x)]) == gen, bar);
            __builtin_amdgcn_fence(__ATOMIC_ACQUIRE, "agent");
            asm volatile("s_waitcnt vmcnt(0)" ::: "memory");
        }
    }
    __syncthreads();
}

__device__ __forceinline__ void grp_barrier(unsigned* gw, volatile LAS unsigned* same, unsigned* barwords) {
    asm volatile("s_waitcnt vmcnt(0)" ::: "memory");
    __syncthreads();
    if (threadIdx.x == 0) {
        __builtin_amdgcn_s_waitcnt(0);
        unsigned sm = same[0];
        if (sm == 0u) { const unsigned a0 = xb_ld(gw + 8), a1 = xb_ld(gw + 9), a2 = xb_ld(gw + 10), a3 = xb_ld(gw + 11); sm = (a0 != 0u && a0 == a1 && a1 == a2 && a2 == a3) ? 1u : 2u; same[0] = sm; }
        if (sm != 1u) { __builtin_amdgcn_fence(__ATOMIC_RELEASE, "agent"); asm volatile("s_waitcnt vmcnt(0)" ::: "memory"); }
        const unsigned old = xb_add(gw, 1u), target = (old / 4u + 1u) * 4u;
        XB_SPIN(xb_ld(gw) < target, barwords);
        __builtin_amdgcn_fence(__ATOMIC_ACQUIRE, "agent");
        asm volatile("s_waitcnt vmcnt(0)" ::: "memory");
    }
    __syncthreads();
}


__device__ __forceinline__ void tr_load(const float* W, const float* gain, int N, int k0, int n0, f32x4 (&v)[16], f32x4 (&g)[2], int lane) {
    int nc = n0 + (lane & 15) * 4; nc = nc < N - 4 ? nc : N - 4; const int kr = lane >> 4;
    const GAS float* gp = (const GAS float*)(gain ? gain : W) + k0 + 8 * (lane & 7);
    g[0] = *(const GAS f32x4*)gp; g[1] = *(const GAS f32x4*)(gp + 4);
    const GAS float* src = (const GAS float*)W + (size_t)(k0 + kr) * N + nc;
#pragma unroll
    for (int i = 0; i < 16; ++i) v[i] = *(const GAS f32x4*)(src + (size_t)(4 * i) * N);
}
__device__ __forceinline__ void tr_store(bf16* WT, bool hg, int K, int N, int k0, int n0, int drow0, const f32x4 (&v)[16], const f32x4 (&g)[2], LAS float* scr, int lane) {
    const int c4 = (lane & 15) * 4, kr = lane >> 4;
#pragma unroll
    for (int i = 0; i < 16; ++i) { const int k = 4 * i + kr; scr[(c4 + 0) * 65 + k] = v[i].x; scr[(c4 + 1) * 65 + k] = v[i].y; scr[(c4 + 2) * 65 + k] = v[i].z; scr[(c4 + 3) * 65 + k] = v[i].w; }
    LDS_WAIT(); asm volatile("" ::: "memory");
    const int c = lane & 7;
    const float m0 = hg ? g[0].x : 1.f, m1 = hg ? g[0].y : 1.f, m2 = hg ? g[0].z : 1.f, m3 = hg ? g[0].w : 1.f, m4 = hg ? g[1].x : 1.f, m5 = hg ? g[1].y : 1.f, m6 = hg ? g[1].z : 1.f, m7 = hg ? g[1].w : 1.f;
#pragma unroll
    for (int j = 0; j < 8; ++j) { const int n = (lane >> 3) + 8 * j; const LAS float* s = scr + n * 65 + 8 * c;
        v4u o; o.x = pk2(s[0] * m0, s[1] * m1); o.y = pk2(s[2] * m2, s[3] * m3); o.z = pk2(s[4] * m4, s[5] * m5); o.w = pk2(s[6] * m6, s[7] * m7);
        if (n0 + n < N) *(GAS v4u*)(WT + (size_t)(drow0 + n) * K + k0 + 8 * c) = o; }
    LDS_WAIT(); asm volatile("" ::: "memory");
}
__device__ __forceinline__ int map_row(int mt, int n) {
    if (mt == 1) { if (n >= 2048 && n < 3072) { const int v = (n >= 2560) ? 1 : 0, nn = n - 2048 - v * 512; return 2048 + (nn >> 7) * 256 + v * 128 + (nn & 127); } return n; }
    if (mt == 2) { const int v = (n >= 512) ? 1 : 0, nn = n - v * 512; return (nn >> 7) * 256 + v * 128 + (nn & 127); }
    if (mt == 3) return (n >> 7) * 256 + (n & 127);
    if (mt == 4) return (n >> 7) * 256 + 128 + (n & 127);
    return n;
}
__device__ __forceinline__ void conv_matrix(const float* W, const float* gain, int K, int N, bf16* WT, int mt, LAS float* scr, int gw, int NGW, int lane, int& rot) {
    const int nblk = (N + 63) / 64, nitems = (K / 64) * nblk;
    int it = gw - rot; if (it < 0) it += NGW;
    rot = (rot + nitems) % NGW;
    f32x4 va[16], vb[16], ga[2], gb[2];
#define CONV_KB(i_) ((i_) / nblk)
#define CONV_LOAD(v_, g_, i_) tr_load(W, gain, N, 64 * CONV_KB(i_), 64 * ((i_) - CONV_KB(i_) * nblk), v_, g_, lane)
#define CONV_STORE(v_, g_, i_) tr_store(WT, gain != nullptr, K, N, 64 * CONV_KB(i_), 64 * ((i_) - CONV_KB(i_) * nblk), map_row(mt, 64 * ((i_) - CONV_KB(i_) * nblk)), v_, g_, scr, lane)
    if (it < nitems) CONV_LOAD(va, ga, it);
    while (it < nitems) {
        const int i1 = it + NGW; if (i1 < nitems) CONV_LOAD(vb, gb, i1);
        CONV_STORE(va, ga, it);
        if (i1 >= nitems) break;
        const int i2 = i1 + NGW; if (i2 < nitems) CONV_LOAD(va, ga, i2);
        CONV_STORE(vb, gb, i1);
        it = i2;
    }
#undef CONV_KB
#undef CONV_LOAD
#undef CONV_STORE
}

__device__ __forceinline__ float wave_sum_dpp(float v) {
#define FN_DPP(ctrl) v += __uint_as_float((unsigned)__builtin_amdgcn_update_dpp(0, (int)__float_as_uint(v), ctrl, 0xf, 0xf, false))
    FN_DPP(0xB1); FN_DPP(0x4E); FN_DPP(0x124); FN_DPP(0x128);
#undef FN_DPP
    return bfly32_sum(bfly16_sum(v));
}
__device__ __forceinline__ void xb_phase(const float* x, bf16* XB, float* ss, int gw, int NGW, int lane) {
    for (int m = gw; m < M; m += NGW) {
        const GAS f32x4* xr = (const GAS f32x4*)(x + (size_t)m * DM) + lane; f32x4 v[8]; float s = 0.f;
#pragma unroll
        for (int j = 0; j < 8; ++j) { v[j] = xr[64 * j]; s += (v[j].x * v[j].x + v[j].y * v[j].y) + (v[j].z * v[j].z + v[j].w * v[j].w); }
        s = wave_sum_dpp(s);
#pragma unroll
        for (int j = 0; j < 8; ++j) { const int c0 = 4 * (lane + 64 * j); v2u w; w.x = pk2(v[j].x, v[j].y); w.y = pk2(v[j].z, v[j].w);
            *(GAS v2u*)(XB + ((size_t)((m >> 8) * 8 + (c0 >> 8)) << 16) + (size_t)(m & 255) * 256 + (c0 & 255)) = w; }
        if (lane < 32) ((GAS float*)ss)[(size_t)m * 32 + lane] = lane == 0 ? s : 0.f;
    }
}
__device__ __forceinline__ void final_norm_phase(const bf16* xb, const float* g, float* out, int gw, int NGW, int lane) {
    f32x4 gg[4][2];
#pragma unroll
    for (int j = 0; j < 4; ++j) { const int c0 = (lane + 64 * j) * 8; gg[j][0] = *(const GAS f32x4*)(g + c0); gg[j][1] = *(const GAS f32x4*)(g + c0 + 4); }
    v4u v[4], vn[4];
#define FN_LOAD(dst, m_) do { _Pragma("unroll") for (int j = 0; j < 4; ++j) { const int c0 = 8 * (lane + 64 * j); dst[j] = *(const GAS v4u*)(xb + ((size_t)(((m_) >> 8) * 8 + (c0 >> 8)) << 16) + (size_t)((m_) & 255) * 256 + (c0 & 255)); } } while (0)
    if (gw < M) FN_LOAD(vn, gw);
    for (int m = gw; m < M; m += NGW) {
#pragma unroll
        for (int j = 0; j < 4; ++j) v[j] = vn[j];
        { const int mn = m + NGW < M ? m + NGW : m; FN_LOAD(vn, mn); }
        float s = 0.f;
#pragma unroll
        for (int j = 0; j < 4; ++j) { const unsigned w[4] = {v[j].x, v[j].y, v[j].z, v[j].w};
#pragma unroll
            for (int e = 0; e < 4; ++e) { const float lo = __uint_as_float(w[e] << 16), hi = __uint_as_float(w[e] & 0xffff0000u); s += lo * lo + hi * hi; } }
        const float r = 1.0f / sqrtf(wave_sum_dpp(s) * (1.f / DM) + RMS_EPS);
#pragma unroll
        for (int j = 0; j < 4; ++j) { const int c0 = (lane + 64 * j) * 8; const unsigned w[4] = {v[j].x, v[j].y, v[j].z, v[j].w};
            const f32x4 g0 = gg[j][0], g1 = gg[j][1];
            f32x4 o0, o1; o0.x = __uint_as_float(w[0] << 16) * r * g0.x; o0.y = __uint_as_float(w[0] & 0xffff0000u) * r * g0.y; o0.z = __uint_as_float(w[1] << 16) * r * g0.z; o0.w = __uint_as_float(w[1] & 0xffff0000u) * r * g0.w;
            o1.x = __uint_as_float(w[2] << 16) * r * g1.x; o1.y = __uint_as_float(w[2] & 0xffff0000u) * r * g1.y; o1.z = __uint_as_float(w[3] << 16) * r * g1.z; o1.w = __uint_as_float(w[3] & 0xffff0000u) * r * g1.w;
            GAS f32x4* op = (GAS f32x4*)(out + (size_t)m * DM + c0); op[0] = o0; op[1] = o1; }
    }
#undef FN_LOAD
}

__device__ __forceinline__ void build_bias_tab(LAS float* tab, const float* rel_bias, int tid) {
    for (int e = tid; e < TAB_ENTRIES; e += NWAVES * 64) { const int rel = e >> 4, h = e & 15; int bk;
        if (rel < 16) bk = rel; else if (rel >= 128) bk = 31; else { bk = 16 + (int)(logf((float)rel * (1.f / 16.f)) / logf(8.f) * 16.f); bk = bk > 31 ? 31 : bk; }
        tab[e] = rel_bias[bk * 16 + h]; }
}

__device__ __forceinline__ unsigned mono_key(float s) { const unsigned u = __float_as_uint(s); return (u & 0x80000000u) ? ~u : (u | 0x80000000u); }
__device__ __forceinline__ int mbcnt64(unsigned long long m) { return (int)__builtin_amdgcn_mbcnt_hi((unsigned)(m >> 32), __builtin_amdgcn_mbcnt_lo((unsigned)m, 0u)); }
constexpr int IDX_CAND = 512;
__device__ __forceinline__ void idx_scan(LAS unsigned* hrow, unsigned k_rem, int lane, unsigned& D, unsigned& above, unsigned& cD) {
    const int rl = 63 - lane;
    v4u w[4];
#pragma unroll
    for (int k = 0; k < 4; ++k) w[k] = *(const LAS v4u*)(hrow + 16 * rl + 4 * k);
    const unsigned wd[16] = {w[0].x, w[0].y, w[0].z, w[0].w, w[1].x, w[1].y, w[1].z, w[1].w, w[2].x, w[2].y, w[2].z, w[2].w, w[3].x, w[3].y, w[3].z, w[3].w};
    unsigned tot = 0u;
#pragma unroll
    for (int k = 0; k < 16; ++k) tot += (wd[k] & 0xffffu) + (wd[k] >> 16);
    unsigned v = tot;
#define IDX_DPP_ADD(ctrl, rmask, bmask) v += (unsigned)__builtin_amdgcn_update_dpp(0, (int)v, ctrl, rmask, bmask, false)
    IDX_DPP_ADD(0x111, 0xf, 0xf); IDX_DPP_ADD(0x112, 0xf, 0xf); IDX_DPP_ADD(0x114, 0xf, 0xe); IDX_DPP_ADD(0x118, 0xf, 0xc); IDX_DPP_ADD(0x142, 0xa, 0xf); IDX_DPP_ADD(0x143, 0xc, 0xf);
#undef IDX_DPP_ADD
    const unsigned sx = v - tot;
    const bool mine = (sx < k_rem) && (k_rem <= sx + tot);
    unsigned S = sx + tot, kw = 0u, alw = sx, xw = 0u;
#pragma unroll
    for (int k = 0; k < 16; ++k) { const unsigned wsk = (wd[k] & 0xffffu) + (wd[k] >> 16), Sn = S - wsk; const bool ge = S >= k_rem;
        xw = ge ? wd[k] : xw; alw = ge ? Sn : alw; kw = ge ? (unsigned)k : kw; S = Sn; }
    const unsigned chi = xw >> 16, clo = xw & 0xffffu;
    const bool inhi = alw + chi >= k_rem;
    const unsigned Dl = (unsigned)(32 * rl) + 2u * kw + (inhi ? 1u : 0u), al = inhi ? alw : alw + chi, cl = inhi ? chi : clo;
    const unsigned long long bal = __ballot(mine); const int Ls = bal ? (__ffsll((long long)bal) - 1) : 0;
    D = (unsigned)__builtin_amdgcn_readlane((int)Dl, Ls); above = (unsigned)__builtin_amdgcn_readlane((int)al, Ls); cD = (unsigned)__builtin_amdgcn_readlane((int)cl, Ls);
#pragma unroll
    for (int k = 0; k < 4; ++k) *(LAS v4u*)(hrow + 16 * rl + 4 * k) = (v4u){0u, 0u, 0u, 0u};
}
__device__ __forceinline__ void indexer_phase(LAS unsigned char* lds, const bf16* QI, const bf16* KIW, const bf16* KIT, int* IDX, int c, int G, int tid, int wave, int lane) {
    LAS unsigned* sc = (LAS unsigned*)lds;
    LAS unsigned* hist = (LAS unsigned*)(lds + 131072);
    LAS int* cand = (LAS int*)(lds + 131072 + 16384);
    volatile LAS unsigned* st = (volatile LAS unsigned*)(lds + 131072 + 16384 + 8192);
    for (int i = tid; i < 4096; i += NWAVES * 64) hist[i] = 0u;
    __syncthreads();
    const int q = wave >> 1, half = wave & 1;
    const int r32 = lane & 31, hf = lane >> 5;
    constexpr int NU = M / 4;
    for (int rnd = 0; rnd * G < NU; ++rnd) {
        const int L = rnd * G + ((rnd & 1) ? (G - 1 - c) : c);
        if (L >= NU) continue;
        const int b = L & 1, t0 = (L >> 1) * 4; const size_t tok0 = (size_t)b * SEQ;
        const int t = t0 + q, n = t + 1;
        GAS int* orow = (GAS int*)(IDX + (tok0 + t) * TOPK);
        if (t0 + 4 <= TOPK) {
#pragma unroll
            for (int j = 0; j < 2; ++j) { const int p = half * 128 + j * 64 + lane; orow[p] = p < n ? p : -1; }
            continue;
        }
#ifndef IDX_REP_SCORE
#define IDX_REP_SCORE 1
#endif
        for (int srep = 0; srep < IDX_REP_SCORE; ++srep) {
            const int ntiles = (t0 + 4 + 31) >> 5;
            const int nmine = (ntiles - wave + NWAVES - 1) / NWAVES;
            const GAS bf16* kbase = (const GAS bf16*)(KIT + (tok0 >> 5) * (4 * 64 * 8) + lane * 8);
            bf16x8 B0[4], B1[4], B2[4];
#define IDX_LOAD(Bx, i) do { const int ii_ = (i) < nmine ? (i) : nmine - 1; const GAS bf16* ks_ = kbase + (size_t)(wave + NWAVES * ii_) * (4 * 64 * 8); _Pragma("unroll") for (int ks = 0; ks < 4; ++ks) Bx[ks] = *(const GAS bf16x8*)(ks_ + ks * (64 * 8)); } while (0)
            IDX_LOAD(B0, 0); IDX_LOAD(B1, 1);
            bf16x8 A[2][4]; float wgt[2][16];
            const int ql = (r32 >> 2) & 1, h = (r32 & 3) + 4 * (r32 >> 3);
#pragma unroll
            for (int rb = 0; rb < 2; ++rb) { const GAS bf16* src = (const GAS bf16*)(QI + (tok0 + t0 + 2 * rb + ql) * 1024 + h * 64 + 8 * hf);
#pragma unroll
                for (int ks = 0; ks < 4; ++ks) A[rb][ks] = *(const GAS bf16x8*)(src + ks * 16); }
#pragma unroll
            for (int rb = 0; rb < 2; ++rb) { const GAS bf16* wsrc = (const GAS bf16*)(KIW + (tok0 + t0 + 2 * rb + hf) * 256 + 64);
                const v4u w0 = *(const GAS v4u*)wsrc, w1 = *(const GAS v4u*)(wsrc + 8);
                const unsigned ww[8] = {w0.x, w0.y, w0.z, w0.w, w1.x, w1.y, w1.z, w1.w};
#pragma unroll
                for (int i = 0; i < 8; ++i) { wgt[rb][2 * i] = __uint_as_float(ww[i] << 16) * (1.f / 32.f); wgt[rb][2 * i + 1] = __uint_as_float(ww[i] & 0xffff0000u) * (1.f / 32.f); } }
#define IDX_PROBE_ATOM
#define IDX_TILE(Bx, i) do { if ((i) < nmine) { const int j_ = wave + NWAVES * (i); \
                f32x16 acc0, acc1; _Pragma("unroll") for (int e = 0; e < 16; ++e) { acc0[e] = 0.f; acc1[e] = 0.f; } \
                _Pragma("unroll") for (int ks = 0; ks < 4; ++ks) { acc0 = __builtin_amdgcn_mfma_f32_32x32x16_bf16(A[0][ks], Bx[ks], acc0, 0, 0, 0); acc1 = __builtin_amdgcn_mfma_f32_32x32x16_bf16(A[1][ks], Bx[ks], acc1, 0, 0, 0); }     \
                _Pragma("unroll") for (int rb = 0; rb < 2; ++rb) { \
                    float sa_ = 0.f, sb_ = 0.f, sc_ = 0.f, sd_ = 0.f;                                                                   \
                    _Pragma("unroll") for (int e = 0; e < 4; ++e) { const float x0 = rb ? acc1[e] : acc0[e], x1 = rb ? acc1[e + 4] : acc0[e + 4], x2 = rb ? acc1[e + 8] : acc0[e + 8], x3 = rb ? acc1[e + 12] : acc0[e + 12]; \
                        sa_ = fmaf(wgt[rb][e], __int_as_float(max(__float_as_int(x0), 0)), sa_); sb_ = fmaf(wgt[rb][e + 4], __int_as_float(max(__float_as_int(x1), 0)), sb_); \
                        sc_ = fmaf(wgt[rb][e + 8], __int_as_float(max(__float_as_int(x2), 0)), sc_); sd_ = fmaf(wgt[rb][e + 12], __int_as_float(max(__float_as_int(x3), 0)), sd_); } \
                    const float s_ = (sa_ + sb_) + (sc_ + sd_); \
                    const int tq_ = t0 + 2 * rb + hf, key_ = j_ * 32 + r32; const bool ok_ = key_ <= tq_; const unsigned mk_ = ok_ ? mono_key(s_) : 0u; \
                    sc[(2 * rb + hf) * 8192 + key_] = mk_; \
                    if (ok_ && srep == 0) { __hip_atomic_fetch_add(hist + (2 * rb + hf) * 1024 + (mk_ >> 22), 1u << ((mk_ >> 17) & 16u), __ATOMIC_RELAXED, __HIP_MEMORY_SCOPE_WORKGROUP); IDX_PROBE_ATOM } } } } while (0)
#define IDX_TILE2(Bx, i) IDX_TILE(Bx, i)
#define IDX_LOAD2(Bx, i) IDX_LOAD(Bx, i)
#pragma unroll 1
            for (int i = 0; i < nmine; i += 3) {
                IDX_LOAD2(B2, i + 2); IDX_TILE2(B0, i);
                IDX_LOAD2(B0, i + 3); IDX_TILE2(B1, i + 1);
                IDX_LOAD2(B1, i + 4); IDX_TILE2(B2, i + 2);
            }
#undef IDX_TILE2
#undef IDX_LOAD2
#undef IDX_LOAD
#undef IDX_TILE
        }
        __syncthreads();
        LAS unsigned* srow = sc + q * 8192; LAS unsigned* hrow = hist + q * 1024; LAS int* crow = cand + q * IDX_CAND;
        if (half == 0) { unsigned D, above, cD; idx_scan(hrow, (unsigned)TOPK, lane, D, above, cD);
            if (lane == 0) { st[q * 4 + 0] = D << 21; st[q * 4 + 1] = (unsigned)TOPK - above; st[q * 4 + 2] = cD; } }
        __syncthreads();
        int shift = 21;
        while (shift > 0 && (st[2] > IDX_CAND || st[6] > IDX_CAND || st[10] > IDX_CAND || st[14] > IDX_CAND)) {
            const unsigned prefix = st[q * 4 + 0], k_rem = st[q * 4 + 1]; const int nshift = shift > 11 ? shift - 11 : 0; const unsigned dmask = (1u << (shift - nshift)) - 1u;
            const int nh_ = ((n >> 1) + 63) & ~63; const int lo_ = half ? nh_ : 0, hi_ = half ? n : (nh_ < n ? nh_ : n);
            __syncthreads();
            for (int i = lo_ + lane; i < hi_; i += 64) { const unsigned key = srow[i];
                if ((key >> shift) == (prefix >> shift)) { const unsigned d = (key >> nshift) & dmask; __hip_atomic_fetch_add(hrow + (d >> 1), 1u << (16 * (d & 1)), __ATOMIC_RELAXED, __HIP_MEMORY_SCOPE_WORKGROUP); } }
            __syncthreads();
            if (half == 0) { unsigned D, above, cD; idx_scan(hrow, k_rem, lane, D, above, cD);
                if (lane == 0) { st[q * 4 + 0] = prefix | (D << nshift); st[q * 4 + 1] = k_rem - above; st[q * 4 + 2] = cD; } }
            __syncthreads();
            shift = nshift;
        }
        const unsigned prefix = st[q * 4 + 0]; const int need = (int)st[q * 4 + 1], cD = (int)st[q * 4 + 2], c_gt = TOPK - need;
        const unsigned tp = prefix >> shift; const bool exact_dup = cD > IDX_CAND;
        const int nh = ((n >> 1) + 63) & ~63; const int lo = half ? nh : 0, hi = half ? n : (nh < n ? nh : n);
        if (exact_dup) {
          if (half == 0) {
            int cg = 0, ce = 0;
            for (int base = 0; base < n; base += 64) { const int i = base + lane; const unsigned kp = (i < n) ? srow[i] : 0u;
                const bool gt = (i < hi) && kp > tp, eq = (i < n) && kp == tp;
                const unsigned long long mg = __ballot(gt), me = __ballot(eq);
                const int pg = cg + mbcnt64(mg), pe = ce + mbcnt64(me);
                if (gt) orow[pg] = i;
                if (eq && pe < need) orow[c_gt + pe] = i;
                cg += __popcll(mg); ce += __popcll(me); }
          } else if (hi > lo) {
            int cg = 0;
            for (int base = lo + ((hi - 1 - lo) & ~63); base >= lo; base -= 64) { const int i = base + lane; const bool in = i < hi; const unsigned kp = in ? srow[i] : 0u;
                const bool gt = in && kp > tp; const unsigned long long mg = __ballot(gt);
                const int ag = __popcll(mg) - mbcnt64(mg) - (gt ? 1 : 0);
                if (gt) orow[c_gt - 1 - cg - ag] = i;
                cg += __popcll(mg); }
          }
        } else {
          LAS unsigned short* hl_ = (LAS unsigned short*)hrow + half * 1024;
          int nhit = 0;
          for (int base = lo; base < hi; base += 256) {
              const int i0 = base + 4 * lane; const v4u k4 = (i0 < hi) ? *(const LAS v4u*)(srow + i0) : (v4u){0u, 0u, 0u, 0u};
              const bool h0 = (i0 < hi) && (k4.x >> shift) >= tp, h1 = (i0 + 1 < hi) && (k4.y >> shift) >= tp, h2 = (i0 + 2 < hi) && (k4.z >> shift) >= tp, h3 = (i0 + 3 < hi) && (k4.w >> shift) >= tp;
              const int cnt = (int)h0 + (int)h1 + (int)h2 + (int)h3;
              int v = cnt;
#define IDX_DPP_ADD(ctrl, rmask, bmask) v += __builtin_amdgcn_update_dpp(0, v, ctrl, rmask, bmask, false)
              IDX_DPP_ADD(0x111, 0xf, 0xf); IDX_DPP_ADD(0x112, 0xf, 0xf); IDX_DPP_ADD(0x114, 0xf, 0xe); IDX_DPP_ADD(0x118, 0xf, 0xc); IDX_DPP_ADD(0x142, 0xa, 0xf); IDX_DPP_ADD(0x143, 0xc, 0xf);
#undef IDX_DPP_ADD
              int p = nhit + v - cnt;
              if (h0) { hl_[p] = (unsigned short)i0; ++p; }
              if (h1) { hl_[p] = (unsigned short)(i0 + 1); ++p; }
              if (h2) { hl_[p] = (unsigned short)(i0 + 2); ++p; }
              if (h3) { hl_[p] = (unsigned short)(i0 + 3); }
              nhit += __builtin_amdgcn_readlane(v, 63);
          }
          if (half == 0) {
            int cg = 0, ce = 0;
            for (int j0 = 0; j0 < nhit; j0 += 64) { const int j = j0 + lane; const bool in = j < nhit; const int i = in ? (int)hl_[j] : 0; const unsigned kp = in ? (srow[i] >> shift) : 0u;
                const bool gt = in && kp > tp, eq = in && kp == tp;
                const unsigned long long mg = __ballot(gt), me = __ballot(eq);
                const int pg = cg + mbcnt64(mg), pe = ce + mbcnt64(me);
                if (gt) orow[pg] = i;
                if (eq) crow[pe] = i;
                cg += __popcll(mg); ce += __popcll(me); }
          } else if (nhit > 0) {
            int cg = 0, ce = 0;
            for (int j0 = (nhit - 1) & ~63; j0 >= 0; j0 -= 64) { const int j = j0 + lane; const bool in = j < nhit; const int i = in ? (int)hl_[j] : 0; const unsigned kp = in ? (srow[i] >> shift) : 0u;
                const bool gt = in && kp > tp, eq = in && kp == tp;
                const unsigned long long mg = __ballot(gt), me = __ballot(eq);
                const int ag = __popcll(mg) - mbcnt64(mg) - (gt ? 1 : 0), ae = __popcll(me) - mbcnt64(me) - (eq ? 1 : 0);
                if (gt) orow[c_gt - 1 - cg - ag] = i;
                if (eq) crow[cD - 1 - ce - ae] = i;
                cg += __popcll(mg); ce += __popcll(me); }
          }
        }
        __syncthreads();
#ifndef IDX_REP_TAIL
#define IDX_REP_TAIL 1
#endif
        for (int trep = 0; trep < IDX_REP_TAIL; ++trep)
        if (half == 0 && !exact_dup) {
#pragma unroll
            for (int k = 0; k < 4; ++k) *(LAS v4u*)(hrow + 16 * lane + 4 * k) = (v4u){0u, 0u, 0u, 0u};
            unsigned pfx = prefix, k_rem = (unsigned)need; int sh = shift;
            int ci[8]; unsigned ck[8];
#pragma unroll
            for (int m = 0; m < 8; ++m) { const int j = lane + 64 * m; ci[m] = j < cD ? crow[j] : 0; }
            __builtin_amdgcn_sched_barrier(0);
#pragma unroll
            for (int m = 0; m < 8; ++m) { const int j = lane + 64 * m; ck[m] = j < cD ? srow[ci[m]] : 0u; }
            __builtin_amdgcn_sched_barrier(0);
            while (sh > 0) {
                const int nsh = sh > 11 ? sh - 11 : 0; const unsigned dmask = (1u << (sh - nsh)) - 1u;
#pragma unroll
                for (int m = 0; m < 8; ++m) { const int j = lane + 64 * m; const unsigned key = ck[m];
                    if (j < cD && (key >> sh) == (pfx >> sh)) { const unsigned d = (key >> nsh) & dmask; __hip_atomic_fetch_add(hrow + (d >> 1), 1u << (16 * (d & 1)), __ATOMIC_RELAXED, __HIP_MEMORY_SCOPE_WORKGROUP); } }
                unsigned D, above, cDn; idx_scan(hrow, k_rem, lane, D, above, cDn);
                pfx |= D << nsh; k_rem -= above; sh = nsh;
            }
            int cg = 0, ce = 0; const int n_gt = need - (int)k_rem;
#pragma unroll
            for (int m = 0; m < 8; ++m) { const int j = lane + 64 * m; const bool in = j < cD; const unsigned key = ck[m];
                const bool gt = in && key > pfx, eq = in && key == pfx;
                const unsigned long long mg = __ballot(gt), me = __ballot(eq);
                const int pg = cg + mbcnt64(mg), pe = ce + mbcnt64(me);
                if (gt) orow[c_gt + pg] = ci[m];
                if (eq && pe < (int)k_rem) orow[c_gt + n_gt + pe] = ci[m];
                cg += __popcll(mg); ce += __popcll(me); }
        }
        __syncthreads();
    }
}
constexpr float ATT_SCALE = 0.08838834764831845f;
__device__ __forceinline__ unsigned pkbf(float lo, float hi) { return pg8::cvt_pk_bf16(lo, hi); }
__device__ __forceinline__ void dsa_attn_phase(LAS unsigned char* lds, const bf16* Q, const unsigned char* KV8, const int* IDX, bf16* AO, const float* rel_bias, int c, int G, int tid, int wave, int lane) {
    typedef int v4i __attribute__((ext_vector_type(4))); typedef float f32x2 __attribute__((ext_vector_type(2)));
    constexpr int KSTR = 144, VSTR = 272, WBYTES = 32 * KSTR + 32 * VSTR;
    LAS unsigned char* kb = lds + wave * WBYTES; LAS unsigned char* vb = kb + 32 * KSTR;
    LAS int* idl = (LAS int*)(lds + NWAVES * WBYTES + wave * 2048);
    LAS float* tab = (LAS float*)(lds + NWAVES * WBYTES + NWAVES * 2048);
    build_bias_tab(tab, rel_bias, tid);
    __syncthreads();
    const int hl = lane & 15, Gq = lane >> 4, hsel = hl & 3, qrow = hl >> 2, pcol = lane & 3;
    const int NGW = G * NWAVES;
    const int uid0 = c * NWAVES + wave, nun = (8 * SEQ - uid0 + NGW - 1) / NGW;
    v4i ivn; v4u qraw[4];
#define DSA_UNIT(u_, k_, bg_, t_, tok_) const int u_ = uid0 + ((k_) < nun ? (k_) : nun - 1) * NGW; const int bg_ = (u_ >> 3) & 7, t_ = ((u_ >> 6) << 3) | (u_ & 7); const size_t tok_ = (size_t)(bg_ >> 2) * SEQ + t_
    { DSA_UNIT(ua_, 0, bg0, t0_, tok0); ivn = *(const GAS v4i*)(IDX + tok0 * TOPK + lane * 4);
      const GAS bf16* qs = (const GAS bf16*)(Q + tok0 * DM + ((bg0 & 3) * 4 + hsel) * HDIM + 8 * Gq);
#pragma unroll
      for (int ks = 0; ks < 4; ++ks) qraw[ks] = *(const GAS v4u*)(qs + ks * 32);
      *(LAS v4i*)(idl + lane * 4) = ivn; }
    v4u stk[4], stv[4];
#define DSA_RSRC(bg_) __builtin_amdgcn_make_buffer_rsrc((void*)(((unsigned long long)(unsigned)__builtin_amdgcn_readfirstlane((int)(unsigned)(((unsigned long long)(KV8 + (size_t)(bg_) * SEQ * 256)) >> 32)) << 32) | (unsigned)__builtin_amdgcn_readfirstlane((int)(unsigned)(unsigned long long)(KV8 + (size_t)(bg_) * SEQ * 256))), (short)0, SEQ * 256, 0x00020000)
#define DSA_LOAD(idp, cc, rs_) { int sj_[4]; _Pragma("unroll") for (int j = 0; j < 4; ++j) sj_[j] = (idp)[(cc) * 32 + 8 * j + (lane >> 3)]; __builtin_amdgcn_sched_barrier(0); \
        _Pragma("unroll") for (int j = 0; j < 4; ++j) { const int vo_ = (max(sj_[j], 0) << 8) + (lane & 7) * 16; stk[j] = __builtin_bit_cast(v4u, __builtin_amdgcn_raw_buffer_load_b128(rs_, vo_, 0, 0)); stv[j] = __builtin_bit_cast(v4u, __builtin_amdgcn_raw_buffer_load_b128(rs_, vo_ + 128, 0, 0)); } }
    { DSA_UNIT(ub_, 0, bg0, t0_, tok0); (void)t0_; (void)tok0; const __amdgpu_buffer_rsrc_t rs0 = DSA_RSRC(bg0); DSA_LOAD(idl, 0, rs0) }
    for (int k = 0; k < nun; ++k) {
        DSA_UNIT(uc_, k, bg, t, tok); const int b = bg >> 2, g = bg & 3; (void)b;
        LAS int* idc = idl + (k & 1) * 256; LAS int* idn = idl + ((k + 1) & 1) * 256;
        long qf[4];
#pragma unroll
        for (int ks = 0; ks < 4; ++ks) { const v4u v = qraw[ks];
            int w0 = __builtin_amdgcn_cvt_pk_fp8_f32(__uint_as_float(v.x << 16) * 16.f, __uint_as_float(v.x & 0xffff0000u) * 16.f, 0, false); w0 = __builtin_amdgcn_cvt_pk_fp8_f32(__uint_as_float(v.y << 16) * 16.f, __uint_as_float(v.y & 0xffff0000u) * 16.f, w0, true);
            int w1 = __builtin_amdgcn_cvt_pk_fp8_f32(__uint_as_float(v.z << 16) * 16.f, __uint_as_float(v.z & 0xffff0000u) * 16.f, 0, false); w1 = __builtin_amdgcn_cvt_pk_fp8_f32(__uint_as_float(v.w << 16) * 16.f, __uint_as_float(v.w & 0xffff0000u) * 16.f, w1, true);
            qf[ks] = hl < 4 ? (long)(((unsigned long long)(unsigned)w1 << 32) | (unsigned)w0) : 0L; }
        unsigned long long fastmask;
        { const int mn_ = min(min(ivn[0], ivn[1]), min(ivn[2], ivn[3])), mx_ = max(max(ivn[0], ivn[1]), max(ivn[2], ivn[3])); fastmask = __ballot(mn_ >= 0 && t - mx_ >= 128); }
        DSA_UNIT(un_, k + 1, bgn, tn, tokn); (void)tn;
        ivn = *(const GAS v4i*)(IDX + tokn * TOPK + lane * 4);
        { const GAS bf16* qs = (const GAS bf16*)(Q + tokn * DM + ((bgn & 3) * 4 + hsel) * HDIM + 8 * Gq);
#pragma unroll
          for (int ks = 0; ks < 4; ++ks) qraw[ks] = *(const GAS v4u*)(qs + ks * 32); }
        const __amdgpu_buffer_rsrc_t kvbn = DSA_RSRC(bgn), kvbase = DSA_RSRC(bg);
        const int hq = g * 4 + hsel; const float bfar = tab[128 * 16 + hq] * 1.4426950408889634f;
        float mrun = -3.0e38f, lsum = 0.f; f32x4 O[8];
#pragma unroll
        for (int db = 0; db < 8; ++db) O[db] = (f32x4){0.f, 0.f, 0.f, 0.f};
#pragma unroll 1
        for (int cc = 0; cc < 8; ++cc) {
#pragma unroll
            for (int j = 0; j < 4; ++j) { const int key = 8 * j + (lane >> 3), pc = lane & 7;
                *(LAS v4u*)(kb + key * KSTR + pc * 16) = stk[j];
                const unsigned w[4] = {stv[j].x, stv[j].y, stv[j].z, stv[j].w}; unsigned o[8];
#pragma unroll
                for (int e = 0; e < 4; ++e) { typedef __bf16 bf2_t __attribute__((ext_vector_type(2))); o[2 * e] = __builtin_bit_cast(unsigned, (bf2_t)__builtin_amdgcn_cvt_scalef32_pk_bf16_fp8(w[e], 1.0f, false)); o[2 * e + 1] = __builtin_bit_cast(unsigned, (bf2_t)__builtin_amdgcn_cvt_scalef32_pk_bf16_fp8(w[e], 1.0f, true)); }
                *(LAS v4u*)(vb + key * VSTR + pc * 32) = (v4u){o[0], o[1], o[2], o[3]}; *(LAS v4u*)(vb + key * VSTR + pc * 32 + 16) = (v4u){o[4], o[5], o[6], o[7]}; }
            if (cc < 7) { DSA_LOAD(idc, cc + 1, kvbase) } else { *(LAS v4i*)(idn + lane * 4) = ivn; DSA_LOAD(idn, 0, kvbn) }
            long ka[2][4];
#pragma unroll
            for (int rb = 0; rb < 2; ++rb)
#pragma unroll
                for (int ks = 0; ks < 4; ++ks) ka[rb][ks] = *(const LAS long*)(kb + (16 * rb + hl) * KSTR + ks * 32 + 8 * Gq);
            __builtin_amdgcn_sched_barrier(0);
            f32x4 S[2];
#pragma unroll
            for (int rb = 0; rb < 2; ++rb) S[rb] = (f32x4){0.f, 0.f, 0.f, 0.f};
#pragma unroll
            for (int ks = 0; ks < 4; ++ks)
#pragma unroll
                for (int rb = 0; rb < 2; ++rb) S[rb] = __builtin_amdgcn_mfma_f32_16x16x32_fp8_fp8(ka[rb][ks], qf[ks], S[rb], 0, 0, 0);
            float l[2][4]; float cmax = -3.0e38f;
            if (((fastmask >> (8 * cc)) & 0xFFull) == 0xFFull) {
#pragma unroll
                for (int rb = 0; rb < 2; ++rb)
#pragma unroll
                    for (int i = 0; i < 4; ++i) { const float v = fmaf(S[rb][i], ATT_SCALE * (1.f / 256.f) * 1.4426950408889634f, bfar); l[rb][i] = v; cmax = fmaxf(cmax, v); }
            } else {
                const v4i sv0 = *(const LAS v4i*)(idc + cc * 32 + 4 * Gq), sv1 = *(const LAS v4i*)(idc + cc * 32 + 16 + 4 * Gq);
#pragma unroll
                for (int rb = 0; rb < 2; ++rb)
#pragma unroll
                    for (int i = 0; i < 4; ++i) { const int s_ = rb ? sv1[i] : sv0[i]; int rel = t - s_; rel = rel > 128 ? 128 : (rel < 0 ? 0 : rel);
                        const float v = (s_ >= 0) ? (S[rb][i] * (ATT_SCALE * (1.f / 256.f)) + tab[rel * 16 + hq]) * 1.4426950408889634f : -1.0e30f; l[rb][i] = v; cmax = fmaxf(cmax, v); }
            }
            cmax = bfly32_max(bfly16_max(cmax));
            const float mnew = fmaxf(mrun, cmax);
            if (__any(mnew > mrun)) {
                const float alpha = __builtin_amdgcn_exp2f(mrun - mnew); lsum *= alpha;
#pragma unroll
                for (int db = 0; db < 8; ++db) O[db] = O[db] * alpha;
            }
            mrun = mnew;
            float ps = 0.f;
#pragma unroll
            for (int rb = 0; rb < 2; ++rb)
#pragma unroll
                for (int i = 0; i < 4; ++i) { l[rb][i] = __builtin_amdgcn_exp2f(l[rb][i] - mnew); ps += l[rb][i]; }
            lsum += ps;
            v4u pu; pu.x = pkbf(l[0][0], l[0][1]); pu.y = pkbf(l[0][2], l[0][3]); pu.z = pkbf(l[1][0], l[1][1]); pu.w = pkbf(l[1][2], l[1][3]);
            const bf16x8 pa = __builtin_bit_cast(bf16x8, pu);
            s16x4 vt[8][2];
#pragma unroll
            for (int db = 0; db < 8; ++db) { vt[db][0] = vtr(vb + (4 * Gq + qrow) * VSTR + (16 * db + 4 * pcol) * 2); vt[db][1] = vtr(vb + (16 + 4 * Gq + qrow) * VSTR + (16 * db + 4 * pcol) * 2); }
            __builtin_amdgcn_sched_barrier(0);
#pragma unroll
            for (int db = 0; db < 8; ++db) { const s16x4 v0 = vt[db][0], v1 = vt[db][1];
                const bf16x8 a = (bf16x8){v0[0], v0[1], v0[2], v0[3], v1[0], v1[1], v1[2], v1[3]};
                O[db] = __builtin_amdgcn_mfma_f32_16x16x32_bf16(a, pa, O[db], 0, 0, 0); }
        }
#undef DSA_LOAD
#undef DSA_RSRC
#undef DSA_UNIT
        lsum = bfly32_sum(bfly16_sum(lsum));
        const float inv = 1.0f / (lsum * 16.0f);
        if (hl < 4) { GAS bf16* op = (GAS bf16*)(AO + tok * DM + (g * 4 + hl) * HDIM + 4 * Gq);
#pragma unroll
            for (int db = 0; db < 8; ++db) { const f32x4 o = O[db] * inv; v2u w; w.x = pkbf(o[0], o[1]); w.y = pkbf(o[2], o[3]); *(GAS v2u*)(op + 16 * db) = w; } }
    }
}

__device__ __forceinline__ void swa_attn_phase(LAS unsigned char* lds, const bf16* Q, const bf16* KV, bf16* AO, const float* rel_bias, const float* sinks, int c, int G, int tid, int wave, int lane) {
    LAS unsigned char* band = lds;
    LAS float* tab = (LAS float*)(lds + 272 * 528);
    LAS float* tabM = tab + TAB_ENTRIES;
    build_bias_tab(tab, rel_bias, tid);
    for (int i = tid; i < 16 * 528 / 4; i += NWAVES * 64) ((LAS unsigned*)(band + 256 * 528))[i] = 0u;
    const int hl = lane & 15, Gq = lane >> 4, qrow = hl >> 2, pcol = lane & 3;
    for (int uid = c; uid < 512; uid += G) {
        const int b = uid >> 8, nb = (uid & 255) >> 2, g = uid & 3, bg = b * 4 + g;
        __syncthreads();
        { const int piece = tid & 31;
#pragma unroll 4
          for (int i = 0; i < 16; ++i) { const int row = (tid >> 5) + 16 * i, ka = nb * 128 - 128 + row; v4u v = (v4u){0u, 0u, 0u, 0u};
              if (ka >= 0) v = *(const GAS v4u*)(KV + ((size_t)bg * SEQ + ka) * 256 + piece * 8);
              *(LAS v4u*)(band + row * 528 + piece * 16) = v; } }
        for (int e = tid; e < 4 * 176; e += NWAVES * 64) { const int r = e / 176, rel = e - r * 176 - 31; tabM[e] = (rel >= 0 && rel < 128) ? tab[rel * 16 + g * 4 + r] * 1.4426950408889634f : -1.0e30f; }
        __syncthreads();
        const int ql = 16 * wave + hl, t = nb * 128 + ql, cbase = 16 * wave; const size_t tok = (size_t)b * SEQ + t;
        bf16x8 qn[4];
        { const GAS bf16* qs = (const GAS bf16*)(Q + tok * DM + (g * 4) * HDIM + 8 * Gq);
#pragma unroll
          for (int ks = 0; ks < 4; ++ks) qn[ks] = *(const GAS bf16x8*)(qs + ks * 32); }
#pragma unroll 1
        for (int r = 0; r < 4; ++r) {
            const int hq = g * 4 + r;
            bf16x8 qf[4];
#pragma unroll
            for (int ks = 0; ks < 4; ++ks) qf[ks] = qn[ks];
            { const GAS bf16* qs = (const GAS bf16*)(Q + tok * DM + (g * 4 + (r < 3 ? r + 1 : 3)) * HDIM + 8 * Gq);
#pragma unroll
              for (int ks = 0; ks < 4; ++ks) qn[ks] = *(const GAS bf16x8*)(qs + ks * 32); }
            f32x4 S[10];
#pragma unroll
            for (int rh = 0; rh < 2; ++rh) {
                bf16x8 ka[5][4];
#pragma unroll
                for (int r5 = 0; r5 < 5; ++r5)
#pragma unroll
                    for (int ks = 0; ks < 4; ++ks) ka[r5][ks] = *(const LAS bf16x8*)(band + (cbase + 16 * (5 * rh + r5) + hl) * 528 + (ks * 32 + 8 * Gq) * 2);
                __builtin_amdgcn_sched_barrier(0);
#pragma unroll
                for (int r5 = 0; r5 < 5; ++r5) S[5 * rh + r5] = (f32x4){0.f, 0.f, 0.f, 0.f};
#pragma unroll
                for (int ks = 0; ks < 4; ++ks)
#pragma unroll
                    for (int r5 = 0; r5 < 5; ++r5) S[5 * rh + r5] = __builtin_amdgcn_mfma_f32_16x16x32_bf16(ka[r5][ks], qf[ks], S[5 * rh + r5], 0, 0, 0);
            }
            const float sink2 = sinks[hq] * 1.4426950408889634f; float mx = sink2;
            const LAS float* tlow = tabM + r * 176 + (hl - 4 * Gq + 12);
            float bv[10][4];
#pragma unroll
            for (int rb = 0; rb < 10; ++rb)
#pragma unroll
                for (int i = 0; i < 4; ++i) bv[rb][i] = tlow[147 - 16 * rb - i];
#pragma unroll
            for (int rb = 0; rb < 10; ++rb)
#pragma unroll
                for (int i = 0; i < 4; ++i) S[rb][i] = S[rb][i] * (ATT_SCALE * 1.4426950408889634f) + bv[rb][i];
            if (nb == 0) {
#pragma unroll
                for (int rb = 0; rb < 8; ++rb) if (rb < 8 - wave) S[rb] = (f32x4){-1.0e30f, -1.0e30f, -1.0e30f, -1.0e30f};
            }
#pragma unroll
            for (int rb = 0; rb < 10; ++rb) mx = fmaxf(mx, fmaxf(fmaxf(S[rb][0], S[rb][1]), fmaxf(S[rb][2], S[rb][3])));
            mx = bfly32_max(bfly16_max(mx));
            float sum = 0.f;
#pragma unroll
            for (int rb = 0; rb < 10; ++rb)
#pragma unroll
                for (int i = 0; i < 4; ++i) { const float p = __builtin_amdgcn_exp2f(S[rb][i] - mx); S[rb][i] = p; sum += p; }
            sum = bfly32_sum(bfly16_sum(sum)); sum += __builtin_amdgcn_exp2f(sink2 - mx);
            const float inv = 1.0f / sum;
            f32x4 O[8];
#pragma unroll
            for (int db = 0; db < 8; ++db) O[db] = (f32x4){0.f, 0.f, 0.f, 0.f};
#pragma unroll
            for (int ch = 0; ch < 5; ++ch) {
                v4u pu; pu.x = pkbf(S[2 * ch][0], S[2 * ch][1]); pu.y = pkbf(S[2 * ch][2], S[2 * ch][3]); pu.z = pkbf(S[2 * ch + 1][0], S[2 * ch + 1][1]); pu.w = pkbf(S[2 * ch + 1][2], S[2 * ch + 1][3]);
                const bf16x8 pa = __builtin_bit_cast(bf16x8, pu);
                s16x4 vt[8][2];
#pragma unroll
                for (int db = 0; db < 8; ++db) { vt[db][0] = vtr(band + (cbase + 32 * ch + 4 * Gq + qrow) * 528 + 256 + (16 * db + 4 * pcol) * 2); vt[db][1] = vtr(band + (cbase + 32 * ch + 16 + 4 * Gq + qrow) * 528 + 256 + (16 * db + 4 * pcol) * 2); }
                __builtin_amdgcn_sched_barrier(0);
#pragma unroll
                for (int db = 0; db < 8; ++db) { const s16x4 v0 = vt[db][0], v1 = vt[db][1];
                    const bf16x8 a = (bf16x8){v0[0], v0[1], v0[2], v0[3], v1[0], v1[1], v1[2], v1[3]};
                    O[db] = __builtin_amdgcn_mfma_f32_16x16x32_bf16(a, pa, O[db], 0, 0, 0); }
            }
            GAS bf16* op = (GAS bf16*)(AO + tok * DM + hq * HDIM + 4 * Gq);
#pragma unroll
            for (int db = 0; db < 8; ++db) { const f32x4 o = O[db] * inv; v2u w; w.x = pkbf(o[0], o[1]); w.y = pkbf(o[2], o[3]); *(GAS v2u*)(op + 16 * db) = w; }
        }
    }
}
#ifndef REPP
#define REPP 1
#endif
#ifndef REP0
#define REP0 1
#endif
#ifndef REP1
#define REP1 1
#endif
#ifndef REP2
#define REP2 1
#endif
#ifndef REP3D
#define REP3D 1
#endif
#ifndef REP3S
#define REP3S 1
#endif
#ifndef REP4
#define REP4 1
#endif
#ifndef REP5
#define REP5 1
#endif
#ifndef REP6
#define REP6 1
#endif
#ifndef REP7
#define REP7 1
#endif
#ifndef REP8
#define REP8 1
#endif
#ifndef REP9
#define REP9 1
#endif
#ifndef REP10
#define REP10 1
#endif
#ifndef REP11
#define REP11 1
#endif
#ifndef DEFER_CONV
#define DEFER_CONV 1
#endif
#ifndef CONV_GG
#define CONV_GG 224
#endif
#ifndef GRP_BAR
#define GRP_BAR 1
#endif
#ifndef NOS1
#define NOS1 0
#endif
#ifndef NOS4
#define NOS4 0
#endif
#ifndef NOS6
#define NOS6 0
#endif
#ifndef NOS7
#define NOS7 0
#endif
#ifndef NOS8
#define NOS8 0
#endif
#ifndef NOS9
#define NOS9 0
#endif
#ifndef NOS11
#define NOS11 0
#endif

constexpr int PH_FINAL = 1 + 12 * DEPTH, PH_END = PH_FINAL + 1;
struct Args { const float* in[19]; float* out; unsigned char* ws; int ph_lo, ph_hi; };
__global__ void __launch_bounds__(NWAVES * 64, 2) yoco_fwd(Args args) {
    extern __shared__ __attribute__((aligned(16))) unsigned char lds_raw[];
    LAS unsigned char* lds = (LAS unsigned char*)lds_raw;
    volatile LAS unsigned* MISC = (volatile LAS unsigned*)(lds + MISC_OFF);
    const int tid = threadIdx.x, lane = tid & 63, wave = __builtin_amdgcn_readfirstlane(tid >> 6);
    const int G = gridDim.x, bx = blockIdx.x, vcu = (G % 8 == 0) ? (bx % 8) * (G / 8) + bx / 8 : bx;
    const int gw = vcu * NWAVES + wave, NGW = G * NWAVES;
    for (int u = tid; u < 64; u += NWAVES * 64) MISC[u] = 0u;
    __syncthreads();
    gu32* ctl = (gu32*)(args.ws + WS_CTL);
    XcdBarrier bar; bar.bar = (unsigned*)ctl + CW_BAR; bar.x = 0; bar.st = nullptr;
    if (!MK_PER_PHASE) bar = xcd_barrier_post((unsigned*)ctl + CW_BAR, MISC + 8);
#define GRID_BAR() do { if (!MK_PER_PHASE) xcd_barrier(bar); } while (0)
    unsigned* const grpw = (unsigned*)ctl + 64 * (8 * (bx % 8) + (bx / 8) % 8);
    if (!MK_PER_PHASE && G == 256 && tid == 0) __hip_atomic_store(grpw + 8 + (bx / 8) / 8, xb_xcc_id() + 1u, __ATOMIC_RELAXED, __HIP_MEMORY_SCOPE_AGENT);
#define GROUP_BAR() do { if (!MK_PER_PHASE) { if (GRP_BAR && gridDim.x == 256) grp_barrier(grpw, MISC + 10, bar.bar); else xcd_barrier(bar); } } while (0)
    const int lo = args.ph_lo, hi = args.ph_hi;
#define IN(k) (lo <= (k) && (k) < hi)
#define SITE() unsigned char* wsp = args.ws; float* Xp = args.out; int bxs = blockIdx.x, Gs = gridDim.x, tids = threadIdx.x; \
    asm volatile("" : "+s"(wsp), "+s"(Xp), "+s"(bxs), "+s"(Gs), "+v"(tids)); \
    const int lanes = tids & 63, waves = __builtin_amdgcn_readfirstlane(tids >> 6); \
    const int vcus = (Gs % 8 == 0) ? (bxs % 8) * (Gs / 8) + bxs / 8 : bxs, gws = vcus * NWAVES + waves, NGWs = Gs * NWAVES; (void)lanes; (void)gws; (void)NGWs; (void)Xp; (void)wsp
#define x_in (args.in[0])
#define X (Xp)
#define XN ((bf16*)(wsp + WS_XN))
#define Qb ((bf16*)(wsp + WS_Q))
#define AOb ((bf16*)(wsp + WS_AO))
#define QIb ((bf16*)(wsp + WS_QI))
#define KIWb ((bf16*)(wsp + WS_KIW))
#define IDXb ((int*)(wsp + WS_IDX))
#define KITb ((bf16*)(wsp + WS_KIT))
#define KVA ((bf16*)(wsp + WS_KVA))
#define KVB ((bf16*)(wsp + WS_KVB))
#define Ub ((bf16*)(wsp + WS_U))
#define PEb ((bf16*)(wsp + WS_PE))
#define PB ((bf16*)(wsp + WS_PB))
#define XNB2 ((bf16*)(wsp + WS_XNB))
#define SSQ(i) ((float*)(wsp + WS_SSP) + (size_t)(i) * M * 32)
#define RTAB ((LAS float*)(lds + RTAB_OFF))

#ifndef NO_PRO
    for (int rep = 0; rep < REPP; ++rep) if (IN(0)) { SITE();
        LAS float* scr = (LAS float*)(lds + waves * 16640);
        int rot = 0;
        for (int i = 0; i < N_A; ++i) conv_matrix(args.in[2] + (size_t)i * DM * A_IN, args.in[10] + (size_t)i * DM, DM, A_IN, (bf16*)(wsp + WS_WIN) + (size_t)i * A_INP * DM, 1, scr, gws, NGWs, lanes, rot);
        const bool defer = DEFER_CONV && Gs == 256;
        for (int i = 0; i < N_A; ++i) if (!(defer && i == 1)) conv_matrix(args.in[3] + (size_t)i * DM * DM, nullptr, DM, DM, (bf16*)(wsp + WS_WOA) + (size_t)i * DM * DM, 0, scr, gws, NGWs, lanes, rot);
        for (int i = 0; i < DEPTH - N_A; ++i) conv_matrix(args.in[4] + (size_t)i * DM * DM, args.in[10] + (size_t)(N_A + i) * DM, DM, DM, (bf16*)(wsp + WS_WQB) + (size_t)i * DM * DM, 0, scr, gws, NGWs, lanes, rot);
        for (int i = 0; i < DEPTH - N_A; ++i) conv_matrix(args.in[5] + (size_t)i * DM * DM, nullptr, DM, DM, (bf16*)(wsp + WS_WOB) + (size_t)i * DM * DM, 0, scr, gws, NGWs, lanes, rot);
        conv_matrix(args.in[8], args.in[7], DM, 1024, (bf16*)(wsp + WS_WKV), 2, scr, gws, NGWs, lanes, rot);
        for (int i = 0; i < DEPTH; ++i) if (!(defer && i == 1)) conv_matrix(args.in[17] + (size_t)i * DM * DM, args.in[15] + (size_t)i * DM, DM, DM, (bf16*)(wsp + WS_WPG) + (size_t)i * DM * DM, 0, scr, gws, NGWs, lanes, rot);
        for (int i = 0; i < DEPTH; ++i) conv_matrix(args.in[16] + (size_t)i * PLE * DM, nullptr, PLE, DM, (bf16*)(wsp + WS_WPE) + (size_t)i * DM * PLE, 0, scr, gws, NGWs, lanes, rot);
        for (int i = 0; i < DEPTH; ++i) if (!(defer && (i == 1 || i == 2))) conv_matrix(args.in[12] + (size_t)i * DM * DFF, args.in[11] + (size_t)i * DM, DM, DFF, (bf16*)(wsp + WS_W13) + (size_t)i * 2 * DFF * DM, 3, scr, gws, NGWs, lanes, rot);
        for (int i = 0; i < DEPTH; ++i) if (!(defer && (i == 1 || i == 2))) conv_matrix(args.in[13] + (size_t)i * DM * DFF, args.in[11] + (size_t)i * DM, DM, DFF, (bf16*)(wsp + WS_W13) + (size_t)i * 2 * DFF * DM, 4, scr, gws, NGWs, lanes, rot);
        for (int i = 0; i < DEPTH; ++i) if (!(defer && i == 2)) conv_matrix(args.in[14] + (size_t)i * DFF * DM, nullptr, DFF, DM, (bf16*)(wsp + WS_W2) + (size_t)i * DM * DFF, 0, scr, gws, NGWs, lanes, rot);
        const size_t gt = (size_t)vcus * (NWAVES * 64) + tids, NT = (size_t)Gs * (NWAVES * 64);
        for (int i = 0; i < N_A; ++i) { GAS v4u* z = (GAS v4u*)((bf16*)(wsp + WS_WIN) + ((size_t)i * A_INP + A_IN) * DM);
            for (size_t e = gt; e < (size_t)(A_INP - A_IN) * DM / 8; e += NT) z[e] = (v4u){0u, 0u, 0u, 0u}; }
        { const GAS f32x4* ps = (const GAS f32x4*)args.in[1]; GAS v4u* pd = (GAS v4u*)PB;
          for (size_t e = gt; e < (size_t)DEPTH * M * PLE / 8; e += 4 * NT) { f32x4 a[4], b[4];
#pragma unroll
              for (int u = 0; u < 4; ++u) { a[u] = ps[2 * (e + u * NT)]; b[u] = ps[2 * (e + u * NT) + 1]; }
#pragma unroll
              for (int u = 0; u < 4; ++u) { v4u o; o.x = pk2(a[u].x, a[u].y); o.y = pk2(a[u].z, a[u].w); o.z = pk2(b[u].x, b[u].y); o.w = pk2(b[u].z, b[u].w); pd[e + u * NT] = o; } } }
        xb_phase(x_in, XNB2, SSQ(12), gws, NGWs, lanes);
        GRID_BAR();
    }
#endif

    { constexpr int L = 0;
        const int pb = 1 + 12 * L; const bool dsa = L < N_A; const int Lb = L - N_A;
        for (int rep = 0; rep < REP1; ++rep) if (IN(pb + 1) && !NOS1) { SITE();
            const bf16* Bt = dsa ? (const bf16*)(wsp + WS_WIN) + (size_t)L * A_INP * DM : (const bf16*)(wsp + WS_WQB) + (size_t)Lb * DM * DM; const int N = dsa ? A_INP : DM;
            const bool part = DEFER_CONV && dsa && Gs == 256; const int Gg = part ? CONV_GG : Gs;
            pg8::Gemm g{XNB2, Bt, M, N, DM, 1}; pg8::StaticOrder S; S.init(M, N, Gg, bxs); if (part && bxs >= Gg) S.nwg = 0;
            pg8::rs_finalize(RTAB, S, SSQ(L == 0 ? 12 : 3 * (L - 1) + 2), tids);
            pg8::EpiBf16Map E{dsa ? 1 : 0, Qb, DM, KVA, QIb, KIWb, RTAB, KITb};
            pg8::gemm_phase<pg8::EpiBf16Map, pg8::StaticOrder, true, true>(lds, g, S, E);
            if (part && rep == 0 && bxs >= Gg) {
                __syncthreads();
                LAS float* scr = (LAS float*)(lds + waves * 16640); int rot = 0; const int gw2 = (bxs - Gg) * NWAVES + waves, NGW2 = (Gs - Gg) * NWAVES; const int Ld = L + 1;
                conv_matrix(args.in[12] + (size_t)Ld * DM * DFF, args.in[11] + (size_t)Ld * DM, DM, DFF, (bf16*)(wsp + WS_W13) + (size_t)Ld * 2 * DFF * DM, 3, scr, gw2, NGW2, lanes, rot);
                conv_matrix(args.in[13] + (size_t)Ld * DM * DFF, args.in[11] + (size_t)Ld * DM, DM, DFF, (bf16*)(wsp + WS_W13) + (size_t)Ld * 2 * DFF * DM, 4, scr, gw2, NGW2, lanes, rot);
                if (L == 0) { conv_matrix(args.in[17] + (size_t)1 * DM * DM, args.in[15] + (size_t)1 * DM, DM, DM, (bf16*)(wsp + WS_WPG) + (size_t)1 * DM * DM, 0, scr, gw2, NGW2, lanes, rot);
                              conv_matrix(args.in[3] + (size_t)1 * DM * DM, nullptr, DM, DM, (bf16*)(wsp + WS_WOA) + (size_t)1 * DM * DM, 0, scr, gw2, NGW2, lanes, rot); }
                else conv_matrix(args.in[14] + (size_t)2 * DFF * DM, nullptr, DFF, DM, (bf16*)(wsp + WS_W2) + (size_t)2 * DM * DFF, 0, scr, gw2, NGW2, lanes, rot);
            }
            GRID_BAR();
        }
#ifndef NO_IDX
        for (int rep = 0; rep < REP2; ++rep) if (dsa && IN(pb + 2)) { SITE(); indexer_phase(lds, QIb, KIWb, KITb, IDXb, bxs, Gs, tids, waves, lanes); GRID_BAR(); }
#endif
        for (int rep = 0; rep < (dsa ? REP3D : REP3S); ++rep) if (IN(pb + 3)) { SITE();
#ifndef NO_DSA
            if (dsa) dsa_attn_phase(lds, Qb, (const unsigned char*)KVA, IDXb, AOb, args.in[9], bxs, Gs, tids, waves, lanes);
#endif
#ifndef NO_SWA
            if (!dsa) swa_attn_phase(lds, Qb, KVB, AOb, args.in[9], args.in[6] + (size_t)Lb * NHEAD, bxs, Gs, tids, waves, lanes);
#endif
            GRID_BAR();
        }
        for (int rep = 0; rep < REP4; ++rep) if (IN(pb + 4) && !NOS4) { SITE();
            const bf16* Bt = dsa ? (const bf16*)(wsp + WS_WOA) + (size_t)L * DM * DM : (const bf16*)(wsp + WS_WOB) + (size_t)Lb * DM * DM;
            pg8::Gemm g{AOb, Bt, M, DM, DM}; pg8::StaticOrder S; S.init(M, DM, Gs, bxs);
            pg8::EpiResid E{XNB2, rep ? Qb : XN, rep ? (float*)(wsp + WS_QI) : SSQ(3 * L)};
            pg8::gemm_phase<pg8::EpiResid, pg8::StaticOrder, true, true>(lds, g, S, E);
            GROUP_BAR();
        }
        for (int rep = 0; rep < REP6; ++rep) if (IN(pb + 6) && !NOS6) { SITE();
            pg8::Gemm g{XN, (const bf16*)(wsp + WS_W13) + (size_t)L * 2 * DFF * DM, M, 2 * DFF, DM, 1}; pg8::StaticOrder S; S.init(M, 2 * DFF, Gs, bxs);
            pg8::rs_finalize(RTAB, S, SSQ(3 * L), tids);
            pg8::EpiSwiglu E{Ub, RTAB};
            pg8::gemm_phase<pg8::EpiSwiglu, pg8::StaticOrder, true, true>(lds, g, S, E);
            GROUP_BAR();
        }
        for (int rep = 0; rep < REP7; ++rep) if (IN(pb + 7) && !NOS7) { SITE();
            { pg8::Gemm g{Ub, (const bf16*)(wsp + WS_W2) + (size_t)L * DM * DFF, M, DM, DFF, 1}; pg8::StaticOrder S; S.init(M, DM, Gs, bxs);
              pg8::EpiResid E{XN, rep ? XNB2 : XN, rep ? SSQ(3 * L + 2) : SSQ(3 * L + 1)};
              pg8::gemm_phase<pg8::EpiResid, pg8::StaticOrder, true, true>(lds, g, S, E); }
            { pg8::Gemm g{PB + (size_t)L * M * PLE, (const bf16*)(wsp + WS_WPE) + (size_t)L * DM * PLE, M, DM, PLE}; pg8::StaticOrder S; S.init(M, DM, Gs, bxs);
              pg8::EpiBf16Map E{3, PEb, DM, nullptr, nullptr, nullptr, nullptr, nullptr};
              pg8::gemm_phase<pg8::EpiBf16Map, pg8::StaticOrder, true, true>(lds, g, S, E); }
            GROUP_BAR();
        }
        for (int rep = 0; rep < REP9; ++rep) if (IN(pb + 9) && !NOS9) { SITE();
            pg8::Gemm g{XN, (const bf16*)(wsp + WS_WPG) + (size_t)L * DM * DM, M, DM, DM, 1}; pg8::StaticOrder S; S.init(M, DM, Gs, bxs);
            pg8::rs_finalize(RTAB, S, SSQ(3 * L + 1), tids);
            pg8::EpiGate E{XN, PEb, RTAB, rep ? Qb : XNB2, rep ? (float*)(wsp + WS_QI) : SSQ(3 * L + 2)};
            pg8::gemm_phase<pg8::EpiGate, pg8::StaticOrder, true, true>(lds, g, S, E);
            GRID_BAR();
        }
        if (L == N_A - 1) {
            for (int rep = 0; rep < REP11; ++rep) if (IN(pb + 11) && !NOS11) { SITE();
                pg8::Gemm g{XNB2, (const bf16*)(wsp + WS_WKV), M, 1024, DM, 1}; pg8::StaticOrder S; S.init(M, 1024, Gs, bxs);
                pg8::rs_finalize(RTAB, S, SSQ(3 * L + 2), tids);
                pg8::EpiBf16Map E{2, nullptr, 0, KVB, nullptr, nullptr, RTAB, nullptr};
                pg8::gemm_phase<pg8::EpiBf16Map, pg8::StaticOrder, true, true>(lds, g, S, E);
                GRID_BAR();
            }
        }
        }
    { constexpr int L = 1;
        const int pb = 1 + 12 * L; const bool dsa = L < N_A; const int Lb = L - N_A;
        for (int rep = 0; rep < REP1; ++rep) if (IN(pb + 1) && !NOS1) { SITE();
            const bf16* Bt = dsa ? (const bf16*)(wsp + WS_WIN) + (size_t)L * A_INP * DM : (const bf16*)(wsp + WS_WQB) + (size_t)Lb * DM * DM; const int N = dsa ? A_INP : DM;
            const bool part = DEFER_CONV && dsa && Gs == 256; const int Gg = part ? CONV_GG : Gs;
            pg8::Gemm g{XNB2, Bt, M, N, DM, 1}; pg8::StaticOrder S; S.init(M, N, Gg, bxs); if (part && bxs >= Gg) S.nwg = 0;
            pg8::rs_finalize(RTAB, S, SSQ(L == 0 ? 12 : 3 * (L - 1) + 2), tids);
            pg8::EpiBf16Map E{dsa ? 1 : 0, Qb, DM, KVA, QIb, KIWb, RTAB, KITb};
            pg8::gemm_phase<pg8::EpiBf16Map, pg8::StaticOrder, true, true>(lds, g, S, E);
            if (part && rep == 0 && bxs >= Gg) {
                __syncthreads();
                LAS float* scr = (LAS float*)(lds + waves * 16640); int rot = 0; const int gw2 = (bxs - Gg) * NWAVES + waves, NGW2 = (Gs - Gg) * NWAVES; const int Ld = L + 1;
                conv_matrix(args.in[12] + (size_t)Ld * DM * DFF, args.in[11] + (size_t)Ld * DM, DM, DFF, (bf16*)(wsp + WS_W13) + (size_t)Ld * 2 * DFF * DM, 3, scr, gw2, NGW2, lanes, rot);
                conv_matrix(args.in[13] + (size_t)Ld * DM * DFF, args.in[11] + (size_t)Ld * DM, DM, DFF, (bf16*)(wsp + WS_W13) + (size_t)Ld * 2 * DFF * DM, 4, scr, gw2, NGW2, lanes, rot);
                if (L == 0) { conv_matrix(args.in[17] + (size_t)1 * DM * DM, args.in[15] + (size_t)1 * DM, DM, DM, (bf16*)(wsp + WS_WPG) + (size_t)1 * DM * DM, 0, scr, gw2, NGW2, lanes, rot);
                              conv_matrix(args.in[3] + (size_t)1 * DM * DM, nullptr, DM, DM, (bf16*)(wsp + WS_WOA) + (size_t)1 * DM * DM, 0, scr, gw2, NGW2, lanes, rot); }
                else conv_matrix(args.in[14] + (size_t)2 * DFF * DM, nullptr, DFF, DM, (bf16*)(wsp + WS_W2) + (size_t)2 * DM * DFF, 0, scr, gw2, NGW2, lanes, rot);
            }
            GRID_BAR();
        }
#ifndef NO_IDX
        for (int rep = 0; rep < REP2; ++rep) if (dsa && IN(pb + 2)) { SITE(); indexer_phase(lds, QIb, KIWb, KITb, IDXb, bxs, Gs, tids, waves, lanes); GRID_BAR(); }
#endif
        for (int rep = 0; rep < (dsa ? REP3D : REP3S); ++rep) if (IN(pb + 3)) { SITE();
#ifndef NO_DSA
            if (dsa) dsa_attn_phase(lds, Qb, (const unsigned char*)KVA, IDXb, AOb, args.in[9], bxs, Gs, tids, waves, lanes);
#endif
#ifndef NO_SWA
            if (!dsa) swa_attn_phase(lds, Qb, KVB, AOb, args.in[9], args.in[6] + (size_t)Lb * NHEAD, bxs, Gs, tids, waves, lanes);
#endif
            GRID_BAR();
        }
        for (int rep = 0; rep < REP4; ++rep) if (IN(pb + 4) && !NOS4) { SITE();
            const bf16* Bt = dsa ? (const bf16*)(wsp + WS_WOA) + (size_t)L * DM * DM : (const bf16*)(wsp + WS_WOB) + (size_t)Lb * DM * DM;
            pg8::Gemm g{AOb, Bt, M, DM, DM}; pg8::StaticOrder S; S.init(M, DM, Gs, bxs);
            pg8::EpiResid E{XNB2, rep ? Qb : XN, rep ? (float*)(wsp + WS_QI) : SSQ(3 * L)};
            pg8::gemm_phase<pg8::EpiResid, pg8::StaticOrder, true, true>(lds, g, S, E);
            GROUP_BAR();
        }
        for (int rep = 0; rep < REP6; ++rep) if (IN(pb + 6) && !NOS6) { SITE();
            pg8::Gemm g{XN, (const bf16*)(wsp + WS_W13) + (size_t)L * 2 * DFF * DM, M, 2 * DFF, DM, 1}; pg8::StaticOrder S; S.init(M, 2 * DFF, Gs, bxs);
            pg8::rs_finalize(RTAB, S, SSQ(3 * L), tids);
            pg8::EpiSwiglu E{Ub, RTAB};
            pg8::gemm_phase<pg8::EpiSwiglu, pg8::StaticOrder, true, true>(lds, g, S, E);
            GROUP_BAR();
        }
        for (int rep = 0; rep < REP7; ++rep) if (IN(pb + 7) && !NOS7) { SITE();
            { pg8::Gemm g{Ub, (const bf16*)(wsp + WS_W2) + (size_t)L * DM * DFF, M, DM, DFF, 1}; pg8::StaticOrder S; S.init(M, DM, Gs, bxs);
              pg8::EpiResid E{XN, rep ? XNB2 : XN, rep ? SSQ(3 * L + 2) : SSQ(3 * L + 1)};
              pg8::gemm_phase<pg8::EpiResid, pg8::StaticOrder, true, true>(lds, g, S, E); }
            { pg8::Gemm g{PB + (size_t)L * M * PLE, (const bf16*)(wsp + WS_WPE) + (size_t)L * DM * PLE, M, DM, PLE}; pg8::StaticOrder S; S.init(M, DM, Gs, bxs);
              pg8::EpiBf16Map E{3, PEb, DM, nullptr, nullptr, nullptr, nullptr, nullptr};
              pg8::gemm_phase<pg8::EpiBf16Map, pg8::StaticOrder, true, true>(lds, g, S, E); }
            GROUP_BAR();
        }
        for (int rep = 0; rep < REP9; ++rep) if (IN(pb + 9) && !NOS9) { SITE();
            pg8::Gemm g{XN, (const bf16*)(wsp + WS_WPG) + (size_t)L * DM * DM, M, DM, DM, 1}; pg8::StaticOrder S; S.init(M, DM, Gs, bxs);
            pg8::rs_finalize(RTAB, S, SSQ(3 * L + 1), tids);
            pg8::EpiGate E{XN, PEb, RTAB, rep ? Qb : XNB2, rep ? (float*)(wsp + WS_QI) : SSQ(3 * L + 2)};
            pg8::gemm_phase<pg8::EpiGate, pg8::StaticOrder, true, true>(lds, g, S, E);
            GRID_BAR();
        }
        if (L == N_A - 1) {
            for (int rep = 0; rep < REP11; ++rep) if (IN(pb + 11) && !NOS11) { SITE();
                pg8::Gemm g{XNB2, (const bf16*)(wsp + WS_WKV), M, 1024, DM, 1}; pg8::StaticOrder S; S.init(M, 1024, Gs, bxs);
                pg8::rs_finalize(RTAB, S, SSQ(3 * L + 2), tids);
                pg8::EpiBf16Map E{2, nullptr, 0, KVB, nullptr, nullptr, RTAB, nullptr};
                pg8::gemm_phase<pg8::EpiBf16Map, pg8::StaticOrder, true, true>(lds, g, S, E);
                GRID_BAR();
            }
        }
        }
    { constexpr int L = 2;
        const int pb = 1 + 12 * L; const bool dsa = L < N_A; const int Lb = L - N_A;
        for (int rep = 0; rep < REP1; ++rep) if (IN(pb + 1) && !NOS1) { SITE();
            const bf16* Bt = dsa ? (const bf16*)(wsp + WS_WIN) + (size_t)L * A_INP * DM : (const bf16*)(wsp + WS_WQB) + (size_t)Lb * DM * DM; const int N = dsa ? A_INP : DM;
            const bool part = DEFER_CONV && dsa && Gs == 256; const int Gg = part ? CONV_GG : Gs;
            pg8::Gemm g{XNB2, Bt, M, N, DM, 1}; pg8::StaticOrder S; S.init(M, N, Gg, bxs); if (part && bxs >= Gg) S.nwg = 0;
            pg8::rs_finalize(RTAB, S, SSQ(L == 0 ? 12 : 3 * (L - 1) + 2), tids);
            pg8::EpiBf16Map E{dsa ? 1 : 0, Qb, DM, KVA, QIb, KIWb, RTAB, KITb};
            pg8::gemm_phase<pg8::EpiBf16Map, pg8::StaticOrder, true, true>(lds, g, S, E);
            if (part && rep == 0 && bxs >= Gg) {
                __syncthreads();
                LAS float* scr = (LAS float*)(lds + waves * 16640); int rot = 0; const int gw2 = (bxs - Gg) * NWAVES + waves, NGW2 = (Gs - Gg) * NWAVES; const int Ld = L + 1;
                conv_matrix(args.in[12] + (size_t)Ld * DM * DFF, args.in[11] + (size_t)Ld * DM, DM, DFF, (bf16*)(wsp + WS_W13) + (size_t)Ld * 2 * DFF * DM, 3, scr, gw2, NGW2, lanes, rot);
                conv_matrix(args.in[13] + (size_t)Ld * DM * DFF, args.in[11] + (size_t)Ld * DM, DM, DFF, (bf16*)(wsp + WS_W13) + (size_t)Ld * 2 * DFF * DM, 4, scr, gw2, NGW2, lanes, rot);
                if (L == 0) { conv_matrix(args.in[17] + (size_t)1 * DM * DM, args.in[15] + (size_t)1 * DM, DM, DM, (bf16*)(wsp + WS_WPG) + (size_t)1 * DM * DM, 0, scr, gw2, NGW2, lanes, rot);
                              conv_matrix(args.in[3] + (size_t)1 * DM * DM, nullptr, DM, DM, (bf16*)(wsp + WS_WOA) + (size_t)1 * DM * DM, 0, scr, gw2, NGW2, lanes, rot); }
                else conv_matrix(args.in[14] + (size_t)2 * DFF * DM, nullptr, DFF, DM, (bf16*)(wsp + WS_W2) + (size_t)2 * DM * DFF, 0, scr, gw2, NGW2, lanes, rot);
            }
            GRID_BAR();
        }
#ifndef NO_IDX
        for (int rep = 0; rep < REP2; ++rep) if (dsa && IN(pb + 2)) { SITE(); indexer_phase(lds, QIb, KIWb, KITb, IDXb, bxs, Gs, tids, waves, lanes); GRID_BAR(); }
#endif
        for (int rep = 0; rep < (dsa ? REP3D : REP3S); ++rep) if (IN(pb + 3)) { SITE();
#ifndef NO_DSA
            if (dsa) dsa_attn_phase(lds, Qb, (const unsigned char*)KVA, IDXb, AOb, args.in[9], bxs, Gs, tids, waves, lanes);
#endif
#ifndef NO_SWA
            if (!dsa) swa_attn_phase(lds, Qb, KVB, AOb, args.in[9], args.in[6] + (size_t)Lb * NHEAD, bxs, Gs, tids, waves, lanes);
#endif
            GRID_BAR();
        }
        for (int rep = 0; rep < REP4; ++rep) if (IN(pb + 4) && !NOS4) { SITE();
            const bf16* Bt = dsa ? (const bf16*)(wsp + WS_WOA) + (size_t)L * DM * DM : (const bf16*)(wsp + WS_WOB) + (size_t)Lb * DM * DM;
            pg8::Gemm g{AOb, Bt, M, DM, DM}; pg8::StaticOrder S; S.init(M, DM, Gs, bxs);
            pg8::EpiResid E{XNB2, rep ? Qb : XN, rep ? (float*)(wsp + WS_QI) : SSQ(3 * L)};
            pg8::gemm_phase<pg8::EpiResid, pg8::StaticOrder, true, true>(lds, g, S, E);
            GROUP_BAR();
        }
        for (int rep = 0; rep < REP6; ++rep) if (IN(pb + 6) && !NOS6) { SITE();
            pg8::Gemm g{XN, (const bf16*)(wsp + WS_W13) + (size_t)L * 2 * DFF * DM, M, 2 * DFF, DM, 1}; pg8::StaticOrder S; S.init(M, 2 * DFF, Gs, bxs);
            pg8::rs_finalize(RTAB, S, SSQ(3 * L), tids);
            pg8::EpiSwiglu E{Ub, RTAB};
            pg8::gemm_phase<pg8::EpiSwiglu, pg8::StaticOrder, true, true>(lds, g, S, E);
            GROUP_BAR();
        }
        for (int rep = 0; rep < REP7; ++rep) if (IN(pb + 7) && !NOS7) { SITE();
            { pg8::Gemm g{Ub, (const bf16*)(wsp + WS_W2) + (size_t)L * DM * DFF, M, DM, DFF, 1}; pg8::StaticOrder S; S.init(M, DM, Gs, bxs);
              pg8::EpiResid E{XN, rep ? XNB2 : XN, rep ? SSQ(3 * L + 2) : SSQ(3 * L + 1)};
              pg8::gemm_phase<pg8::EpiResid, pg8::StaticOrder, true, true>(lds, g, S, E); }
            { pg8::Gemm g{PB + (size_t)L * M * PLE, (const bf16*)(wsp + WS_WPE) + (size_t)L * DM * PLE, M, DM, PLE}; pg8::StaticOrder S; S.init(M, DM, Gs, bxs);
              pg8::EpiBf16Map E{3, PEb, DM, nullptr, nullptr, nullptr, nullptr, nullptr};
              pg8::gemm_phase<pg8::EpiBf16Map, pg8::StaticOrder, true, true>(lds, g, S, E); }
            GROUP_BAR();
        }
        for (int rep = 0; rep < REP9; ++rep) if (IN(pb + 9) && !NOS9) { SITE();
            pg8::Gemm g{XN, (const bf16*)(wsp + WS_WPG) + (size_t)L * DM * DM, M, DM, DM, 1}; pg8::StaticOrder S; S.init(M, DM, Gs, bxs);
            pg8::rs_finalize(RTAB, S, SSQ(3 * L + 1), tids);
            pg8::EpiGate E{XN, PEb, RTAB, rep ? Qb : XNB2, rep ? (float*)(wsp + WS_QI) : SSQ(3 * L + 2)};
            pg8::gemm_phase<pg8::EpiGate, pg8::StaticOrder, true, true>(lds, g, S, E);
            GRID_BAR();
        }
        if (L == N_A - 1) {
            for (int rep = 0; rep < REP11; ++rep) if (IN(pb + 11) && !NOS11) { SITE();
                pg8::Gemm g{XNB2, (const bf16*)(wsp + WS_WKV), M, 1024, DM, 1}; pg8::StaticOrder S; S.init(M, 1024, Gs, bxs);
                pg8::rs_finalize(RTAB, S, SSQ(3 * L + 2), tids);
                pg8::EpiBf16Map E{2, nullptr, 0, KVB, nullptr, nullptr, RTAB, nullptr};
                pg8::gemm_phase<pg8::EpiBf16Map, pg8::StaticOrder, true, true>(lds, g, S, E);
                GRID_BAR();
            }
        }
        }
    { constexpr int L = 3;
        const int pb = 1 + 12 * L; const bool dsa = L < N_A; const int Lb = L - N_A;
        for (int rep = 0; rep < REP1; ++rep) if (IN(pb + 1) && !NOS1) { SITE();
            const bf16* Bt = dsa ? (const bf16*)(wsp + WS_WIN) + (size_t)L * A_INP * DM : (const bf16*)(wsp + WS_WQB) + (size_t)Lb * DM * DM; const int N = dsa ? A_INP : DM;
            const bool part = DEFER_CONV && dsa && Gs == 256; const int Gg = part ? CONV_GG : Gs;
            pg8::Gemm g{XNB2, Bt, M, N, DM, 1}; pg8::StaticOrder S; S.init(M, N, Gg, bxs); if (part && bxs >= Gg) S.nwg = 0;
            pg8::rs_finalize(RTAB, S, SSQ(L == 0 ? 12 : 3 * (L - 1) + 2), tids);
            pg8::EpiBf16Map E{dsa ? 1 : 0, Qb, DM, KVA, QIb, KIWb, RTAB, KITb};
            pg8::gemm_phase<pg8::EpiBf16Map, pg8::StaticOrder, true, true>(lds, g, S, E);
            if (part && rep == 0 && bxs >= Gg) {
                __syncthreads();
                LAS float* scr = (LAS float*)(lds + waves * 16640); int rot = 0; const int gw2 = (bxs - Gg) * NWAVES + waves, NGW2 = (Gs - Gg) * NWAVES; const int Ld = L + 1;
                conv_matrix(args.in[12] + (size_t)Ld * DM * DFF, args.in[11] + (size_t)Ld * DM, DM, DFF, (bf16*)(wsp + WS_W13) + (size_t)Ld * 2 * DFF * DM, 3, scr, gw2, NGW2, lanes, rot);
                conv_matrix(args.in[13] + (size_t)Ld * DM * DFF, args.in[11] + (size_t)Ld * DM, DM, DFF, (bf16*)(wsp + WS_W13) + (size_t)Ld * 2 * DFF * DM, 4, scr, gw2, NGW2, lanes, rot);
                if (L == 0) { conv_matrix(args.in[17] + (size_t)1 * DM * DM, args.in[15] + (size_t)1 * DM, DM, DM, (bf16*)(wsp + WS_WPG) + (size_t)1 * DM * DM, 0, scr, gw2, NGW2, lanes, rot);
                              conv_matrix(args.in[3] + (size_t)1 * DM * DM, nullptr, DM, DM, (bf16*)(wsp + WS_WOA) + (size_t)1 * DM * DM, 0, scr, gw2, NGW2, lanes, rot); }
                else conv_matrix(args.in[14] + (size_t)2 * DFF * DM, nullptr, DFF, DM, (bf16*)(wsp + WS_W2) + (size_t)2 * DM * DFF, 0, scr, gw2, NGW2, lanes, rot);
            }
            GRID_BAR();
        }
#ifndef NO_IDX
        for (int rep = 0; rep < REP2; ++rep) if (dsa && IN(pb + 2)) { SITE(); indexer_phase(lds, QIb, KIWb, KITb, IDXb, bxs, Gs, tids, waves, lanes); GRID_BAR(); }
#endif
        for (int rep = 0; rep < (dsa ? REP3D : REP3S); ++rep) if (IN(pb + 3)) { SITE();
#ifndef NO_DSA
            if (dsa) dsa_attn_phase(lds, Qb, (const unsigned char*)KVA, IDXb, AOb, args.in[9], bxs, Gs, tids, waves, lanes);
#endif
#ifndef NO_SWA
            if (!dsa) swa_attn_phase(lds, Qb, KVB, AOb, args.in[9], args.in[6] + (size_t)Lb * NHEAD, bxs, Gs, tids, waves, lanes);
#endif
            GRID_BAR();
        }
        for (int rep = 0; rep < REP4; ++rep) if (IN(pb + 4) && !NOS4) { SITE();
            const bf16* Bt = dsa ? (const bf16*)(wsp + WS_WOA) + (size_t)L * DM * DM : (const bf16*)(wsp + WS_WOB) + (size_t)Lb * DM * DM;
            pg8::Gemm g{AOb, Bt, M, DM, DM}; pg8::StaticOrder S; S.init(M, DM, Gs, bxs);
            pg8::EpiResid E{XNB2, rep ? Qb : XN, rep ? (float*)(wsp + WS_QI) : SSQ(3 * L)};
            pg8::gemm_phase<pg8::EpiResid, pg8::StaticOrder, true, true>(lds, g, S, E);
            GROUP_BAR();
        }
        for (int rep = 0; rep < REP6; ++rep) if (IN(pb + 6) && !NOS6) { SITE();
            pg8::Gemm g{XN, (const bf16*)(wsp + WS_W13) + (size_t)L * 2 * DFF * DM, M, 2 * DFF, DM, 1}; pg8::StaticOrder S; S.init(M, 2 * DFF, Gs, bxs);
            pg8::rs_finalize(RTAB, S, SSQ(3 * L), tids);
            pg8::EpiSwiglu E{Ub, RTAB};
            pg8::gemm_phase<pg8::EpiSwiglu, pg8::StaticOrder, true, true>(lds, g, S, E);
            GROUP_BAR();
        }
        for (int rep = 0; rep < REP7; ++rep) if (IN(pb + 7) && !NOS7) { SITE();
            { pg8::Gemm g{Ub, (const bf16*)(wsp + WS_W2) + (size_t)L * DM * DFF, M, DM, DFF, 1}; pg8::StaticOrder S; S.init(M, DM, Gs, bxs);
              pg8::EpiResid E{XN, rep ? XNB2 : XN, rep ? SSQ(3 * L + 2) : SSQ(3 * L + 1)};
              pg8::gemm_phase<pg8::EpiResid, pg8::StaticOrder, true, true>(lds, g, S, E); }
            { pg8::Gemm g{PB + (size_t)L * M * PLE, (const bf16*)(wsp + WS_WPE) + (size_t)L * DM * PLE, M, DM, PLE}; pg8::StaticOrder S; S.init(M, DM, Gs, bxs);
              pg8::EpiBf16Map E{3, PEb, DM, nullptr, nullptr, nullptr, nullptr, nullptr};
              pg8::gemm_phase<pg8::EpiBf16Map, pg8::StaticOrder, true, true>(lds, g, S, E); }
            GROUP_BAR();
        }
        for (int rep = 0; rep < REP9; ++rep) if (IN(pb + 9) && !NOS9) { SITE();
            pg8::Gemm g{XN, (const bf16*)(wsp + WS_WPG) + (size_t)L * DM * DM, M, DM, DM, 1}; pg8::StaticOrder S; S.init(M, DM, Gs, bxs);
            pg8::rs_finalize(RTAB, S, SSQ(3 * L + 1), tids);
            pg8::EpiGate E{XN, PEb, RTAB, rep ? Qb : XNB2, rep ? (float*)(wsp + WS_QI) : SSQ(3 * L + 2)};
            pg8::gemm_phase<pg8::EpiGate, pg8::StaticOrder, true, true>(lds, g, S, E);
            GRID_BAR();
        }
        if (L == N_A - 1) {
            for (int rep = 0; rep < REP11; ++rep) if (IN(pb + 11) && !NOS11) { SITE();
                pg8::Gemm g{XNB2, (const bf16*)(wsp + WS_WKV), M, 1024, DM, 1}; pg8::StaticOrder S; S.init(M, 1024, Gs, bxs);
                pg8::rs_finalize(RTAB, S, SSQ(3 * L + 2), tids);
                pg8::EpiBf16Map E{2, nullptr, 0, KVB, nullptr, nullptr, RTAB, nullptr};
                pg8::gemm_phase<pg8::EpiBf16Map, pg8::StaticOrder, true, true>(lds, g, S, E);
                GRID_BAR();
            }
        }
        }

    if (IN(PH_FINAL)) { SITE(); final_norm_phase(XNB2, args.in[18], X, gws, NGWs, lanes); }
#undef IN
#undef SITE
#undef GRID_BAR
#undef GROUP_BAR
#undef x_in
#undef X
#undef XN
#undef Qb
#undef AOb
#undef QIb
#undef KIWb
#undef IDXb
#undef KITb
#undef KVA
#undef KVB
#undef Ub
#undef PEb
#undef PB
#undef XNB2
#undef SSQ
#undef RTAB
}

static bool phase_exists(int p) {
    if (p == 0 || p == PH_FINAL) return true;
    if (p < 0 || p > PH_FINAL) return false;
    const int L = (p - 1) / 12, s = (p - 1) % 12;
    if (s == 0 || s == 5 || s == 8 || s == 10) return false;
    if (s == 2) return L < N_A;
    if (s == 11) return L == N_A - 1;
    return true;
}
extern "C" void kernel_launch(void* const* d_in, const int* in_sizes, int n_in, void* d_out, int out_size, void* d_ws, size_t ws_size, hipStream_t stream) {
    static int grid = 0;
    if (grid == 0) {
        if (n_in != 19 || in_sizes[0] != M * DM || out_size != M * DM || ws_size < WS_END) { fprintf(stderr, "kernel_launch: shape/workspace mismatch (n_in %d, in0 %d, out %d, ws %zu, need %zu); nothing launched\n", n_in, n_in > 0 ? in_sizes[0] : -1, out_size, ws_size, (size_t)WS_END); grid = -1; return; }
        int dev = 0, cus = 0, per_cu = 0;
        if (hipGetDevice(&dev) != hipSuccess || hipDeviceGetAttribute(&cus, hipDeviceAttributeMultiprocessorCount, dev) != hipSuccess) { fprintf(stderr, "kernel_launch: device query failed\n"); grid = -1; return; }
        if (hipFuncSetAttribute((const void*)yoco_fwd, hipFuncAttributeMaxDynamicSharedMemorySize, LDS_BYTES) != hipSuccess) { fprintf(stderr, "kernel_launch: hipFuncSetAttribute failed\n"); grid = -1; return; }
        if (hipOccupancyMaxActiveBlocksPerMultiprocessor(&per_cu, (const void*)yoco_fwd, NWAVES * 64, LDS_BYTES) != hipSuccess || per_cu < 1) fprintf(stderr, "kernel_launch: note: occupancy query reports %d workgroups per CU\n", per_cu);
        (void)hipGetLastError();
        grid = cus;
    }
    if (grid < 0) return;
    if (hipMemsetAsync((char*)d_ws + WS_CTL, 0, CTL_ZERO_BYTES, stream) != hipSuccess) { fprintf(stderr, "kernel_launch: memset failed\n"); return; }
    Args a{};
    for (int i = 0; i < 19; ++i) a.in[i] = (const float*)d_in[i];
    a.out = (float*)d_out; a.ws = (unsigned char*)d_ws;
#if MK_PER_PHASE
    for (int p = 0; p < PH_END; ++p) { if (!phase_exists(p)) continue; a.ph_lo = p; a.ph_hi = p + 1;
        hipLaunchKernelGGL(yoco_fwd, dim3(grid), dim3(NWAVES * 64), LDS_BYTES, stream, a); }
#else
    a.ph_lo = 0; a.ph_hi = PH_END;
    hipLaunchKernelGGL(yoco_fwd, dim3(grid), dim3(NWAVES * 64), LDS_BYTES, stream, a);
#endif
    const hipError_t le = hipPeekAtLastError();
    if (le != hipSuccess) fprintf(stderr, "kernel_launch: launch failed: %s\n", hipGetErrorName(le));
}
```

```cpp
#include <hip/hip_runtime.h>
#include <cstdio>
#include <cstdint>
#ifndef MK_PER_PHASE
#define MK_PER_PHASE 0
#endif
namespace pg8 {
#define PG8_LAS __attribute__((address_space(3)))
typedef unsigned short bf16_t;
typedef short bf16x8 __attribute__((ext_vector_type(8)));
typedef float f32x4 __attribute__((ext_vector_type(4)));
typedef unsigned u32x4 __attribute__((ext_vector_type(4)));
constexpr int BM = 256, BK = 64, HALF = 128, HTB = HALF * BK * 2  , STAGE_BYTES = 8 * HTB, NXCD = 8, WGM = 8;

__host__ __device__ __forceinline__ int lds_byte(int r, int c) { const int st = (r >> 4) * 2 + (c >> 5), rr = r & 15, cc = c & 31, ob = rr * 64 + cc * 2; return st * 1024 + (ob ^ (((ob >> 9) & 1) << 5)); }
__host__ __device__ __forceinline__ void stage_rc(int b, int& R, int& C) { const int st = b / 1024, sb = b % 1024, swz = sb ^ (((sb >> 9) & 1) << 5); R = (st >> 1) * 16 + swz / 64; C = (st & 1) * 32 + (swz % 64) / 2; }
__host__ __device__ __forceinline__ int perm32(int rho) { const int n = rho >> 4, i = rho & 15; return 8 * (i >> 2) + 4 * n + (i & 3); }

struct Unit { int pm, pn, ord; };
struct Gemm { const bf16_t* A; const bf16_t* Bt; int M, N, K; int tiledA; };

struct StaticOrder {
    int nM, nN, nwg, G, c;
    __host__ __device__ void init(int M, int N, int G_, int c_) { nM = M / BM; nN = N / BM; nwg = nM * nN; G = G_; c = c_; }
    __host__ __device__ bool next(int i, Unit& u) const {
        const long L = (long)i * G + c; if (L >= nwg) return false;
        int wgid = (int)L; { const int q = nwg / NXCD, r = nwg % NXCD, xcd = wgid % NXCD, off = wgid / NXCD; wgid = (xcd < r ? xcd * (q + 1) : r * (q + 1) + (xcd - r) * q) + off; }
        const int nig = WGM * nN, gid = wgid / nig, fm = gid * WGM, gsz = (nM - fm) < WGM ? (nM - fm) : WGM;
        u.pm = fm + ((wgid % nig) % gsz); u.pn = (wgid % nig) / gsz; u.ord = i; return true;
    }
    __device__ __forceinline__ void a_ready(const Unit&) const {}
    __device__ __forceinline__ void done(const Unit&) const {}
};

__device__ __forceinline__ unsigned cvt_pk_bf16(float lo, float hi) { unsigned r; asm volatile("v_cvt_pk_bf16_f32 %0, %1, %2" : "=v"(r) : "v"(lo), "v"(hi)); return r; }
#define PG8_GAS __attribute__((address_space(1)))

__device__ __forceinline__ float fast_sigmoid(float a) { return __builtin_amdgcn_rcpf(1.0f + __builtin_amdgcn_exp2f(-1.4426950408889634f * a)); }

__device__ __forceinline__ void row_scales(const PG8_LAS float* rtab, const Unit& u, int wr, int fr, float (&r)[2][4]) {
#pragma unroll
    for (int ai = 0; ai < 2; ++ai)
#pragma unroll
        for (int m = 0; m < 4; ++m) r[ai][m] = rtab ? rtab[u.ord * BM + ai * HALF + wr * 64 + m * 16 + fr] : 1.0f;
}
template <class Sched> __device__ __forceinline__ void rs_finalize(PG8_LAS float* rtab, const Sched& S, const float* ssp, int tid) {
    const int row = tid >> 1, h = tid & 1;
    for (int i0 = 0; ; i0 += 4) {
        Unit u[4]; bool ok[4]; f32x4 v[4][4];
#pragma unroll
        for (int j = 0; j < 4; ++j) { ok[j] = S.next(i0 + j, u[j]); if (!ok[j]) u[j].pm = 0; }
        if (!ok[0]) break;
#pragma unroll
        for (int j = 0; j < 4; ++j) { const PG8_GAS f32x4* p = (const PG8_GAS f32x4*)(ssp + ((size_t)(u[j].pm * BM + row)) * 32 + h * 16);
#pragma unroll
            for (int e = 0; e < 4; ++e) v[j][e] = p[e]; }
#pragma unroll
        for (int j = 0; j < 4; ++j) { const f32x4 a = v[j][0], b = v[j][1], c = v[j][2], d = v[j][3];
            const float s = (((a[0] + a[1]) + (a[2] + a[3])) + ((b[0] + b[1]) + (b[2] + b[3]))) + (((c[0] + c[1]) + (c[2] + c[3])) + ((d[0] + d[1]) + (d[2] + d[3])));
            const float o = __shfl_xor(s, 1); const float tot = h ? (o + s) : (s + o);
            if (h == 0 && ok[j]) rtab[(i0 + j) * BM + row] = __builtin_amdgcn_rsqf(tot * (1.0f / 2048.0f) + 1e-6f); }
    }
    __syncthreads();
}
struct EpiBf16Map {
    static constexpr bool PERM = true, AFTER_DRAIN = false;
    int kind; bf16_t* O; int ldc; bf16_t* KV; bf16_t* QI; bf16_t* KIW; const PG8_LAS float* rtab; bf16_t* KIT;
    __device__ __forceinline__ void operator()(const f32x4 (&acc)[2][2][4][2], const Unit& u, int wr, int wc, int fr, int fq) const {
        const int row0 = u.pm * BM + wr * 64 + fr; bf16_t* base; int ld;
        if (kind == 0) { base = O + u.pn * BM; ld = ldc; }
        else if (kind == 3) { base = O + ((size_t)(u.pm * 8 + u.pn) << 16) - (size_t)u.pm * BM * 256; ld = 256; }
        else if (kind == 1) {
            if (u.pn < 8) { base = O + u.pn * BM; ld = 2048; }
            else if (u.pn < 12) { const int b = u.pm >> 5, g = u.pn - 8; base = KV + ((size_t)(b * 4 + g) * 8192 - (size_t)b * 8192) * 256; ld = 256; }
            else if (u.pn < 16) { base = QI + (u.pn - 12) * BM; ld = 1024; }
            else { base = KIW; ld = 256; }
        } else { const int b = u.pm >> 5, g = u.pn; base = KV + ((size_t)(b * 4 + g) * 8192 - (size_t)b * 8192) * 256; ld = 256; }
        const int col0 = wc * 32 + 8 * fq; float rs[2][4]; row_scales(rtab, u, wr, fr, rs);
        if (kind == 1 && u.pn == 16) {
            if (wc < 2) {
#pragma unroll
                for (int ai = 0; ai < 2; ++ai)
#pragma unroll
                    for (int m = 0; m < 4; ++m) { const int row = row0 + ai * HALF + m * 16, d0 = wc * 32 + 8 * fq;
                        bf16_t* dst = QI  ; dst = KIT + ((size_t)((row >> 5) * 4 + (d0 >> 4)) * 64 + ((d0 >> 3) & 1) * 32 + (row & 31)) * 8;
                        const f32x4 v0 = acc[ai][0][m][0] * rs[ai][m], v1 = acc[ai][0][m][1] * rs[ai][m];
                        u32x4 w; w.x = cvt_pk_bf16(v0[0], v0[1]); w.y = cvt_pk_bf16(v0[2], v0[3]); w.z = cvt_pk_bf16(v1[0], v1[1]); w.w = cvt_pk_bf16(v1[2], v1[3]);
                        *(PG8_GAS u32x4*)dst = w; }
            } else if (wc == 2 && fq < 2) {
#pragma unroll
                for (int ai = 0; ai < 2; ++ai)
#pragma unroll
                    for (int m = 0; m < 4; ++m) { bf16_t* rowp = KIW + (size_t)(row0 + ai * HALF + m * 16) * 256 + col0;
                        const f32x4 v0 = acc[ai][0][m][0] * rs[ai][m], v1 = acc[ai][0][m][1] * rs[ai][m];
                        u32x4 w; w.x = cvt_pk_bf16(v0[0], v0[1]); w.y = cvt_pk_bf16(v0[2], v0[3]); w.z = cvt_pk_bf16(v1[0], v1[1]); w.w = cvt_pk_bf16(v1[2], v1[3]);
                        *(PG8_GAS u32x4*)rowp = w; }
            }
            return;
        }
        if (kind == 1 && u.pn >= 8 && u.pn < 12) {
            unsigned char* b8 = (unsigned char*)KV + ((size_t)((u.pm >> 5) * 4 + (u.pn - 8)) * 8192 - (size_t)(u.pm >> 5) * 8192) * 256 + col0;
#pragma unroll
            for (int ai = 0; ai < 2; ++ai)
#pragma unroll
                for (int m = 0; m < 4; ++m) { unsigned char* rowp = b8 + (size_t)(row0 + ai * HALF + m * 16) * 256; const float sc = rs[ai][m] * 16.0f;
#pragma unroll
                    for (int bj = 0; bj < 2; ++bj) { const f32x4 v0 = acc[ai][bj][m][0] * sc, v1 = acc[ai][bj][m][1] * sc; typedef unsigned u32x2 __attribute__((ext_vector_type(2)));
                        int w0 = __builtin_amdgcn_cvt_pk_fp8_f32(v0[0], v0[1], 0, false); w0 = __builtin_amdgcn_cvt_pk_fp8_f32(v0[2], v0[3], w0, true);
                        int w1 = __builtin_amdgcn_cvt_pk_fp8_f32(v1[0], v1[1], 0, false); w1 = __builtin_amdgcn_cvt_pk_fp8_f32(v1[2], v1[3], w1, true);
                        u32x2 w; w.x = (unsigned)w0; w.y = (unsigned)w1; *(PG8_GAS u32x2*)(rowp + bj * HALF) = w; } }
            return;
        }
#pragma unroll
        for (int ai = 0; ai < 2; ++ai)
#pragma unroll
            for (int m = 0; m < 4; ++m) { bf16_t* rowp = base + (size_t)(row0 + ai * HALF + m * 16) * ld + col0;
#pragma unroll
                for (int bj = 0; bj < 2; ++bj) { const f32x4 v0 = acc[ai][bj][m][0] * rs[ai][m], v1 = acc[ai][bj][m][1] * rs[ai][m];
                    u32x4 w; w.x = cvt_pk_bf16(v0[0], v0[1]); w.y = cvt_pk_bf16(v0[2], v0[3]); w.z = cvt_pk_bf16(v1[0], v1[1]); w.w = cvt_pk_bf16(v1[2], v1[3]);
                    *(PG8_GAS u32x4*)(rowp + bj * HALF) = w; } }
    }
};
__device__ __forceinline__ float bflo(unsigned w) { return __uint_as_float(w << 16); }
__device__ __forceinline__ float bfhi(unsigned w) { return __uint_as_float(w & 0xffff0000u); }
typedef float f32x2 __attribute__((ext_vector_type(2)));
__device__ __forceinline__ f32x2 bf2(unsigned w) { f32x2 r; r.x = bflo(w); r.y = bfhi(w); return r; }
#define PG8_LO2(v) __builtin_shufflevector(v, v, 0, 1)
#define PG8_HI2(v) __builtin_shufflevector(v, v, 2, 3)
__device__ __forceinline__ void sig8(f32x4& s0, f32x4& s1, const f32x4 a0, const f32x4 a1, float nrs) {
    f32x4 t0 = a0 * nrs, t1 = a1 * nrs;
    __builtin_amdgcn_sched_barrier(0);
#pragma unroll
    for (int e = 0; e < 4; ++e) { t0[e] = __builtin_amdgcn_exp2f(t0[e]); t1[e] = __builtin_amdgcn_exp2f(t1[e]); }
    __builtin_amdgcn_sched_barrier(0);
    t0 = t0 + 1.0f; t1 = t1 + 1.0f;
    __builtin_amdgcn_sched_barrier(0);
#pragma unroll
    for (int e = 0; e < 4; ++e) { t0[e] = __builtin_amdgcn_rcpf(t0[e]); t1[e] = __builtin_amdgcn_rcpf(t1[e]); }
    __builtin_amdgcn_sched_barrier(0);
    s0 = t0; s1 = t1;
}
struct EpiResid {
    static constexpr bool PERM = true, AFTER_DRAIN = false;
    const bf16_t* Xin; bf16_t* Xout; float* ssp;
    __device__ __forceinline__ void operator()(const f32x4 (&acc)[2][2][4][2], const Unit& u, int wr, int wc, int fr, int fq) const {
        const int row0 = u.pm * BM + wr * 64 + fr, rl0 = wr * 64 + fr, cl0 = wc * 32 + 8 * fq; const size_t tb = (size_t)(u.pm * 8 + u.pn) << 16;
        u32x4 xv[2][4][2];
#pragma unroll
        for (int ai = 0; ai < 2; ++ai)
#pragma unroll
            for (int m = 0; m < 4; ++m)
#pragma unroll
                for (int bj = 0; bj < 2; ++bj) xv[ai][m][bj] = *(const PG8_GAS u32x4*)(Xin + tb + (size_t)(rl0 + ai * HALF + m * 16) * 256 + cl0 + bj * HALF);
#pragma unroll
        for (int ai = 0; ai < 2; ++ai)
#pragma unroll
            for (int m = 0; m < 4; ++m) { float q; f32x2 qq = (f32x2){0.f, 0.f};
#pragma unroll
                for (int bj = 0; bj < 2; ++bj) { const u32x4 x = xv[ai][m][bj]; const f32x4 a0 = acc[ai][bj][m][0], a1 = acc[ai][bj][m][1];
                    const f32x2 o0 = bf2(x.x) + PG8_LO2(a0), o1 = bf2(x.y) + PG8_HI2(a0), o2 = bf2(x.z) + PG8_LO2(a1), o3 = bf2(x.w) + PG8_HI2(a1);
                    u32x4 w; w.x = cvt_pk_bf16(o0.x, o0.y); w.y = cvt_pk_bf16(o1.x, o1.y); w.z = cvt_pk_bf16(o2.x, o2.y); w.w = cvt_pk_bf16(o3.x, o3.y);
                    *(PG8_GAS u32x4*)(Xout + tb + (size_t)(rl0 + ai * HALF + m * 16) * 256 + cl0 + bj * HALF) = w;
                    const f32x2 w0 = bf2(w.x), w1 = bf2(w.y), w2 = bf2(w.z), w3 = bf2(w.w); qq = qq + w0 * w0; qq = qq + w1 * w1; qq = qq + w2 * w2; qq = qq + w3 * w3; }
                q = qq.x + qq.y;
                { auto r16_ = __builtin_amdgcn_permlane16_swap(__float_as_uint(q), __float_as_uint(q), false, false); q = __uint_as_float(r16_[0]) + __uint_as_float(r16_[1]); auto r32_ = __builtin_amdgcn_permlane32_swap(__float_as_uint(q), __float_as_uint(q), false, false); q = __uint_as_float(r32_[0]) + __uint_as_float(r32_[1]); }
                if (fq == 0) ((PG8_GAS float*)ssp)[(size_t)(row0 + ai * HALF + m * 16) * 32 + u.pn * 4 + wc] = q; }
    }
};
struct EpiSwiglu {
    static constexpr bool PERM = true, AFTER_DRAIN = false;
    bf16_t* U; const PG8_LAS float* rtab;
    __device__ __forceinline__ void operator()(const f32x4 (&acc)[2][2][4][2], const Unit& u, int wr, int wc, int fr, int fq) const {
        const int row0 = wr * 64 + fr; float rs[2][4]; row_scales(rtab, u, wr, fr, rs);
        bf16_t* const ub = U + ((size_t)(u.pm * 22 + (u.pn >> 1)) << 16) + (u.pn & 1) * HALF + wc * 32 + 8 * fq;
#ifndef EPI_SWIGLU_REP
#define EPI_SWIGLU_REP 1
#endif
        for (int er_ = 0; er_ < EPI_SWIGLU_REP; ++er_) { asm volatile("" ::: "memory");
#pragma unroll
        for (int ai = 0; ai < 2; ++ai)
#pragma unroll
            for (int m = 0; m < 4; ++m) { bf16_t* rowp = ub + (size_t)(row0 + ai * HALF + m * 16) * 256;
                f32x4 o[2]; const float rsv = rs[ai][m], rr = rsv * rsv;
                { f32x4 s0, s1; sig8(s0, s1, acc[ai][0][m][0], acc[ai][0][m][1], rsv * -1.4426950408889634f);
                  o[0] = (acc[ai][0][m][0] * acc[ai][1][m][0]) * (s0 * rr); o[1] = (acc[ai][0][m][1] * acc[ai][1][m][1]) * (s1 * rr); }
                u32x4 w; w.x = cvt_pk_bf16(o[0][0], o[0][1]); w.y = cvt_pk_bf16(o[0][2], o[0][3]); w.z = cvt_pk_bf16(o[1][0], o[1][1]); w.w = cvt_pk_bf16(o[1][2], o[1][3]);
                *(PG8_GAS u32x4*)rowp = w; }
        }
    }
};
struct EpiGate {
    static constexpr bool PERM = true, AFTER_DRAIN = false;
    const bf16_t* Xin; const bf16_t* PE; const PG8_LAS float* rtab; bf16_t* Xout; float* ssp;
    __device__ __forceinline__ void operator()(const f32x4 (&acc)[2][2][4][2], const Unit& u, int wr, int wc, int fr, int fq) const {
        const int row0 = u.pm * BM + wr * 64 + fr, rl0 = wr * 64 + fr, cl0 = wc * 32 + 8 * fq; const size_t tb = (size_t)(u.pm * 8 + u.pn) << 16;
#pragma unroll
        for (int ai = 0; ai < 2; ++ai) {
            u32x4 xv[4][2], pv[4][2];
#pragma unroll
            for (int m = 0; m < 4; ++m)
#pragma unroll
                for (int bj = 0; bj < 2; ++bj) { const size_t off = tb + (size_t)(rl0 + ai * HALF + m * 16) * 256 + cl0 + bj * HALF; xv[m][bj] = *(const PG8_GAS u32x4*)(Xin + off); pv[m][bj] = *(const PG8_GAS u32x4*)(PE + off); }
#pragma unroll
            for (int m = 0; m < 4; ++m) { float q; f32x2 qq = (f32x2){0.f, 0.f}; const float nr = rtab[u.ord * BM + ai * HALF + wr * 64 + m * 16 + fr] * -1.4426950408889634f;
#pragma unroll
                for (int bj = 0; bj < 2; ++bj) { const u32x4 x = xv[m][bj], p = pv[m][bj]; f32x4 s0, s1; sig8(s0, s1, acc[ai][bj][m][0], acc[ai][bj][m][1], nr);
                    const f32x2 o0 = bf2(x.x) + bf2(p.x) * PG8_LO2(s0), o1 = bf2(x.y) + bf2(p.y) * PG8_HI2(s0), o2 = bf2(x.z) + bf2(p.z) * PG8_LO2(s1), o3 = bf2(x.w) + bf2(p.w) * PG8_HI2(s1);
                    u32x4 w; w.x = cvt_pk_bf16(o0.x, o0.y); w.y = cvt_pk_bf16(o1.x, o1.y); w.z = cvt_pk_bf16(o2.x, o2.y); w.w = cvt_pk_bf16(o3.x, o3.y);
                    *(PG8_GAS u32x4*)(Xout + tb + (size_t)(rl0 + ai * HALF + m * 16) * 256 + cl0 + bj * HALF) = w;
                    const f32x2 w0 = bf2(w.x), w1 = bf2(w.y), w2 = bf2(w.z), w3 = bf2(w.w); qq = qq + w0 * w0; qq = qq + w1 * w1; qq = qq + w2 * w2; qq = qq + w3 * w3; }
                q = qq.x + qq.y;
                { auto r16_ = __builtin_amdgcn_permlane16_swap(__float_as_uint(q), __float_as_uint(q), false, false); q = __uint_as_float(r16_[0]) + __uint_as_float(r16_[1]); auto r32_ = __builtin_amdgcn_permlane32_swap(__float_as_uint(q), __float_as_uint(q), false, false); q = __uint_as_float(r32_[0]) + __uint_as_float(r32_[1]); }
                if (fq == 0) ((PG8_GAS float*)ssp)[(size_t)(row0 + ai * HALF + m * 16) * 32 + u.pn * 4 + wc] = q; }
            asm volatile("" ::: "memory"); }
    }
};
template <class Epi, class Sched, bool ALIGN_EPI = false, bool SP2 = false>
__device__ __forceinline__ void gemm_phase(PG8_LAS unsigned char* lds, const Gemm g, const Sched& S, const Epi& E) {
    int tid_l = threadIdx.x; asm volatile("" : "+v"(tid_l));
    const int tid = tid_l, wid = __builtin_amdgcn_readfirstlane(tid >> 6), lane = tid & 63, wr = wid >> 2, wc = wid & 3, fr = lane & 15, fq = lane >> 4;
    const int K = g.K, nt = K / BK;
    unsigned voffA[2], voffB[2];
#pragma unroll
    for (int i = 0; i < 2; ++i) { int R, C; stage_rc(tid * 16 + i * 8192, R, C); const int Rb = Epi::PERM ? ((R & ~31) + perm32(R & 31)) : R;
        voffA[i] = (unsigned)(R * (g.tiledA ? 256 : K) + C) * 2u; voffB[i] = (unsigned)(Rb * K + C) * 2u; }
    const unsigned kstep = (unsigned)(BK * 2);
    const unsigned hstep = (unsigned)HALF * K * 2;
    const unsigned tstep = 2 * hstep;
    const unsigned hstepA = g.tiledA ? 65536u : hstep;
#define PG8_KA(t_) (g.tiledA ? ((((unsigned)(t_)) >> 2) << 17) + ((((unsigned)(t_)) & 3u) << 7) : (unsigned)(t_) * kstep)
    const unsigned ldsw = (unsigned)wid * 1024u;
    const int aoff = lds_byte(wr * 64 + fr, fq * 8), boff = lds_byte(wc * 32 + fr, fq * 8);
#define PG8_SA(b, h) (((b) * 2 + (h)) * HTB)
#define PG8_SB(b, h) ((4 + (b) * 2 + (h)) * HTB)
    const unsigned long long pA_ = (unsigned long long)g.A, pB_ = (unsigned long long)g.Bt;
    void* const uA_ = (void*)(((unsigned long long)(unsigned)__builtin_amdgcn_readfirstlane((int)(unsigned)(pA_ >> 32)) << 32) | (unsigned)__builtin_amdgcn_readfirstlane((int)(unsigned)pA_));
    void* const uB_ = (void*)(((unsigned long long)(unsigned)__builtin_amdgcn_readfirstlane((int)(unsigned)(pB_ >> 32)) << 32) | (unsigned)__builtin_amdgcn_readfirstlane((int)(unsigned)pB_));
    const __amdgpu_buffer_rsrc_t rs_voffA = __builtin_amdgcn_make_buffer_rsrc(uA_, (short)0, __builtin_amdgcn_readfirstlane((int)((unsigned)g.M * (unsigned)K * 2u)), 0x00020000);
    const __amdgpu_buffer_rsrc_t rs_voffB = __builtin_amdgcn_make_buffer_rsrc(uB_, (short)0, __builtin_amdgcn_readfirstlane((int)((unsigned)g.N * (unsigned)K * 2u)), 0x00020000);
#define PG8_STAGE(bufoff, goff, voff) do { _Pragma("unroll") for (int _i = 0; _i < 2; ++_i) \
        __builtin_amdgcn_raw_ptr_buffer_load_lds(rs_##voff, (PG8_LAS void*)(lds + (bufoff) + ldsw + _i * 8192), 16, (int)(voff)[_i], (int)(goff), 0, 0); } while (0)
#define PG8_LDA(dst, b, h) do { _Pragma("unroll") for (int m = 0; m < 4; ++m) _Pragma("unroll") for (int k = 0; k < 2; ++k) dst[m][k] = *(const PG8_LAS bf16x8*)(lds + PG8_SA(b, h) + aoff + m * 2048 + k * 1024); } while (0)
#define PG8_LDB(dst, b, h) do { _Pragma("unroll") for (int n = 0; n < 2; ++n) _Pragma("unroll") for (int k = 0; k < 2; ++k) dst[n][k] = *(const PG8_LAS bf16x8*)(lds + PG8_SB(b, h) + boff + n * 2048 + k * 1024); } while (0)
#define PG8_MMA(ai, bj, At, Bt) do { __builtin_amdgcn_s_setprio(1); _Pragma("unroll") for (int m = 0; m < 4; ++m) _Pragma("unroll") for (int n = 0; n < 2; ++n) _Pragma("unroll") for (int k = 0; k < 2; ++k) \
        acc[ai][bj][m][n] = __builtin_amdgcn_mfma_f32_16x16x32_bf16(Bt[n][k], At[m][k], acc[ai][bj][m][n], 0, 0, 0); __builtin_amdgcn_s_setprio(0); } while (0)
#define PG8_WAIT_V(n) asm volatile("s_waitcnt vmcnt(" #n ")" ::: "memory")
#define PG8_WAIT_L(n) asm volatile("s_waitcnt lgkmcnt(" #n ")" ::: "memory")
#define PG8_BAR __builtin_amdgcn_s_barrier()
#define PG8_SCHED __builtin_amdgcn_sched_barrier(0)
    Unit cur, nxt; int ui = 0;
    if (!S.next(0, cur)) return;
    f32x4 acc[2][2][4][2];
#pragma unroll
    for (int a = 0; a < 2; ++a)
#pragma unroll
        for (int b = 0; b < 2; ++b)
#pragma unroll
            for (int m = 0; m < 4; ++m)
#pragma unroll
                for (int n = 0; n < 2; ++n) acc[a][b][m][n] = (f32x4){0.f, 0.f, 0.f, 0.f};
    bf16x8 At[4][2], B0[2][2], B1[2][2];
    unsigned cA = (unsigned)cur.pm * tstep, cB = (unsigned)cur.pn * tstep;
    S.a_ready(cur);
    if constexpr (SP2) {
        PG8_STAGE(PG8_SB(0, 0), cB, voffB); PG8_STAGE(PG8_SB(0, 1), cB + hstep, voffB); PG8_STAGE(PG8_SA(0, 0), cA, voffA); PG8_STAGE(PG8_SA(0, 1), cA + hstepA, voffA);
        if (wr == 1) PG8_BAR;
        PG8_WAIT_V(2); PG8_BAR;
        PG8_STAGE(PG8_SB(1, 0), cB + kstep, voffB); PG8_STAGE(PG8_SA(1, 0), cA + kstep, voffA); PG8_STAGE(PG8_SB(1, 1), cB + hstep + kstep, voffB);
        PG8_WAIT_V(6); PG8_BAR;
    } else {
        PG8_STAGE(PG8_SB(0, 0), cB, voffB); PG8_STAGE(PG8_SA(0, 0), cA, voffA); PG8_STAGE(PG8_SB(0, 1), cB + hstep, voffB); PG8_STAGE(PG8_SA(0, 1), cA + hstepA, voffA);
        if (wr == 1) PG8_BAR;
        PG8_WAIT_V(4); PG8_BAR;
        PG8_STAGE(PG8_SB(1, 0), cB + kstep, voffB); PG8_STAGE(PG8_SA(1, 0), cA + kstep, voffA); PG8_STAGE(PG8_SB(1, 1), cB + hstep + kstep, voffB);
        PG8_WAIT_V(6); PG8_BAR;
    }
    for (;;) {
        const bool has_next = S.next(ui + 1, nxt);
        const unsigned nA = has_next ? (unsigned)nxt.pm * tstep : cA, nB = has_next ? (unsigned)nxt.pn * tstep : cB;
        for (int t = 0; t < nt; t += 2) {
            const bool last = (t == nt - 2);
            const unsigned a1 = cA + PG8_KA(t + 1);
            const unsigned a2 = last ? nA : cA + PG8_KA(t + 2), b2 = last ? nB : cB + (unsigned)(t + 2) * kstep;
            const unsigned a3 = a2 + kstep, b3 = b2 + kstep;
            if (last && has_next) S.a_ready(nxt);
            if constexpr (SP2) {
            PG8_LDB(B0, 0, 0); PG8_LDB(B1, 0, 1); PG8_SCHED; PG8_LDA(At, 0, 0); PG8_STAGE(PG8_SA(1, 1), a1 + hstepA, voffA);
            PG8_WAIT_V(8); PG8_WAIT_L(0); PG8_BAR; PG8_MMA(0, 0, At, B0); PG8_MMA(0, 1, At, B1); PG8_BAR; PG8_SCHED;
            PG8_LDA(At, 0, 1); PG8_STAGE(PG8_SB(0, 0), b2, voffB); PG8_STAGE(PG8_SB(0, 1), b2 + hstep, voffB); PG8_STAGE(PG8_SA(0, 0), a2, voffA);
            PG8_WAIT_V(8); PG8_WAIT_L(0); PG8_BAR; PG8_MMA(1, 0, At, B0); PG8_MMA(1, 1, At, B1); PG8_BAR; PG8_SCHED;
            PG8_LDB(B0, 1, 0); PG8_LDB(B1, 1, 1); PG8_SCHED; PG8_LDA(At, 1, 0); PG8_STAGE(PG8_SA(0, 1), a2 + hstepA, voffA);
            PG8_WAIT_V(8); PG8_WAIT_L(0); PG8_BAR; PG8_MMA(0, 0, At, B0); PG8_MMA(0, 1, At, B1); PG8_BAR; PG8_SCHED;
            PG8_LDA(At, 1, 1); PG8_STAGE(PG8_SB(1, 0), b3, voffB); PG8_STAGE(PG8_SB(1, 1), b3 + hstep, voffB); PG8_STAGE(PG8_SA(1, 0), a3, voffA);
            PG8_WAIT_V(8); PG8_WAIT_L(0); PG8_BAR; PG8_MMA(1, 0, At, B0); PG8_MMA(1, 1, At, B1); PG8_BAR; PG8_SCHED;
            } else {
            PG8_LDB(B0, 0, 0); PG8_SCHED; PG8_LDA(At, 0, 0); PG8_STAGE(PG8_SA(1, 1), a1 + hstepA, voffA);
            PG8_WAIT_L(8); PG8_BAR; PG8_WAIT_L(0); PG8_MMA(0, 0, At, B0); PG8_BAR; PG8_SCHED;
            PG8_LDB(B1, 0, 1); PG8_STAGE(PG8_SB(0, 0), b2, voffB);
            PG8_BAR; PG8_WAIT_L(0); PG8_MMA(0, 1, At, B1); PG8_BAR;
            PG8_LDA(At, 0, 1); PG8_STAGE(PG8_SA(0, 0), a2, voffA);
            PG8_BAR; PG8_WAIT_L(0); PG8_MMA(1, 0, At, B0); PG8_BAR; PG8_SCHED;
            PG8_STAGE(PG8_SB(0, 1), b2 + hstep, voffB);
            PG8_WAIT_V(6); PG8_BAR; PG8_MMA(1, 1, At, B1); PG8_BAR;
            PG8_LDB(B0, 1, 0); PG8_SCHED; PG8_LDA(At, 1, 0); PG8_STAGE(PG8_SA(0, 1), a2 + hstepA, voffA);
            PG8_WAIT_L(8); PG8_BAR; PG8_WAIT_L(0); PG8_MMA(0, 0, At, B0); PG8_BAR; PG8_SCHED;
            PG8_LDB(B1, 1, 1); PG8_STAGE(PG8_SB(1, 0), b3, voffB);
            PG8_BAR; PG8_WAIT_L(0); PG8_MMA(0, 1, At, B1); PG8_BAR;
            PG8_LDA(At, 1, 1); PG8_STAGE(PG8_SA(1, 0), a3, voffA);
            PG8_BAR; PG8_WAIT_L(0); PG8_MMA(1, 0, At, B0); PG8_BAR; PG8_SCHED;
            PG8_STAGE(PG8_SB(1, 1), b3 + hstep, voffB);
            PG8_WAIT_V(6); PG8_BAR; PG8_MMA(1, 1, At, B1); PG8_BAR;
            }
        }
        if constexpr (ALIGN_EPI) { if (wr == 0) PG8_BAR; }
        if constexpr (!Epi::AFTER_DRAIN) { E(acc, cur, wr, wc, fr, fq); S.done(cur); }
        if (!has_next) break;
#pragma unroll
        for (int a = 0; a < 2; ++a)
#pragma unroll
            for (int b = 0; b < 2; ++b)
#pragma unroll
                for (int m = 0; m < 4; ++m)
#pragma unroll
                    for (int n = 0; n < 2; ++n) acc[a][b][m][n] = (f32x4){0.f, 0.f, 0.f, 0.f};
        cur = nxt; cA = nA; cB = nB; ++ui;
        if constexpr (ALIGN_EPI) { if (wr == 1) PG8_BAR; }
    }
    PG8_WAIT_V(0);
    if constexpr (!ALIGN_EPI) { if (wr == 0) PG8_BAR; }
    PG8_BAR;
    if constexpr (Epi::AFTER_DRAIN) { E.fused(acc, cur, wr, wc, fr, fq, lds, wid, lane); S.done(cur); }
#undef PG8_KA
#undef PG8_SA
#undef PG8_SB
#undef PG8_STAGE
#undef PG8_LDA
#undef PG8_LDB
#undef PG8_MMA
#undef PG8_WAIT_V
#undef PG8_WAIT_L
#undef PG8_BAR
#undef PG8_SCHED
}
}

constexpr int NWAVES = 8;
constexpr int BATCH = 2, SEQ = 8192, DM = 2048, DEPTH = 4, N_A = 2, NHEAD = 16, HDIM = 128, NKV = 4, GRP = 4, IHEAD = 16, IDIM = 64, TOPK = 256, DFF = 5632, PLE = 256;
constexpr int M = BATCH * SEQ;
constexpr int A_IN = 4176, A_INP = 4352;
constexpr float RMS_EPS = 1e-6f;

constexpr size_t MiB = 1u << 20;
constexpr size_t WS_CTL = 0, CTL_ZERO_BYTES = 32 * 1024;
constexpr size_t SZ_WIN = (size_t)A_INP * DM * 2, SZ_SQ = (size_t)DM * DM * 2, SZ_W13 = (size_t)2 * DFF * DM * 2, SZ_W2 = (size_t)DM * DFF * 2, SZ_WPE = (size_t)DM * PLE * 2, SZ_WKV = (size_t)1024 * DM * 2;
constexpr size_t WS_WIN = 1 * MiB;
constexpr size_t WS_WOA = WS_WIN + 2 * SZ_WIN;
constexpr size_t WS_WQB = WS_WOA + 2 * SZ_SQ;
constexpr size_t WS_WOB = WS_WQB + 2 * SZ_SQ;
constexpr size_t WS_WPG = WS_WOB + 2 * SZ_SQ;
constexpr size_t WS_W13 = WS_WPG + 4 * SZ_SQ;
constexpr size_t WS_W2 = WS_W13 + 4 * SZ_W13;
constexpr size_t WS_WPE = WS_W2 + 4 * SZ_W2;
constexpr size_t WS_WKV = WS_WPE + 4 * SZ_WPE;
constexpr size_t WS_PB = WS_WKV + SZ_WKV;
constexpr size_t WS_XN = WS_PB + (size_t)4 * M * PLE * 2;
constexpr size_t WS_KVA = WS_XN + (size_t)M * DM * 2;
constexpr size_t WS_KVB = WS_KVA + (size_t)8 * SEQ * 256 * 2;
constexpr size_t WS_R1 = WS_KVB + (size_t)8 * SEQ * 256 * 2;
constexpr size_t WS_Q = WS_R1;
constexpr size_t WS_QI = WS_Q + (size_t)2 * M * DM * 2;
constexpr size_t WS_KIW = WS_QI + (size_t)M * 1024 * 2;
constexpr size_t WS_IDX = WS_KIW + (size_t)M * 256 * 2;
constexpr size_t WS_KIT = WS_IDX + (size_t)M * 256 * 4;
constexpr size_t WS_R1_END = WS_KIT + (size_t)M * 64 * 2;
constexpr size_t WS_U = WS_R1;
static_assert(WS_U + (size_t)M * DFF * 2 <= WS_R1_END, "U fits the attention scratch region");
constexpr size_t WS_XNB = WS_R1_END;
constexpr size_t WS_PE = WS_XNB + (size_t)M * DM * 2;
constexpr size_t WS_SSP = WS_PE + (size_t)M * DM * 2;
constexpr size_t WS_AO = WS_SSP + (size_t)13 * M * 32 * 4;
constexpr size_t WS_END = WS_AO + (size_t)M * DM * 2;
constexpr int RTAB_OFF = 131072;
constexpr int CW_BAR = 4096;

constexpr int LDS_BYTES = 163840;
constexpr int MISC_OFF = LDS_BYTES - 256;
constexpr int TAB_ENTRIES = 129 * 16;

#define GAS __attribute__((address_space(1)))
#define LAS __attribute__((address_space(3)))
typedef unsigned short bf16;
typedef unsigned v4u __attribute__((ext_vector_type(4)));
typedef unsigned v2u __attribute__((ext_vector_type(2)));
typedef float f32x4 __attribute__((ext_vector_type(4)));
typedef float f32x16 __attribute__((ext_vector_type(16)));
typedef short bf16x8 __attribute__((ext_vector_type(8)));
typedef short s16x4 __attribute__((ext_vector_type(4)));
typedef GAS unsigned gu32;
#define RLX_AGENT __ATOMIC_RELAXED, __HIP_MEMORY_SCOPE_AGENT
#define LDS_WAIT() asm volatile("s_waitcnt lgkmcnt(0)" ::: "memory")
__device__ __forceinline__ unsigned f2bf(float f) { unsigned u = __builtin_bit_cast(unsigned, f); return (u + 0x7fffu + ((u >> 16) & 1u)) >> 16; }
__device__ __forceinline__ unsigned pk2(float lo, float hi) { return pg8::cvt_pk_bf16(lo, hi); }
__device__ __forceinline__ float bf2f(unsigned short b) { return __uint_as_float(((unsigned)b) << 16); }
__device__ __forceinline__ s16x4 vtr(const LAS unsigned char* p) { typedef short v4i16_t __attribute__((ext_vector_type(4))); return __builtin_bit_cast(s16x4, __builtin_amdgcn_ds_read_tr16_b64_v4i16((LAS v4i16_t*)p)); }
__device__ __forceinline__ float bfly16_max(float v) { auto rr = __builtin_amdgcn_permlane16_swap(__float_as_uint(v), __float_as_uint(v), false, false); return fmaxf(__uint_as_float(rr[0]), __uint_as_float(rr[1])); }
__device__ __forceinline__ float bfly32_max(float v) { auto rr = __builtin_amdgcn_permlane32_swap(__float_as_uint(v), __float_as_uint(v), false, false); return fmaxf(__uint_as_float(rr[0]), __uint_as_float(rr[1])); }
__device__ __forceinline__ float bfly16_sum(float v) { auto rr = __builtin_amdgcn_permlane16_swap(__float_as_uint(v), __float_as_uint(v), false, false); return __uint_as_float(rr[0]) + __uint_as_float(rr[1]); }
__device__ __forceinline__ float bfly32_sum(float v) { auto rr = __builtin_amdgcn_permlane32_swap(__float_as_uint(v), __float_as_uint(v), false, false); return __uint_as_float(rr[0]) + __uint_as_float(rr[1]); }
__device__ __forceinline__ float wave_sum(float v) {
#pragma unroll
    for (int o = 1; o < 64; o <<= 1) v += __shfl_xor(v, o);
    return v;
}
#define XB_TMO      128
#define XB_XCNT(j)  (256  + 64 * (j))
#define XB_XSUB(j)  (1280 + 64 * (j))
#define XB_XGEN(j)  (2304 + 64 * (j))
#define XB_TOP      3328
#define XB_TOPGEN   3392
#define XCD_BAR_WORDS 3456
#define XB_SPIN_CAP (1u << 18)

__device__ __forceinline__ unsigned xb_ld(unsigned* p)              { return __hip_atomic_load(p, __ATOMIC_RELAXED, __HIP_MEMORY_SCOPE_AGENT); }
__device__ __forceinline__ unsigned xb_add(unsigned* p, unsigned v) { return __hip_atomic_fetch_add(p, v, __ATOMIC_RELAXED, __HIP_MEMORY_SCOPE_AGENT); }
__device__ __forceinline__ unsigned xb_xcc_id() { return (unsigned)__builtin_amdgcn_s_getreg((3 << 11) | 20) & 0xFu; }
#define XB_SPIN(cond, bar) do { unsigned _sp = 0; while (cond) { __builtin_amdgcn_s_sleep(1); \
    if ((++_sp & 255u) == 0u) { if (xb_ld(&(bar)[XB_TMO])) break; if (_sp > XB_SPIN_CAP) { atomicAdd(&(bar)[XB_TMO], 1u); break; } } } } while (0)

struct XcdBarrier {
    unsigned* bar; unsigned x;
    volatile LAS unsigned* st;
};

__device__ __forceinline__ XcdBarrier xcd_barrier_post(unsigned* bar, volatile LAS unsigned* st) {
    XcdBarrier b; b.bar = bar; b.x = xb_xcc_id(); b.st = st;
    if (threadIdx.x == 0) (void)xb_add(&bar[XB_XCNT(b.x)], 1u);
    return b;
}
__device__ __forceinline__ void xcd_barrier_complete(unsigned* bar, unsigned x, unsigned& nloc, unsigned& nx) {
    const unsigned G = gridDim.x * gridDim.y * gridDim.z;
    unsigned sum, cnt, mine, sp = 0u;
    for (;;) {
        sum = 0u; cnt = 0u; mine = 0u;
#pragma unroll
        for (unsigned j = 0; j < 16; ++j) { const unsigned c = xb_ld(&bar[XB_XCNT(j)]); sum += c; cnt += (c > 0u) ? 1u : 0u; mine = (j == x) ? c : mine; }
        if (sum == G) break;
        __builtin_amdgcn_s_sleep(1);
        if ((++sp & 255u) == 0u) { if (xb_ld(&bar[XB_TMO])) break; if (sp > XB_SPIN_CAP) { atomicAdd(&bar[XB_TMO], 1u); break; } }
    }
    nloc = mine > 0u ? mine : 1u; nx = cnt > 0u ? cnt : 1u;
}

__device__ __forceinline__ void xcd_barrier(const XcdBarrier& b) {
    asm volatile("s_waitcnt vmcnt(0)" ::: "memory");
    __syncthreads();
    if (threadIdx.x == 0) {
        unsigned* bar = b.bar;
        __builtin_amdgcn_s_waitcnt(0);
        unsigned nloc = b.st[0], nx = b.st[1];
        if (nloc == 0u) { xcd_barrier_complete(bar, b.x, nloc, nx); b.st[0] = nloc; b.st[1] = nx; }
        const unsigned old = xb_add(&bar[XB_XSUB(b.x)], 1u);
        const unsigned gen = old / nloc;
        if (old + 1u == (gen + 1u) * nloc) {
            __builtin_amdgcn_fence(__ATOMIC_RELEASE, "agent");
            asm volatile("s_waitcnt vmcnt(0)" ::: "memory");
            const unsigned og = xb_add(&bar[XB_TOP], 1u);
            const unsigned tg = og / nx;
            if (og + 1u == (tg + 1u) * nx) xb_add(&bar[XB_TOPGEN], 1u);
            else XB_SPIN(xb_ld(&bar[XB_TOPGEN]) == tg, bar);
            __builtin_amdgcn_fence(__ATOMIC_ACQUIRE, "agent");
            xb_add(&bar[XB_XGEN(b.x)], 1u);
            asm volatile("s_waitcnt vmcnt(0)" ::: "memory");
        } else {
            XB_SPIN(xb_ld(&bar[XB_XGEN(b.x)]) == gen, bar);
            __builtin_amdgcn_fence(__ATOMIC_ACQUIRE, "agent");
            asm volatile("s_waitcnt vmcnt(0)" ::: "memory");
        }
    }
    __syncthreads();
}

__device__ __forceinline__ void grp_barrier(unsigned* gw, volatile LAS unsigned* same, unsigned* barwords) {
    asm volatile("s_waitcnt vmcnt(0)" ::: "memory");
    __syncthreads();
    if (threadIdx.x == 0) {
        __builtin_amdgcn_s_waitcnt(0);
        unsigned sm = same[0];
        if (sm == 0u) { const unsigned a0 = xb_ld(gw + 8), a1 = xb_ld(gw + 9), a2 = xb_ld(gw + 10), a3 = xb_ld(gw + 11); sm = (a0 != 0u && a0 == a1 && a1 == a2 && a2 == a3) ? 1u : 2u; same[0] = sm; }
        if (sm != 1u) { __builtin_amdgcn_fence(__ATOMIC_RELEASE, "agent"); asm volatile("s_waitcnt vmcnt(0)" ::: "memory"); }
        const unsigned old = xb_add(gw, 1u), target = (old / 4u + 1u) * 4u;
        XB_SPIN(xb_ld(gw) < target, barwords);
        __builtin_amdgcn_fence(__ATOMIC_ACQUIRE, "agent");
        asm volatile("s_waitcnt vmcnt(0)" ::: "memory");
    }
    __syncthreads();
}


__device__ __forceinline__ void tr_load(const float* W, const float* gain, int N, int k0, int n0, f32x4 (&v)[16], f32x4 (&g)[2], int lane) {
    int nc = n0 + (lane & 15) * 4; nc = nc < N - 4 ? nc : N - 4; const int kr = lane >> 4;
    const GAS float* gp = (const GAS float*)(gain ? gain : W) + k0 + 8 * (lane & 7);
    g[0] = *(const GAS f32x4*)gp; g[1] = *(const GAS f32x4*)(gp + 4);
    const GAS float* src = (const GAS float*)W + (size_t)(k0 + kr) * N + nc;
#pragma unroll
    for (int i = 0; i < 16; ++i) v[i] = *(const GAS f32x4*)(src + (size_t)(4 * i) * N);
}
__device__ __forceinline__ void tr_store(bf16* WT, bool hg, int K, int N, int k0, int n0, int drow0, const f32x4 (&v)[16], const f32x4 (&g)[2], LAS float* scr, int lane) {
    const int c4 = (lane & 15) * 4, kr = lane >> 4;
#pragma unroll
    for (int i = 0; i < 16; ++i) { const int k = 4 * i + kr; scr[(c4 + 0) * 65 + k] = v[i].x; scr[(c4 + 1) * 65 + k] = v[i].y; scr[(c4 + 2) * 65 + k] = v[i].z; scr[(c4 + 3) * 65 + k] = v[i].w; }
    LDS_WAIT(); asm volatile("" ::: "memory");
    const int c = lane & 7;
    const float m0 = hg ? g[0].x : 1.f, m1 = hg ? g[0].y : 1.f, m2 = hg ? g[0].z : 1.f, m3 = hg ? g[0].w : 1.f, m4 = hg ? g[1].x : 1.f, m5 = hg ? g[1].y : 1.f, m6 = hg ? g[1].z : 1.f, m7 = hg ? g[1].w : 1.f;
#pragma unroll
    for (int j = 0; j < 8; ++j) { const int n = (lane >> 3) + 8 * j; const LAS float* s = scr + n * 65 + 8 * c;
        v4u o; o.x = pk2(s[0] * m0, s[1] * m1); o.y = pk2(s[2] * m2, s[3] * m3); o.z = pk2(s[4] * m4, s[5] * m5); o.w = pk2(s[6] * m6, s[7] * m7);
        if (n0 + n < N) *(GAS v4u*)(WT + (size_t)(drow0 + n) * K + k0 + 8 * c) = o; }
    LDS_WAIT(); asm volatile("" ::: "memory");
}
__device__ __forceinline__ int map_row(int mt, int n) {
    if (mt == 1) { if (n >= 2048 && n < 3072) { const int v = (n >= 2560) ? 1 : 0, nn = n - 2048 - v * 512; return 2048 + (nn >> 7) * 256 + v * 128 + (nn & 127); } return n; }
    if (mt == 2) { const int v = (n >= 512) ? 1 : 0, nn = n - v * 512; return (nn >> 7) * 256 + v * 128 + (nn & 127); }
    if (mt == 3) return (n >> 7) * 256 + (n & 127);
    if (mt == 4) return (n >> 7) * 256 + 128 + (n & 127);
    return n;
}
__device__ __forceinline__ void conv_matrix(const float* W, const float* gain, int K, int N, bf16* WT, int mt, LAS float* scr, int gw, int NGW, int lane, int& rot) {
    const int nblk = (N + 63) / 64, nitems = (K / 64) * nblk;
    int it = gw - rot; if (it < 0) it += NGW;
    rot = (rot + nitems) % NGW;
    f32x4 va[16], vb[16], ga[2], gb[2];
#define CONV_KB(i_) ((i_) / nblk)
#define CONV_LOAD(v_, g_, i_) tr_load(W, gain, N, 64 * CONV_KB(i_), 64 * ((i_) - CONV_KB(i_) * nblk), v_, g_, lane)
#define CONV_STORE(v_, g_, i_) tr_store(WT, gain != nullptr, K, N, 64 * CONV_KB(i_), 64 * ((i_) - CONV_KB(i_) * nblk), map_row(mt, 64 * ((i_) - CONV_KB(i_) * nblk)), v_, g_, scr, lane)
    if (it < nitems) CONV_LOAD(va, ga, it);
    while (it < nitems) {
        const int i1 = it + NGW; if (i1 < nitems) CONV_LOAD(vb, gb, i1);
        CONV_STORE(va, ga, it);
        if (i1 >= nitems) break;
        const int i2 = i1 + NGW; if (i2 < nitems) CONV_LOAD(va, ga, i2);
        CONV_STORE(vb, gb, i1);
        it = i2;
    }
#undef CONV_KB
#undef CONV_LOAD
#undef CONV_STORE
}

__device__ __forceinline__ float wave_sum_dpp(float v) {
#define FN_DPP(ctrl) v += __uint_as_float((unsigned)__builtin_amdgcn_update_dpp(0, (int)__float_as_uint(v), ctrl, 0xf, 0xf, false))
    FN_DPP(0xB1); FN_DPP(0x4E); FN_DPP(0x124); FN_DPP(0x128);
#undef FN_DPP
    return bfly32_sum(bfly16_sum(v));
}
__device__ __forceinline__ void xb_phase(const float* x, bf16* XB, float* ss, int gw, int NGW, int lane) {
    for (int m = gw; m < M; m += NGW) {
        const GAS f32x4* xr = (const GAS f32x4*)(x + (size_t)m * DM) + lane; f32x4 v[8]; float s = 0.f;
#pragma unroll
        for (int j = 0; j < 8; ++j) { v[j] = xr[64 * j]; s += (v[j].x * v[j].x + v[j].y * v[j].y) + (v[j].z * v[j].z + v[j].w * v[j].w); }
        s = wave_sum_dpp(s);
#pragma unroll
        for (int j = 0; j < 8; ++j) { const int c0 = 4 * (lane + 64 * j); v2u w; w.x = pk2(v[j].x, v[j].y); w.y = pk2(v[j].z, v[j].w);
            *(GAS v2u*)(XB + ((size_t)((m >> 8) * 8 + (c0 >> 8)) << 16) + (size_t)(m & 255) * 256 + (c0 & 255)) = w; }
        if (lane < 32) ((GAS float*)ss)[(size_t)m * 32 + lane] = lane == 0 ? s : 0.f;
    }
}
__device__ __forceinline__ void final_norm_phase(const bf16* xb, const float* g, float* out, int gw, int NGW, int mend, int lane) {
    f32x4 gg[4][2];
#pragma unroll
    for (int j = 0; j < 4; ++j) { const int c0 = (lane + 64 * j) * 8; gg[j][0] = *(const GAS f32x4*)(g + c0); gg[j][1] = *(const GAS f32x4*)(g + c0 + 4); }
    v4u v[4], vn[4];
#define FN_LOAD(dst, m_) do { _Pragma("unroll") for (int j = 0; j < 4; ++j) { const int c0 = 8 * (lane + 64 * j); dst[j] = *(const GAS v4u*)(xb + ((size_t)(((m_) >> 8) * 8 + (c0 >> 8)) << 16) + (size_t)((m_) & 255) * 256 + (c0 & 255)); } } while (0)
    if (gw < mend) FN_LOAD(vn, gw);
    for (int m = gw; m < mend; m += NGW) {
#pragma unroll
        for (int j = 0; j < 4; ++j) v[j] = vn[j];
        { const int mn = m + NGW < mend ? m + NGW : m; FN_LOAD(vn, mn); }
        float s = 0.f;
#pragma unroll
        for (int j = 0; j < 4; ++j) { const unsigned w[4] = {v[j].x, v[j].y, v[j].z, v[j].w};
#pragma unroll
            for (int e = 0; e < 4; ++e) { const float lo = __uint_as_float(w[e] << 16), hi = __uint_as_float(w[e] & 0xffff0000u); s += lo * lo + hi * hi; } }
        const float r = 1.0f / sqrtf(wave_sum_dpp(s) * (1.f / DM) + RMS_EPS);
#pragma unroll
        for (int j = 0; j < 4; ++j) { const int c0 = (lane + 64 * j) * 8; const unsigned w[4] = {v[j].x, v[j].y, v[j].z, v[j].w};
            const f32x4 g0 = gg[j][0], g1 = gg[j][1];
            f32x4 o0, o1; o0.x = __uint_as_float(w[0] << 16) * r * g0.x; o0.y = __uint_as_float(w[0] & 0xffff0000u) * r * g0.y; o0.z = __uint_as_float(w[1] << 16) * r * g0.z; o0.w = __uint_as_float(w[1] & 0xffff0000u) * r * g0.w;
            o1.x = __uint_as_float(w[2] << 16) * r * g1.x; o1.y = __uint_as_float(w[2] & 0xffff0000u) * r * g1.y; o1.z = __uint_as_float(w[3] << 16) * r * g1.z; o1.w = __uint_as_float(w[3] & 0xffff0000u) * r * g1.w;
            GAS f32x4* op = (GAS f32x4*)(out + (size_t)m * DM + c0); op[0] = o0; op[1] = o1; }
    }
#undef FN_LOAD
}

__device__ __forceinline__ void build_bias_tab(LAS float* tab, const float* rel_bias, int tid) {
    for (int e = tid; e < TAB_ENTRIES; e += NWAVES * 64) { const int rel = e >> 4, h = e & 15; int bk;
        if (rel < 16) bk = rel; else if (rel >= 128) bk = 31; else { bk = 16 + (int)(logf((float)rel * (1.f / 16.f)) / logf(8.f) * 16.f); bk = bk > 31 ? 31 : bk; }
        tab[e] = rel_bias[bk * 16 + h]; }
}

__device__ __forceinline__ unsigned mono_key(float s) { const unsigned u = __float_as_uint(s); return (u & 0x80000000u) ? ~u : (u | 0x80000000u); }
__device__ __forceinline__ int mbcnt64(unsigned long long m) { return (int)__builtin_amdgcn_mbcnt_hi((unsigned)(m >> 32), __builtin_amdgcn_mbcnt_lo((unsigned)m, 0u)); }
constexpr int IDX_CAND = 512;
__device__ __forceinline__ void idx_scan(LAS unsigned* hrow, unsigned k_rem, int lane, unsigned& D, unsigned& above, unsigned& cD) {
    const int rl = 63 - lane;
    v4u w[4];
#pragma unroll
    for (int k = 0; k < 4; ++k) w[k] = *(const LAS v4u*)(hrow + 16 * rl + 4 * k);
    const unsigned wd[16] = {w[0].x, w[0].y, w[0].z, w[0].w, w[1].x, w[1].y, w[1].z, w[1].w, w[2].x, w[2].y, w[2].z, w[2].w, w[3].x, w[3].y, w[3].z, w[3].w};
    unsigned tot = 0u;
#pragma unroll
    for (int k = 0; k < 16; ++k) tot += (wd[k] & 0xffffu) + (wd[k] >> 16);
    unsigned v = tot;
#define IDX_DPP_ADD(ctrl, rmask, bmask) v += (unsigned)__builtin_amdgcn_update_dpp(0, (int)v, ctrl, rmask, bmask, false)
    IDX_DPP_ADD(0x111, 0xf, 0xf); IDX_DPP_ADD(0x112, 0xf, 0xf); IDX_DPP_ADD(0x114, 0xf, 0xe); IDX_DPP_ADD(0x118, 0xf, 0xc); IDX_DPP_ADD(0x142, 0xa, 0xf); IDX_DPP_ADD(0x143, 0xc, 0xf);
#undef IDX_DPP_ADD
    const unsigned sx = v - tot;
    const bool mine = (sx < k_rem) && (k_rem <= sx + tot);
    unsigned S = sx + tot, kw = 0u, alw = sx, xw = 0u;
#pragma unroll
    for (int k = 0; k < 16; ++k) { const unsigned wsk = (wd[k] & 0xffffu) + (wd[k] >> 16), Sn = S - wsk; const bool ge = S >= k_rem;
        xw = ge ? wd[k] : xw; alw = ge ? Sn : alw; kw = ge ? (unsigned)k : kw; S = Sn; }
    const unsigned chi = xw >> 16, clo = xw & 0xffffu;
    const bool inhi = alw + chi >= k_rem;
    const unsigned Dl = (unsigned)(32 * rl) + 2u * kw + (inhi ? 1u : 0u), al = inhi ? alw : alw + chi, cl = inhi ? chi : clo;
    const unsigned long long bal = __ballot(mine); const int Ls = bal ? (__ffsll((long long)bal) - 1) : 0;
    D = (unsigned)__builtin_amdgcn_readlane((int)Dl, Ls); above = (unsigned)__builtin_amdgcn_readlane((int)al, Ls); cD = (unsigned)__builtin_amdgcn_readlane((int)cl, Ls);
#pragma unroll
    for (int k = 0; k < 4; ++k) *(LAS v4u*)(hrow + 16 * rl + 4 * k) = (v4u){0u, 0u, 0u, 0u};
}
__device__ __forceinline__ void indexer_phase(LAS unsigned char* lds, const bf16* QI, const bf16* KIW, const bf16* KIT, int* IDX, int c, int G, int tid, int wave, int lane) {
    LAS unsigned* sc = (LAS unsigned*)lds;
    LAS unsigned* hist = (LAS unsigned*)(lds + 131072);
    LAS int* cand = (LAS int*)(lds + 131072 + 16384);
    volatile LAS unsigned* st = (volatile LAS unsigned*)(lds + 131072 + 16384 + 8192);
    for (int i = tid; i < 4096; i += NWAVES * 64) hist[i] = 0u;
    __syncthreads();
    const int q = wave >> 1, half = wave & 1;
    const int r32 = lane & 31, hf = lane >> 5;
    constexpr int NU = M / 4;
    for (int rnd = 0; rnd * G < NU; ++rnd) {
        const int L = rnd * G + ((rnd & 1) ? (G - 1 - c) : c);
        if (L >= NU) continue;
        const int b = L & 1, t0 = (L >> 1) * 4; const size_t tok0 = (size_t)b * SEQ;
        const int t = t0 + q, n = t + 1;
        GAS int* orow = (GAS int*)(IDX + (tok0 + t) * TOPK);
        if (t0 + 4 <= TOPK) {
#pragma unroll
            for (int j = 0; j < 2; ++j) { const int p = half * 128 + j * 64 + lane; orow[p] = p < n ? p : -1; }
            continue;
        }
#ifndef IDX_REP_SCORE
#define IDX_REP_SCORE 1
#endif
        for (int srep = 0; srep < IDX_REP_SCORE; ++srep) {
            const int ntiles = (t0 + 4 + 31) >> 5;
            const int nmine = (ntiles - wave + NWAVES - 1) / NWAVES;
            const GAS bf16* kbase = (const GAS bf16*)(KIT + (tok0 >> 5) * (4 * 64 * 8) + lane * 8);
            bf16x8 B0[4], B1[4], B2[4];
#define IDX_LOAD(Bx, i) do { const int ii_ = (i) < nmine ? (i) : nmine - 1; const GAS bf16* ks_ = kbase + (size_t)(wave + NWAVES * ii_) * (4 * 64 * 8); _Pragma("unroll") for (int ks = 0; ks < 4; ++ks) Bx[ks] = *(const GAS bf16x8*)(ks_ + ks * (64 * 8)); } while (0)
            IDX_LOAD(B0, 0); IDX_LOAD(B1, 1);
            bf16x8 A[2][4]; float wgt[2][16];
            const int ql = (r32 >> 2) & 1, h = (r32 & 3) + 4 * (r32 >> 3);
#pragma unroll
            for (int rb = 0; rb < 2; ++rb) { const GAS bf16* src = (const GAS bf16*)(QI + (tok0 + t0 + 2 * rb + ql) * 1024 + h * 64 + 8 * hf);
#pragma unroll
                for (int ks = 0; ks < 4; ++ks) A[rb][ks] = *(const GAS bf16x8*)(src + ks * 16); }
#pragma unroll
            for (int rb = 0; rb < 2; ++rb) { const GAS bf16* wsrc = (const GAS bf16*)(KIW + (tok0 + t0 + 2 * rb + hf) * 256 + 64);
                const v4u w0 = *(const GAS v4u*)wsrc, w1 = *(const GAS v4u*)(wsrc + 8);
                const unsigned ww[8] = {w0.x, w0.y, w0.z, w0.w, w1.x, w1.y, w1.z, w1.w};
#pragma unroll
                for (int i = 0; i < 8; ++i) { wgt[rb][2 * i] = __uint_as_float(ww[i] << 16) * (1.f / 32.f); wgt[rb][2 * i + 1] = __uint_as_float(ww[i] & 0xffff0000u) * (1.f / 32.f); } }
#define IDX_PROBE_ATOM
#define IDX_TILE(Bx, i) do { if ((i) < nmine) { const int j_ = wave + NWAVES * (i); \
                f32x16 acc0, acc1; _Pragma("unroll") for (int e = 0; e < 16; ++e) { acc0[e] = 0.f; acc1[e] = 0.f; } \
                _Pragma("unroll") for (int ks = 0; ks < 4; ++ks) { acc0 = __builtin_amdgcn_mfma_f32_32x32x16_bf16(A[0][ks], Bx[ks], acc0, 0, 0, 0); acc1 = __builtin_amdgcn_mfma_f32_32x32x16_bf16(A[1][ks], Bx[ks], acc1, 0, 0, 0); }     \
                _Pragma("unroll") for (int rb = 0; rb < 2; ++rb) { \
                    float sa_ = 0.f, sb_ = 0.f, sc_ = 0.f, sd_ = 0.f;                                                                   \
                    _Pragma("unroll") for (int e = 0; e < 4; ++e) { const float x0 = rb ? acc1[e] : acc0[e], x1 = rb ? acc1[e + 4] : acc0[e + 4], x2 = rb ? acc1[e + 8] : acc0[e + 8], x3 = rb ? acc1[e + 12] : acc0[e + 12]; \
                        sa_ = fmaf(wgt[rb][e], __int_as_float(max(__float_as_int(x0), 0)), sa_); sb_ = fmaf(wgt[rb][e + 4], __int_as_float(max(__float_as_int(x1), 0)), sb_); \
                        sc_ = fmaf(wgt[rb][e + 8], __int_as_float(max(__float_as_int(x2), 0)), sc_); sd_ = fmaf(wgt[rb][e + 12], __int_as_float(max(__float_as_int(x3), 0)), sd_); } \
                    const float s_ = (sa_ + sb_) + (sc_ + sd_); \
                    const int tq_ = t0 + 2 * rb + hf, key_ = j_ * 32 + r32; const bool ok_ = key_ <= tq_; const unsigned mk_ = ok_ ? mono_key(s_) : 0u; \
                    sc[(2 * rb + hf) * 8192 + key_] = mk_; \
                    if (ok_ && srep == 0) { __hip_atomic_fetch_add(hist + (2 * rb + hf) * 1024 + (mk_ >> 22), 1u << ((mk_ >> 17) & 16u), __ATOMIC_RELAXED, __HIP_MEMORY_SCOPE_WORKGROUP); IDX_PROBE_ATOM } } } } while (0)
#define IDX_TILE2(Bx, i) IDX_TILE(Bx, i)
#define IDX_LOAD2(Bx, i) IDX_LOAD(Bx, i)
#pragma unroll 1
            for (int i = 0; i < nmine; i += 3) {
                IDX_LOAD2(B2, i + 2); IDX_TILE2(B0, i);
                IDX_LOAD2(B0, i + 3); IDX_TILE2(B1, i + 1);
                IDX_LOAD2(B1, i + 4); IDX_TILE2(B2, i + 2);
            }
#undef IDX_TILE2
#undef IDX_LOAD2
#undef IDX_LOAD
#undef IDX_TILE
        }
        __syncthreads();
        LAS unsigned* srow = sc + q * 8192; LAS unsigned* hrow = hist + q * 1024; LAS int* crow = cand + q * IDX_CAND;
        if (half == 0) { unsigned D, above, cD; idx_scan(hrow, (unsigned)TOPK, lane, D, above, cD);
            if (lane == 0) { st[q * 4 + 0] = D << 21; st[q * 4 + 1] = (unsigned)TOPK - above; st[q * 4 + 2] = cD; } }
        __syncthreads();
        int shift = 21;
        while (shift > 0 && (st[2] > IDX_CAND || st[6] > IDX_CAND || st[10] > IDX_CAND || st[14] > IDX_CAND)) {
            const unsigned prefix = st[q * 4 + 0], k_rem = st[q * 4 + 1]; const int nshift = shift > 11 ? shift - 11 : 0; const unsigned dmask = (1u << (shift - nshift)) - 1u;
            const int nh_ = ((n >> 1) + 63) & ~63; const int lo_ = half ? nh_ : 0, hi_ = half ? n : (nh_ < n ? nh_ : n);
            __syncthreads();
            for (int i = lo_ + lane; i < hi_; i += 64) { const unsigned key = srow[i];
                if ((key >> shift) == (prefix >> shift)) { const unsigned d = (key >> nshift) & dmask; __hip_atomic_fetch_add(hrow + (d >> 1), 1u << (16 * (d & 1)), __ATOMIC_RELAXED, __HIP_MEMORY_SCOPE_WORKGROUP); } }
            __syncthreads();
            if (half == 0) { unsigned D, above, cD; idx_scan(hrow, k_rem, lane, D, above, cD);
                if (lane == 0) { st[q * 4 + 0] = prefix | (D << nshift); st[q * 4 + 1] = k_rem - above; st[q * 4 + 2] = cD; } }
            __syncthreads();
            shift = nshift;
        }
        const unsigned prefix = st[q * 4 + 0]; const int need = (int)st[q * 4 + 1], cD = (int)st[q * 4 + 2], c_gt = TOPK - need;
        const unsigned tp = prefix >> shift; const bool exact_dup = cD > IDX_CAND;
        const int nh = ((n >> 1) + 63) & ~63; const int lo = half ? nh : 0, hi = half ? n : (nh < n ? nh : n);
        if (exact_dup) {
          if (half == 0) {
            int cg = 0, ce = 0;
            for (int base = 0; base < n; base += 64) { const int i = base + lane; const unsigned kp = (i < n) ? srow[i] : 0u;
                const bool gt = (i < hi) && kp > tp, eq = (i < n) && kp == tp;
                const unsigned long long mg = __ballot(gt), me = __ballot(eq);
                const int pg = cg + mbcnt64(mg), pe = ce + mbcnt64(me);
                if (gt) orow[pg] = i;
                if (eq && pe < need) orow[c_gt + pe] = i;
                cg += __popcll(mg); ce += __popcll(me); }
          } else if (hi > lo) {
            int cg = 0;
            for (int base = lo + ((hi - 1 - lo) & ~63); base >= lo; base -= 64) { const int i = base + lane; const bool in = i < hi; const unsigned kp = in ? srow[i] : 0u;
                const bool gt = in && kp > tp; const unsigned long long mg = __ballot(gt);
                const int ag = __popcll(mg) - mbcnt64(mg) - (gt ? 1 : 0);
                if (gt) orow[c_gt - 1 - cg - ag] = i;
                cg += __popcll(mg); }
          }
        } else {
          LAS unsigned short* hl_ = (LAS unsigned short*)hrow + half * 1024;
          int nhit = 0;
          for (int base = lo; base < hi; base += 256) {
              const int i0 = base + 4 * lane; const v4u k4 = (i0 < hi) ? *(const LAS v4u*)(srow + i0) : (v4u){0u, 0u, 0u, 0u};
              const bool h0 = (i0 < hi) && (k4.x >> shift) >= tp, h1 = (i0 + 1 < hi) && (k4.y >> shift) >= tp, h2 = (i0 + 2 < hi) && (k4.z >> shift) >= tp, h3 = (i0 + 3 < hi) && (k4.w >> shift) >= tp;
              const int cnt = (int)h0 + (int)h1 + (int)h2 + (int)h3;
              int v = cnt;
#define IDX_DPP_ADD(ctrl, rmask, bmask) v += __builtin_amdgcn_update_dpp(0, v, ctrl, rmask, bmask, false)
              IDX_DPP_ADD(0x111, 0xf, 0xf); IDX_DPP_ADD(0x112, 0xf, 0xf); IDX_DPP_ADD(0x114, 0xf, 0xe); IDX_DPP_ADD(0x118, 0xf, 0xc); IDX_DPP_ADD(0x142, 0xa, 0xf); IDX_DPP_ADD(0x143, 0xc, 0xf);
#undef IDX_DPP_ADD
              int p = nhit + v - cnt;
              if (h0) { hl_[p] = (unsigned short)i0; ++p; }
              if (h1) { hl_[p] = (unsigned short)(i0 + 1); ++p; }
              if (h2) { hl_[p] = (unsigned short)(i0 + 2); ++p; }
              if (h3) { hl_[p] = (unsigned short)(i0 + 3); }
              nhit += __builtin_amdgcn_readlane(v, 63);
          }
          if (half == 0) {
            int cg = 0, ce = 0;
            for (int j0 = 0; j0 < nhit; j0 += 64) { const int j = j0 + lane; const bool in = j < nhit; const int i = in ? (int)hl_[j] : 0; const unsigned kp = in ? (srow[i] >> shift) : 0u;
                const bool gt = in && kp > tp, eq = in && kp == tp;
                const unsigned long long mg = __ballot(gt), me = __ballot(eq);
                const int pg = cg + mbcnt64(mg), pe = ce + mbcnt64(me);
                if (gt) orow[pg] = i;
                if (eq) crow[pe] = i;
                cg += __popcll(mg); ce += __popcll(me); }
          } else if (nhit > 0) {
            int cg = 0, ce = 0;
            for (int j0 = (nhit - 1) & ~63; j0 >= 0; j0 -= 64) { const int j = j0 + lane; const bool in = j < nhit; const int i = in ? (int)hl_[j] : 0; const unsigned kp = in ? (srow[i] >> shift) : 0u;
                const bool gt = in && kp > tp, eq = in && kp == tp;
                const unsigned long long mg = __ballot(gt), me = __ballot(eq);
                const int ag = __popcll(mg) - mbcnt64(mg) - (gt ? 1 : 0), ae = __popcll(me) - mbcnt64(me) - (eq ? 1 : 0);
                if (gt) orow[c_gt - 1 - cg - ag] = i;
                if (eq) crow[cD - 1 - ce - ae] = i;
                cg += __popcll(mg); ce += __popcll(me); }
          }
        }
        __syncthreads();
#ifndef IDX_REP_TAIL
#define IDX_REP_TAIL 1
#endif
        for (int trep = 0; trep < IDX_REP_TAIL; ++trep)
        if (half == 0 && !exact_dup) {
#pragma unroll
            for (int k = 0; k < 4; ++k) *(LAS v4u*)(hrow + 16 * lane + 4 * k) = (v4u){0u, 0u, 0u, 0u};
            unsigned pfx = prefix, k_rem = (unsigned)need; int sh = shift;
            int ci[8]; unsigned ck[8];
#pragma unroll
            for (int m = 0; m < 8; ++m) { const int j = lane + 64 * m; ci[m] = j < cD ? crow[j] : 0; }
            __builtin_amdgcn_sched_barrier(0);
#pragma unroll
            for (int m = 0; m < 8; ++m) { const int j = lane + 64 * m; ck[m] = j < cD ? srow[ci[m]] : 0u; }
            __builtin_amdgcn_sched_barrier(0);
            while (sh > 0) {
                const int nsh = sh > 11 ? sh - 11 : 0; const unsigned dmask = (1u << (sh - nsh)) - 1u;
#pragma unroll
                for (int m = 0; m < 8; ++m) { const int j = lane + 64 * m; const unsigned key = ck[m];
                    if (j < cD && (key >> sh) == (pfx >> sh)) { const unsigned d = (key >> nsh) & dmask; __hip_atomic_fetch_add(hrow + (d >> 1), 1u << (16 * (d & 1)), __ATOMIC_RELAXED, __HIP_MEMORY_SCOPE_WORKGROUP); } }
                unsigned D, above, cDn; idx_scan(hrow, k_rem, lane, D, above, cDn);
                pfx |= D << nsh; k_rem -= above; sh = nsh;
            }
            int cg = 0, ce = 0; const int n_gt = need - (int)k_rem;
#pragma unroll
            for (int m = 0; m < 8; ++m) { const int j = lane + 64 * m; const bool in = j < cD; const unsigned key = ck[m];
                const bool gt = in && key > pfx, eq = in && key == pfx;
                const unsigned long long mg = __ballot(gt), me = __ballot(eq);
                const int pg = cg + mbcnt64(mg), pe = ce + mbcnt64(me);
                if (gt) orow[c_gt + pg] = ci[m];
                if (eq && pe < (int)k_rem) orow[c_gt + n_gt + pe] = ci[m];
                cg += __popcll(mg); ce += __popcll(me); }
        }
        __syncthreads();
    }
}
constexpr float ATT_SCALE = 0.08838834764831845f;
__device__ __forceinline__ unsigned pkbf(float lo, float hi) { return pg8::cvt_pk_bf16(lo, hi); }
__device__ __forceinline__ void dsa_attn_phase(LAS unsigned char* lds, const bf16* Q, const unsigned char* KV8, const int* IDX, bf16* AO, const float* rel_bias, int c, int G, int tid, int wave, int lane) {
    typedef int v4i __attribute__((ext_vector_type(4))); typedef float f32x2 __attribute__((ext_vector_type(2)));
    constexpr int KSTR = 144, VSTR = 272, WBYTES = 32 * KSTR + 32 * VSTR;
    LAS unsigned char* kb = lds + wave * WBYTES; LAS unsigned char* vb = kb + 32 * KSTR;
    LAS int* idl = (LAS int*)(lds + NWAVES * WBYTES + wave * 2048);
    LAS float* tab = (LAS float*)(lds + NWAVES * WBYTES + NWAVES * 2048);
    build_bias_tab(tab, rel_bias, tid);
    __syncthreads();
    const int hl = lane & 15, Gq = lane >> 4, hsel = hl & 3, qrow = hl >> 2, pcol = lane & 3;
    const int NGW = G * NWAVES;
    const int uid0 = c * NWAVES + wave, nun = (8 * SEQ - uid0 + NGW - 1) / NGW;
    v4i ivn; v4u qraw[4];
#define DSA_UNIT(u_, k_, bg_, t_, tok_) const int u_ = uid0 + ((k_) < nun ? (k_) : nun - 1) * NGW; const int bg_ = (u_ >> 3) & 7, t_ = ((u_ >> 6) << 3) | (u_ & 7); const size_t tok_ = (size_t)(bg_ >> 2) * SEQ + t_
    { DSA_UNIT(ua_, 0, bg0, t0_, tok0); ivn = *(const GAS v4i*)(IDX + tok0 * TOPK + lane * 4);
      const GAS bf16* qs = (const GAS bf16*)(Q + tok0 * DM + ((bg0 & 3) * 4 + hsel) * HDIM + 8 * Gq);
#pragma unroll
      for (int ks = 0; ks < 4; ++ks) qraw[ks] = *(const GAS v4u*)(qs + ks * 32);
      *(LAS v4i*)(idl + lane * 4) = ivn; }
    v4u stk[4], stv[4];
#define DSA_RSRC(bg_) __builtin_amdgcn_make_buffer_rsrc((void*)(((unsigned long long)(unsigned)__builtin_amdgcn_readfirstlane((int)(unsigned)(((unsigned long long)(KV8 + (size_t)(bg_) * SEQ * 256)) >> 32)) << 32) | (unsigned)__builtin_amdgcn_readfirstlane((int)(unsigned)(unsigned long long)(KV8 + (size_t)(bg_) * SEQ * 256))), (short)0, SEQ * 256, 0x00020000)
#define DSA_LOAD(idp, cc, rs_) { int sj_[4]; _Pragma("unroll") for (int j = 0; j < 4; ++j) sj_[j] = (idp)[(cc) * 32 + 8 * j + (lane >> 3)]; __builtin_amdgcn_sched_barrier(0); \
        _Pragma("unroll") for (int j = 0; j < 4; ++j) { const int vo_ = (max(sj_[j], 0) << 8) + (lane & 7) * 16; stk[j] = __builtin_bit_cast(v4u, __builtin_amdgcn_raw_buffer_load_b128(rs_, vo_, 0, 0)); stv[j] = __builtin_bit_cast(v4u, __builtin_amdgcn_raw_buffer_load_b128(rs_, vo_ + 128, 0, 0)); } }
    { DSA_UNIT(ub_, 0, bg0, t0_, tok0); (void)t0_; (void)tok0; const __amdgpu_buffer_rsrc_t rs0 = DSA_RSRC(bg0); DSA_LOAD(idl, 0, rs0) }
    for (int k = 0; k < nun; ++k) {
        DSA_UNIT(uc_, k, bg, t, tok); const int b = bg >> 2, g = bg & 3; (void)b;
        LAS int* idc = idl + (k & 1) * 256; LAS int* idn = idl + ((k + 1) & 1) * 256;
        long qf[4];
#pragma unroll
        for (int ks = 0; ks < 4; ++ks) { const v4u v = qraw[ks];
            int w0 = __builtin_amdgcn_cvt_pk_fp8_f32(__uint_as_float(v.x << 16) * 16.f, __uint_as_float(v.x & 0xffff0000u) * 16.f, 0, false); w0 = __builtin_amdgcn_cvt_pk_fp8_f32(__uint_as_float(v.y << 16) * 16.f, __uint_as_float(v.y & 0xffff0000u) * 16.f, w0, true);
            int w1 = __builtin_amdgcn_cvt_pk_fp8_f32(__uint_as_float(v.z << 16) * 16.f, __uint_as_float(v.z & 0xffff0000u) * 16.f, 0, false); w1 = __builtin_amdgcn_cvt_pk_fp8_f32(__uint_as_float(v.w << 16) * 16.f, __uint_as_float(v.w & 0xffff0000u) * 16.f, w1, true);
            qf[ks] = hl < 4 ? (long)(((unsigned long long)(unsigned)w1 << 32) | (unsigned)w0) : 0L; }
        unsigned long long fastmask;
        { const int mn_ = min(min(ivn[0], ivn[1]), min(ivn[2], ivn[3])), mx_ = max(max(ivn[0], ivn[1]), max(ivn[2], ivn[3])); fastmask = __ballot(mn_ >= 0 && t - mx_ >= 128); }
        DSA_UNIT(un_, k + 1, bgn, tn, tokn); (void)tn;
        ivn = *(const GAS v4i*)(IDX + tokn * TOPK + lane * 4);
        { const GAS bf16* qs = (const GAS bf16*)(Q + tokn * DM + ((bgn & 3) * 4 + hsel) * HDIM + 8 * Gq);
#pragma unroll
          for (int ks = 0; ks < 4; ++ks) qraw[ks] = *(const GAS v4u*)(qs + ks * 32); }
        const __amdgpu_buffer_rsrc_t kvbn = DSA_RSRC(bgn), kvbase = DSA_RSRC(bg);
        const int hq = g * 4 + hsel; const float bfar = tab[128 * 16 + hq] * 1.4426950408889634f;
        float mrun = -3.0e38f, lsum = 0.f; f32x4 O[8];
#pragma unroll
        for (int db = 0; db < 8; ++db) O[db] = (f32x4){0.f, 0.f, 0.f, 0.f};
#pragma unroll 1
        for (int cc = 0; cc < 8; ++cc) {
#pragma unroll
            for (int j = 0; j < 4; ++j) { const int key = 8 * j + (lane >> 3), pc = lane & 7;
                *(LAS v4u*)(kb + key * KSTR + pc * 16) = stk[j];
                const unsigned w[4] = {stv[j].x, stv[j].y, stv[j].z, stv[j].w}; unsigned o[8];
#pragma unroll
                for (int e = 0; e < 4; ++e) { typedef __bf16 bf2_t __attribute__((ext_vector_type(2))); o[2 * e] = __builtin_bit_cast(unsigned, (bf2_t)__builtin_amdgcn_cvt_scalef32_pk_bf16_fp8(w[e], 1.0f, false)); o[2 * e + 1] = __builtin_bit_cast(unsigned, (bf2_t)__builtin_amdgcn_cvt_scalef32_pk_bf16_fp8(w[e], 1.0f, true)); }
                *(LAS v4u*)(vb + key * VSTR + pc * 32) = (v4u){o[0], o[1], o[2], o[3]}; *(LAS v4u*)(vb + key * VSTR + pc * 32 + 16) = (v4u){o[4], o[5], o[6], o[7]}; }
            if (cc < 7) { DSA_LOAD(idc, cc + 1, kvbase) } else { *(LAS v4i*)(idn + lane * 4) = ivn; DSA_LOAD(idn, 0, kvbn) }
            long ka[2][4];
#pragma unroll
            for (int rb = 0; rb < 2; ++rb)
#pragma unroll
                for (int ks = 0; ks < 4; ++ks) ka[rb][ks] = *(const LAS long*)(kb + (16 * rb + hl) * KSTR + ks * 32 + 8 * Gq);
            __builtin_amdgcn_sched_barrier(0);
            f32x4 S[2];
#pragma unroll
            for (int rb = 0; rb < 2; ++rb) S[rb] = (f32x4){0.f, 0.f, 0.f, 0.f};
#pragma unroll
            for (int ks = 0; ks < 4; ++ks)
#pragma unroll
                for (int rb = 0; rb < 2; ++rb) S[rb] = __builtin_amdgcn_mfma_f32_16x16x32_fp8_fp8(ka[rb][ks], qf[ks], S[rb], 0, 0, 0);
            float l[2][4]; float cmax = -3.0e38f;
            if (((fastmask >> (8 * cc)) & 0xFFull) == 0xFFull) {
#pragma unroll
                for (int rb = 0; rb < 2; ++rb)
#pragma unroll
                    for (int i = 0; i < 4; ++i) { const float v = fmaf(S[rb][i], ATT_SCALE * (1.f / 256.f) * 1.4426950408889634f, bfar); l[rb][i] = v; cmax = fmaxf(cmax, v); }
            } else {
                const v4i sv0 = *(const LAS v4i*)(idc + cc * 32 + 4 * Gq), sv1 = *(const LAS v4i*)(idc + cc * 32 + 16 + 4 * Gq);
#pragma unroll
                for (int rb = 0; rb < 2; ++rb)
#pragma unroll
                    for (int i = 0; i < 4; ++i) { const int s_ = rb ? sv1[i] : sv0[i]; int rel = t - s_; rel = rel > 128 ? 128 : (rel < 0 ? 0 : rel);
                        const float v = (s_ >= 0) ? (S[rb][i] * (ATT_SCALE * (1.f / 256.f)) + tab[rel * 16 + hq]) * 1.4426950408889634f : -1.0e30f; l[rb][i] = v; cmax = fmaxf(cmax, v); }
            }
            cmax = bfly32_max(bfly16_max(cmax));
            const float mnew = fmaxf(mrun, cmax);
            if (__any(mnew > mrun)) {
                const float alpha = __builtin_amdgcn_exp2f(mrun - mnew); lsum *= alpha;
#pragma unroll
                for (int db = 0; db < 8; ++db) O[db] = O[db] * alpha;
            }
            mrun = mnew;
            float ps = 0.f;
#pragma unroll
            for (int rb = 0; rb < 2; ++rb)
#pragma unroll
                for (int i = 0; i < 4; ++i) { l[rb][i] = __builtin_amdgcn_exp2f(l[rb][i] - mnew); ps += l[rb][i]; }
            lsum += ps;
            v4u pu; pu.x = pkbf(l[0][0], l[0][1]); pu.y = pkbf(l[0][2], l[0][3]); pu.z = pkbf(l[1][0], l[1][1]); pu.w = pkbf(l[1][2], l[1][3]);
            const bf16x8 pa = __builtin_bit_cast(bf16x8, pu);
            s16x4 vt[8][2];
#pragma unroll
            for (int db = 0; db < 8; ++db) { vt[db][0] = vtr(vb + (4 * Gq + qrow) * VSTR + (16 * db + 4 * pcol) * 2); vt[db][1] = vtr(vb + (16 + 4 * Gq + qrow) * VSTR + (16 * db + 4 * pcol) * 2); }
            __builtin_amdgcn_sched_barrier(0);
#pragma unroll
            for (int db = 0; db < 8; ++db) { const s16x4 v0 = vt[db][0], v1 = vt[db][1];
                const bf16x8 a = (bf16x8){v0[0], v0[1], v0[2], v0[3], v1[0], v1[1], v1[2], v1[3]};
                O[db] = __builtin_amdgcn_mfma_f32_16x16x32_bf16(a, pa, O[db], 0, 0, 0); }
        }
#undef DSA_LOAD
#undef DSA_RSRC
#undef DSA_UNIT
        lsum = bfly32_sum(bfly16_sum(lsum));
        const float inv = 1.0f / (lsum * 16.0f);
        if (hl < 4) { GAS bf16* op = (GAS bf16*)(AO + tok * DM + (g * 4 + hl) * HDIM + 4 * Gq);
#pragma unroll
            for (int db = 0; db < 8; ++db) { const f32x4 o = O[db] * inv; v2u w; w.x = pkbf(o[0], o[1]); w.y = pkbf(o[2], o[3]); *(GAS v2u*)(op + 16 * db) = w; } }
    }
}

__device__ __forceinline__ void swa_attn_phase(LAS unsigned char* lds, const bf16* Q, const bf16* KV, bf16* AO, const float* rel_bias, const float* sinks, int c, int G, int tid, int wave, int lane) {
    LAS unsigned char* band = lds;
    LAS float* tab = (LAS float*)(lds + 272 * 528);
    LAS float* tabM = tab + TAB_ENTRIES;
    build_bias_tab(tab, rel_bias, tid);
    for (int i = tid; i < 16 * 528 / 4; i += NWAVES * 64) ((LAS unsigned*)(band + 256 * 528))[i] = 0u;
    const int hl = lane & 15, Gq = lane >> 4, qrow = hl >> 2, pcol = lane & 3;
    for (int uid = c; uid < 512; uid += G) {
        const int b = uid >> 8, nb = (uid & 255) >> 2, g = uid & 3, bg = b * 4 + g;
        __syncthreads();
        { const int piece = tid & 31;
#pragma unroll 4
          for (int i = 0; i < 16; ++i) { const int row = (tid >> 5) + 16 * i, ka = nb * 128 - 128 + row; v4u v = (v4u){0u, 0u, 0u, 0u};
              if (ka >= 0) v = *(const GAS v4u*)(KV + ((size_t)bg * SEQ + ka) * 256 + piece * 8);
              *(LAS v4u*)(band + row * 528 + piece * 16) = v; } }
        for (int e = tid; e < 4 * 176; e += NWAVES * 64) { const int r = e / 176, rel = e - r * 176 - 31; tabM[e] = (rel >= 0 && rel < 128) ? tab[rel * 16 + g * 4 + r] * 1.4426950408889634f : -1.0e30f; }
        __syncthreads();
        const int ql = 16 * wave + hl, t = nb * 128 + ql, cbase = 16 * wave; const size_t tok = (size_t)b * SEQ + t;
        bf16x8 qn[4];
        { const GAS bf16* qs = (const GAS bf16*)(Q + tok * DM + (g * 4) * HDIM + 8 * Gq);
#pragma unroll
          for (int ks = 0; ks < 4; ++ks) qn[ks] = *(const GAS bf16x8*)(qs + ks * 32); }
#pragma unroll 1
        for (int r = 0; r < 4; ++r) {
            const int hq = g * 4 + r;
            bf16x8 qf[4];
#pragma unroll
            for (int ks = 0; ks < 4; ++ks) qf[ks] = qn[ks];
            { const GAS bf16* qs = (const GAS bf16*)(Q + tok * DM + (g * 4 + (r < 3 ? r + 1 : 3)) * HDIM + 8 * Gq);
#pragma unroll
              for (int ks = 0; ks < 4; ++ks) qn[ks] = *(const GAS bf16x8*)(qs + ks * 32); }
            f32x4 S[10];
#pragma unroll
            for (int rh = 0; rh < 2; ++rh) {
                bf16x8 ka[5][4];
#pragma unroll
                for (int r5 = 0; r5 < 5; ++r5)
#pragma unroll
                    for (int ks = 0; ks < 4; ++ks) ka[r5][ks] = *(const LAS bf16x8*)(band + (cbase + 16 * (5 * rh + r5) + hl) * 528 + (ks * 32 + 8 * Gq) * 2);
                __builtin_amdgcn_sched_barrier(0);
#pragma unroll
                for (int r5 = 0; r5 < 5; ++r5) S[5 * rh + r5] = (f32x4){0.f, 0.f, 0.f, 0.f};
#pragma unroll
                for (int ks = 0; ks < 4; ++ks)
#pragma unroll
                    for (int r5 = 0; r5 < 5; ++r5) S[5 * rh + r5] = __builtin_amdgcn_mfma_f32_16x16x32_bf16(ka[r5][ks], qf[ks], S[5 * rh + r5], 0, 0, 0);
            }
            const float sink2 = sinks[hq] * 1.4426950408889634f; float mx = sink2;
            const LAS float* tlow = tabM + r * 176 + (hl - 4 * Gq + 12);
            float bv[10][4];
#pragma unroll
            for (int rb = 0; rb < 10; ++rb)
#pragma unroll
                for (int i = 0; i < 4; ++i) bv[rb][i] = tlow[147 - 16 * rb - i];
#pragma unroll
            for (int rb = 0; rb < 10; ++rb)
#pragma unroll
                for (int i = 0; i < 4; ++i) S[rb][i] = S[rb][i] * (ATT_SCALE * 1.4426950408889634f) + bv[rb][i];
            if (nb == 0) {
#pragma unroll
                for (int rb = 0; rb < 8; ++rb) if (rb < 8 - wave) S[rb] = (f32x4){-1.0e30f, -1.0e30f, -1.0e30f, -1.0e30f};
            }
#pragma unroll
            for (int rb = 0; rb < 10; ++rb) mx = fmaxf(mx, fmaxf(fmaxf(S[rb][0], S[rb][1]), fmaxf(S[rb][2], S[rb][3])));
            mx = bfly32_max(bfly16_max(mx));
            float sum = 0.f;
#pragma unroll
            for (int rb = 0; rb < 10; ++rb)
#pragma unroll
                for (int i = 0; i < 4; ++i) { const float p = __builtin_amdgcn_exp2f(S[rb][i] - mx); S[rb][i] = p; sum += p; }
            sum = bfly32_sum(bfly16_sum(sum)); sum += __builtin_amdgcn_exp2f(sink2 - mx);
            const float inv = 1.0f / sum;
            f32x4 O[8];
#pragma unroll
            for (int db = 0; db < 8; ++db) O[db] = (f32x4){0.f, 0.f, 0.f, 0.f};
#pragma unroll
            for (int ch = 0; ch < 5; ++ch) {
                v4u pu; pu.x = pkbf(S[2 * ch][0], S[2 * ch][1]); pu.y = pkbf(S[2 * ch][2], S[2 * ch][3]); pu.z = pkbf(S[2 * ch + 1][0], S[2 * ch + 1][1]); pu.w = pkbf(S[2 * ch + 1][2], S[2 * ch + 1][3]);
                const bf16x8 pa = __builtin_bit_cast(bf16x8, pu);
                s16x4 vt[8][2];
#pragma unroll
                for (int db = 0; db < 8; ++db) { vt[db][0] = vtr(band + (cbase + 32 * ch + 4 * Gq + qrow) * 528 + 256 + (16 * db + 4 * pcol) * 2); vt[db][1] = vtr(band + (cbase + 32 * ch + 16 + 4 * Gq + qrow) * 528 + 256 + (16 * db + 4 * pcol) * 2); }
                __builtin_amdgcn_sched_barrier(0);
#pragma unroll
                for (int db = 0; db < 8; ++db) { const s16x4 v0 = vt[db][0], v1 = vt[db][1];
                    const bf16x8 a = (bf16x8){v0[0], v0[1], v0[2], v0[3], v1[0], v1[1], v1[2], v1[3]};
                    O[db] = __builtin_amdgcn_mfma_f32_16x16x32_bf16(a, pa, O[db], 0, 0, 0); }
            }
            GAS bf16* op = (GAS bf16*)(AO + tok * DM + hq * HDIM + 4 * Gq);
#pragma unroll
            for (int db = 0; db < 8; ++db) { const f32x4 o = O[db] * inv; v2u w; w.x = pkbf(o[0], o[1]); w.y = pkbf(o[2], o[3]); *(GAS v2u*)(op + 16 * db) = w; }
        }
    }
}
#ifndef REPP
#define REPP 1
#endif
#ifndef REP0
#define REP0 1
#endif
#ifndef REP1
#define REP1 1
#endif
#ifndef REP2
#define REP2 1
#endif
#ifndef REP3D
#define REP3D 1
#endif
#ifndef REP3S
#define REP3S 1
#endif
#ifndef REP4
#define REP4 1
#endif
#ifndef REP5
#define REP5 1
#endif
#ifndef REP6
#define REP6 1
#endif
#ifndef REP7
#define REP7 1
#endif
#ifndef REP8
#define REP8 1
#endif
#ifndef REP9
#define REP9 1
#endif
#ifndef REP10
#define REP10 1
#endif
#ifndef REP11
#define REP11 1
#endif
#ifndef DEFER_CONV
#define DEFER_CONV 1
#endif
#ifndef CONV_GG
#define CONV_GG 224
#endif
#ifndef GRP_BAR
#define GRP_BAR 1
#endif
#ifndef NOS1
#define NOS1 0
#endif
#ifndef NOS4
#define NOS4 0
#endif
#ifndef NOS6
#define NOS6 0
#endif
#ifndef NOS7
#define NOS7 0
#endif
#ifndef NOS8
#define NOS8 0
#endif
#ifndef NOS9
#define NOS9 0
#endif
#ifndef NOS11
#define NOS11 0
#endif

constexpr int PH_FINAL = 1 + 12 * DEPTH, PH_END = PH_FINAL + 1;
struct Args { const float* in[19]; float* out; unsigned char* ws; int ph_lo, ph_hi; };
__global__ void __launch_bounds__(NWAVES * 64, 2) yoco_fwd(Args args) {
    extern __shared__ __attribute__((aligned(16))) unsigned char lds_raw[];
    LAS unsigned char* lds = (LAS unsigned char*)lds_raw;
    volatile LAS unsigned* MISC = (volatile LAS unsigned*)(lds + MISC_OFF);
    const int tid = threadIdx.x, lane = tid & 63, wave = __builtin_amdgcn_readfirstlane(tid >> 6);
    const int G = gridDim.x, bx = blockIdx.x, vcu = (G % 8 == 0) ? (bx % 8) * (G / 8) + bx / 8 : bx;
    const int gw = vcu * NWAVES + wave, NGW = G * NWAVES;
    for (int u = tid; u < 64; u += NWAVES * 64) MISC[u] = 0u;
    __syncthreads();
    gu32* ctl = (gu32*)(args.ws + WS_CTL);
    XcdBarrier bar; bar.bar = (unsigned*)ctl + CW_BAR; bar.x = 0; bar.st = nullptr;
    if (!MK_PER_PHASE) bar = xcd_barrier_post((unsigned*)ctl + CW_BAR, MISC + 8);
#define GRID_BAR() do { if (!MK_PER_PHASE) xcd_barrier(bar); } while (0)
    unsigned* const grpw = (unsigned*)ctl + 64 * (8 * (bx % 8) + (bx / 8) % 8);
    if (!MK_PER_PHASE && G == 256 && tid == 0) __hip_atomic_store(grpw + 8 + (bx / 8) / 8, xb_xcc_id() + 1u, __ATOMIC_RELAXED, __HIP_MEMORY_SCOPE_AGENT);
#define GROUP_BAR() do { if (!MK_PER_PHASE) { if (GRP_BAR && gridDim.x == 256) grp_barrier(grpw, MISC + 10, bar.bar); else xcd_barrier(bar); } } while (0)
    const int lo = args.ph_lo, hi = args.ph_hi;
#define IN(k) (lo <= (k) && (k) < hi)
#define SITE() unsigned char* wsp = args.ws; float* Xp = args.out; int bxs = blockIdx.x, Gs = gridDim.x, tids = threadIdx.x; \
    asm volatile("" : "+s"(wsp), "+s"(Xp), "+s"(bxs), "+s"(Gs), "+v"(tids)); \
    const int lanes = tids & 63, waves = __builtin_amdgcn_readfirstlane(tids >> 6); \
    const int vcus = (Gs % 8 == 0) ? (bxs % 8) * (Gs / 8) + bxs / 8 : bxs, gws = vcus * NWAVES + waves, NGWs = Gs * NWAVES; (void)lanes; (void)gws; (void)NGWs; (void)Xp; (void)wsp
#define x_in (args.in[0])
#define X (Xp)
#define XN ((bf16*)(wsp + WS_XN))
#define Qb ((bf16*)(wsp + WS_Q))
#define AOb ((bf16*)(wsp + WS_AO))
#define QIb ((bf16*)(wsp + WS_QI))
#define KIWb ((bf16*)(wsp + WS_KIW))
#define IDXb ((int*)(wsp + WS_IDX))
#define KITb ((bf16*)(wsp + WS_KIT))
#define KVA ((bf16*)(wsp + WS_KVA))
#define KVB ((bf16*)(wsp + WS_KVB))
#define Ub ((bf16*)(wsp + WS_U))
#define PEb ((bf16*)(wsp + WS_PE))
#define PB ((bf16*)(wsp + WS_PB))
#define XNB2 ((bf16*)(wsp + WS_XNB))
#define SSQ(i) ((float*)(wsp + WS_SSP) + (size_t)(i) * M * 32)
#define RTAB ((LAS float*)(lds + RTAB_OFF))

#ifndef NO_PRO
    for (int rep = 0; rep < REPP; ++rep) if (IN(0)) { SITE();
        LAS float* scr = (LAS float*)(lds + waves * 16640);
        int rot = 0;
        for (int i = 0; i < N_A; ++i) conv_matrix(args.in[2] + (size_t)i * DM * A_IN, args.in[10] + (size_t)i * DM, DM, A_IN, (bf16*)(wsp + WS_WIN) + (size_t)i * A_INP * DM, 1, scr, gws, NGWs, lanes, rot);
        const bool defer = DEFER_CONV && Gs == 256;
        for (int i = 0; i < N_A; ++i) if (!(defer && i == 1)) conv_matrix(args.in[3] + (size_t)i * DM * DM, nullptr, DM, DM, (bf16*)(wsp + WS_WOA) + (size_t)i * DM * DM, 0, scr, gws, NGWs, lanes, rot);
        for (int i = 0; i < DEPTH - N_A; ++i) conv_matrix(args.in[4] + (size_t)i * DM * DM, args.in[10] + (size_t)(N_A + i) * DM, DM, DM, (bf16*)(wsp + WS_WQB) + (size_t)i * DM * DM, 0, scr, gws, NGWs, lanes, rot);
        for (int i = 0; i < DEPTH - N_A; ++i) conv_matrix(args.in[5] + (size_t)i * DM * DM, nullptr, DM, DM, (bf16*)(wsp + WS_WOB) + (size_t)i * DM * DM, 0, scr, gws, NGWs, lanes, rot);
        conv_matrix(args.in[8], args.in[7], DM, 1024, (bf16*)(wsp + WS_WKV), 2, scr, gws, NGWs, lanes, rot);
        for (int i = 0; i < DEPTH; ++i) if (!(defer && i == 1)) conv_matrix(args.in[17] + (size_t)i * DM * DM, args.in[15] + (size_t)i * DM, DM, DM, (bf16*)(wsp + WS_WPG) + (size_t)i * DM * DM, 0, scr, gws, NGWs, lanes, rot);
        for (int i = 0; i < DEPTH; ++i) conv_matrix(args.in[16] + (size_t)i * PLE * DM, nullptr, PLE, DM, (bf16*)(wsp + WS_WPE) + (size_t)i * DM * PLE, 0, scr, gws, NGWs, lanes, rot);
        for (int i = 0; i < DEPTH; ++i) if (!(defer && (i == 1 || i == 2))) conv_matrix(args.in[12] + (size_t)i * DM * DFF, args.in[11] + (size_t)i * DM, DM, DFF, (bf16*)(wsp + WS_W13) + (size_t)i * 2 * DFF * DM, 3, scr, gws, NGWs, lanes, rot);
        for (int i = 0; i < DEPTH; ++i) if (!(defer && (i == 1 || i == 2))) conv_matrix(args.in[13] + (size_t)i * DM * DFF, args.in[11] + (size_t)i * DM, DM, DFF, (bf16*)(wsp + WS_W13) + (size_t)i * 2 * DFF * DM, 4, scr, gws, NGWs, lanes, rot);
        for (int i = 0; i < DEPTH; ++i) if (!(defer && i == 2)) conv_matrix(args.in[14] + (size_t)i * DFF * DM, nullptr, DFF, DM, (bf16*)(wsp + WS_W2) + (size_t)i * DM * DFF, 0, scr, gws, NGWs, lanes, rot);
        const size_t gt = (size_t)vcus * (NWAVES * 64) + tids, NT = (size_t)Gs * (NWAVES * 64);
        for (int i = 0; i < N_A; ++i) { GAS v4u* z = (GAS v4u*)((bf16*)(wsp + WS_WIN) + ((size_t)i * A_INP + A_IN) * DM);
            for (size_t e = gt; e < (size_t)(A_INP - A_IN) * DM / 8; e += NT) z[e] = (v4u){0u, 0u, 0u, 0u}; }
        { const GAS f32x4* ps = (const GAS f32x4*)args.in[1]; GAS v4u* pd = (GAS v4u*)PB;
          for (size_t e = gt; e < (size_t)DEPTH * M * PLE / 8; e += 4 * NT) { f32x4 a[4], b[4];
#pragma unroll
              for (int u = 0; u < 4; ++u) { a[u] = ps[2 * (e + u * NT)]; b[u] = ps[2 * (e + u * NT) + 1]; }
#pragma unroll
              for (int u = 0; u < 4; ++u) { v4u o; o.x = pk2(a[u].x, a[u].y); o.y = pk2(a[u].z, a[u].w); o.z = pk2(b[u].x, b[u].y); o.w = pk2(b[u].z, b[u].w); pd[e + u * NT] = o; } } }
        xb_phase(x_in, XNB2, SSQ(12), gws, NGWs, lanes);
        GRID_BAR();
    }
#endif

    { constexpr int L = 0;
        const int pb = 1 + 12 * L; const bool dsa = L < N_A; const int Lb = L - N_A;
        for (int rep = 0; rep < REP1; ++rep) if (IN(pb + 1) && !NOS1) { SITE();
            const bf16* Bt = dsa ? (const bf16*)(wsp + WS_WIN) + (size_t)L * A_INP * DM : (const bf16*)(wsp + WS_WQB) + (size_t)Lb * DM * DM; const int N = dsa ? A_INP : DM;
            const bool part = DEFER_CONV && dsa && Gs == 256; const int Gg = part ? CONV_GG : Gs;
            pg8::Gemm g{XNB2, Bt, M, N, DM, 1}; pg8::StaticOrder S; S.init(M, N, Gg, bxs); if (part && bxs >= Gg) S.nwg = 0;
            pg8::rs_finalize(RTAB, S, SSQ(L == 0 ? 12 : 3 * (L - 1) + 2), tids);
            pg8::EpiBf16Map E{dsa ? 1 : 0, Qb, DM, KVA, QIb, KIWb, RTAB, KITb};
            pg8::gemm_phase<pg8::EpiBf16Map, pg8::StaticOrder, true, true>(lds, g, S, E);
            if (part && rep == 0 && bxs >= Gg) {
                __syncthreads();
                LAS float* scr = (LAS float*)(lds + waves * 16640); int rot = 0; const int gw2 = (bxs - Gg) * NWAVES + waves, NGW2 = (Gs - Gg) * NWAVES; const int Ld = L + 1;
                conv_matrix(args.in[12] + (size_t)Ld * DM * DFF, args.in[11] + (size_t)Ld * DM, DM, DFF, (bf16*)(wsp + WS_W13) + (size_t)Ld * 2 * DFF * DM, 3, scr, gw2, NGW2, lanes, rot);
                conv_matrix(args.in[13] + (size_t)Ld * DM * DFF, args.in[11] + (size_t)Ld * DM, DM, DFF, (bf16*)(wsp + WS_W13) + (size_t)Ld * 2 * DFF * DM, 4, scr, gw2, NGW2, lanes, rot);
                if (L == 0) { conv_matrix(args.in[17] + (size_t)1 * DM * DM, args.in[15] + (size_t)1 * DM, DM, DM, (bf16*)(wsp + WS_WPG) + (size_t)1 * DM * DM, 0, scr, gw2, NGW2, lanes, rot);
                              conv_matrix(args.in[3] + (size_t)1 * DM * DM, nullptr, DM, DM, (bf16*)(wsp + WS_WOA) + (size_t)1 * DM * DM, 0, scr, gw2, NGW2, lanes, rot); }
                else conv_matrix(args.in[14] + (size_t)2 * DFF * DM, nullptr, DFF, DM, (bf16*)(wsp + WS_W2) + (size_t)2 * DM * DFF, 0, scr, gw2, NGW2, lanes, rot);
            }
            GRID_BAR();
        }
#ifndef NO_IDX
        for (int rep = 0; rep < REP2; ++rep) if (dsa && IN(pb + 2)) { SITE(); indexer_phase(lds, QIb, KIWb, KITb, IDXb, bxs, Gs, tids, waves, lanes); GRID_BAR(); }
#endif
        for (int rep = 0; rep < (dsa ? REP3D : REP3S); ++rep) if (IN(pb + 3)) { SITE();
#ifndef NO_DSA
            if (dsa) dsa_attn_phase(lds, Qb, (const unsigned char*)KVA, IDXb, AOb, args.in[9], bxs, Gs, tids, waves, lanes);
#endif
#ifndef NO_SWA
            if (!dsa) swa_attn_phase(lds, Qb, KVB, AOb, args.in[9], args.in[6] + (size_t)Lb * NHEAD, bxs, Gs, tids, waves, lanes);
#endif
            GRID_BAR();
        }
        for (int rep = 0; rep < REP4; ++rep) if (IN(pb + 4) && !NOS4) { SITE();
            const bf16* Bt = dsa ? (const bf16*)(wsp + WS_WOA) + (size_t)L * DM * DM : (const bf16*)(wsp + WS_WOB) + (size_t)Lb * DM * DM;
            pg8::Gemm g{AOb, Bt, M, DM, DM}; pg8::StaticOrder S; S.init(M, DM, Gs, bxs);
            pg8::EpiResid E{XNB2, rep ? Qb : XN, rep ? (float*)(wsp + WS_QI) : SSQ(3 * L)};
            pg8::gemm_phase<pg8::EpiResid, pg8::StaticOrder, true, true>(lds, g, S, E);
            GROUP_BAR();
        }
        for (int rep = 0; rep < REP6; ++rep) if (IN(pb + 6) && !NOS6) { SITE();
            pg8::Gemm g{XN, (const bf16*)(wsp + WS_W13) + (size_t)L * 2 * DFF * DM, M, 2 * DFF, DM, 1}; pg8::StaticOrder S; S.init(M, 2 * DFF, Gs, bxs);
            pg8::rs_finalize(RTAB, S, SSQ(3 * L), tids);
            pg8::EpiSwiglu E{Ub, RTAB};
            pg8::gemm_phase<pg8::EpiSwiglu, pg8::StaticOrder, true, true>(lds, g, S, E);
            GROUP_BAR();
        }
        for (int rep = 0; rep < REP7; ++rep) if (IN(pb + 7) && !NOS7) { SITE();
            { pg8::Gemm g{Ub, (const bf16*)(wsp + WS_W2) + (size_t)L * DM * DFF, M, DM, DFF, 1}; pg8::StaticOrder S; S.init(M, DM, Gs, bxs);
              pg8::EpiResid E{XN, rep ? XNB2 : XN, rep ? SSQ(3 * L + 2) : SSQ(3 * L + 1)};
              pg8::gemm_phase<pg8::EpiResid, pg8::StaticOrder, true, true>(lds, g, S, E); }
            { pg8::Gemm g{PB + (size_t)L * M * PLE, (const bf16*)(wsp + WS_WPE) + (size_t)L * DM * PLE, M, DM, PLE}; pg8::StaticOrder S; S.init(M, DM, Gs, bxs);
              pg8::EpiBf16Map E{3, PEb, DM, nullptr, nullptr, nullptr, nullptr, nullptr};
              pg8::gemm_phase<pg8::EpiBf16Map, pg8::StaticOrder, true, true>(lds, g, S, E); }
            GROUP_BAR();
        }
        for (int rep = 0; rep < REP9; ++rep) if (IN(pb + 9) && !NOS9) { SITE();
            pg8::Gemm g{XN, (const bf16*)(wsp + WS_WPG) + (size_t)L * DM * DM, M, DM, DM, 1}; pg8::StaticOrder S; S.init(M, DM, Gs, bxs);
            pg8::rs_finalize(RTAB, S, SSQ(3 * L + 1), tids);
            pg8::EpiGate E{XN, PEb, RTAB, rep ? Qb : XNB2, rep ? (float*)(wsp + WS_QI) : SSQ(3 * L + 2)};
            pg8::gemm_phase<pg8::EpiGate, pg8::StaticOrder, true, true>(lds, g, S, E);
            if (L == DEPTH - 1 || L == N_A - 1) GROUP_BAR(); else GRID_BAR();
        }
        if (L == N_A - 1) {
            for (int rep = 0; rep < REP11; ++rep) if (IN(pb + 11) && !NOS11) { SITE();
                pg8::Gemm g{XNB2, (const bf16*)(wsp + WS_WKV), M, 1024, DM, 1}; pg8::StaticOrder S; S.init(M, 1024, Gs, bxs);
                pg8::rs_finalize(RTAB, S, SSQ(3 * L + 2), tids);
                pg8::EpiBf16Map E{2, nullptr, 0, KVB, nullptr, nullptr, RTAB, nullptr};
                pg8::gemm_phase<pg8::EpiBf16Map, pg8::StaticOrder, true, true>(lds, g, S, E);
                GRID_BAR();
            }
        }
        }
    { constexpr int L = 1;
        const int pb = 1 + 12 * L; const bool dsa = L < N_A; const int Lb = L - N_A;
        for (int rep = 0; rep < REP1; ++rep) if (IN(pb + 1) && !NOS1) { SITE();
            const bf16* Bt = dsa ? (const bf16*)(wsp + WS_WIN) + (size_t)L * A_INP * DM : (const bf16*)(wsp + WS_WQB) + (size_t)Lb * DM * DM; const int N = dsa ? A_INP : DM;
            const bool part = DEFER_CONV && dsa && Gs == 256; const int Gg = part ? CONV_GG : Gs;
            pg8::Gemm g{XNB2, Bt, M, N, DM, 1}; pg8::StaticOrder S; S.init(M, N, Gg, bxs); if (part && bxs >= Gg) S.nwg = 0;
            pg8::rs_finalize(RTAB, S, SSQ(L == 0 ? 12 : 3 * (L - 1) + 2), tids);
            pg8::EpiBf16Map E{dsa ? 1 : 0, Qb, DM, KVA, QIb, KIWb, RTAB, KITb};
            pg8::gemm_phase<pg8::EpiBf16Map, pg8::StaticOrder, true, true>(lds, g, S, E);
            if (part && rep == 0 && bxs >= Gg) {
                __syncthreads();
                LAS float* scr = (LAS float*)(lds + waves * 16640); int rot = 0; const int gw2 = (bxs - Gg) * NWAVES + waves, NGW2 = (Gs - Gg) * NWAVES; const int Ld = L + 1;
                conv_matrix(args.in[12] + (size_t)Ld * DM * DFF, args.in[11] + (size_t)Ld * DM, DM, DFF, (bf16*)(wsp + WS_W13) + (size_t)Ld * 2 * DFF * DM, 3, scr, gw2, NGW2, lanes, rot);
                conv_matrix(args.in[13] + (size_t)Ld * DM * DFF, args.in[11] + (size_t)Ld * DM, DM, DFF, (bf16*)(wsp + WS_W13) + (size_t)Ld * 2 * DFF * DM, 4, scr, gw2, NGW2, lanes, rot);
                if (L == 0) { conv_matrix(args.in[17] + (size_t)1 * DM * DM, args.in[15] + (size_t)1 * DM, DM, DM, (bf16*)(wsp + WS_WPG) + (size_t)1 * DM * DM, 0, scr, gw2, NGW2, lanes, rot);
                              conv_matrix(args.in[3] + (size_t)1 * DM * DM, nullptr, DM, DM, (bf16*)(wsp + WS_WOA) + (size_t)1 * DM * DM, 0, scr, gw2, NGW2, lanes, rot); }
                else conv_matrix(args.in[14] + (size_t)2 * DFF * DM, nullptr, DFF, DM, (bf16*)(wsp + WS_W2) + (size_t)2 * DM * DFF, 0, scr, gw2, NGW2, lanes, rot);
            }
            GRID_BAR();
        }
#ifndef NO_IDX
        for (int rep = 0; rep < REP2; ++rep) if (dsa && IN(pb + 2)) { SITE(); indexer_phase(lds, QIb, KIWb, KITb, IDXb, bxs, Gs, tids, waves, lanes); GRID_BAR(); }
#endif
        for (int rep = 0; rep < (dsa ? REP3D : REP3S); ++rep) if (IN(pb + 3)) { SITE();
#ifndef NO_DSA
            if (dsa) dsa_attn_phase(lds, Qb, (const unsigned char*)KVA, IDXb, AOb, args.in[9], bxs, Gs, tids, waves, lanes);
#endif
#ifndef NO_SWA
            if (!dsa) swa_attn_phase(lds, Qb, KVB, AOb, args.in[9], args.in[6] + (size_t)Lb * NHEAD, bxs, Gs, tids, waves, lanes);
#endif
            GRID_BAR();
        }
        for (int rep = 0; rep < REP4; ++rep) if (IN(pb + 4) && !NOS4) { SITE();
            const bf16* Bt = dsa ? (const bf16*)(wsp + WS_WOA) + (size_t)L * DM * DM : (const bf16*)(wsp + WS_WOB) + (size_t)Lb * DM * DM;
            pg8::Gemm g{AOb, Bt, M, DM, DM}; pg8::StaticOrder S; S.init(M, DM, Gs, bxs);
            pg8::EpiResid E{XNB2, rep ? Qb : XN, rep ? (float*)(wsp + WS_QI) : SSQ(3 * L)};
            pg8::gemm_phase<pg8::EpiResid, pg8::StaticOrder, true, true>(lds, g, S, E);
            GROUP_BAR();
        }
        for (int rep = 0; rep < REP6; ++rep) if (IN(pb + 6) && !NOS6) { SITE();
            pg8::Gemm g{XN, (const bf16*)(wsp + WS_W13) + (size_t)L * 2 * DFF * DM, M, 2 * DFF, DM, 1}; pg8::StaticOrder S; S.init(M, 2 * DFF, Gs, bxs);
            pg8::rs_finalize(RTAB, S, SSQ(3 * L), tids);
            pg8::EpiSwiglu E{Ub, RTAB};
            pg8::gemm_phase<pg8::EpiSwiglu, pg8::StaticOrder, true, true>(lds, g, S, E);
            GROUP_BAR();
        }
        for (int rep = 0; rep < REP7; ++rep) if (IN(pb + 7) && !NOS7) { SITE();
            { pg8::Gemm g{Ub, (const bf16*)(wsp + WS_W2) + (size_t)L * DM * DFF, M, DM, DFF, 1}; pg8::StaticOrder S; S.init(M, DM, Gs, bxs);
              pg8::EpiResid E{XN, rep ? XNB2 : XN, rep ? SSQ(3 * L + 2) : SSQ(3 * L + 1)};
              pg8::gemm_phase<pg8::EpiResid, pg8::StaticOrder, true, true>(lds, g, S, E); }
            { pg8::Gemm g{PB + (size_t)L * M * PLE, (const bf16*)(wsp + WS_WPE) + (size_t)L * DM * PLE, M, DM, PLE}; pg8::StaticOrder S; S.init(M, DM, Gs, bxs);
              pg8::EpiBf16Map E{3, PEb, DM, nullptr, nullptr, nullptr, nullptr, nullptr};
              pg8::gemm_phase<pg8::EpiBf16Map, pg8::StaticOrder, true, true>(lds, g, S, E); }
            GROUP_BAR();
        }
        for (int rep = 0; rep < REP9; ++rep) if (IN(pb + 9) && !NOS9) { SITE();
            pg8::Gemm g{XN, (const bf16*)(wsp + WS_WPG) + (size_t)L * DM * DM, M, DM, DM, 1}; pg8::StaticOrder S; S.init(M, DM, Gs, bxs);
            pg8::rs_finalize(RTAB, S, SSQ(3 * L + 1), tids);
            pg8::EpiGate E{XN, PEb, RTAB, rep ? Qb : XNB2, rep ? (float*)(wsp + WS_QI) : SSQ(3 * L + 2)};
            pg8::gemm_phase<pg8::EpiGate, pg8::StaticOrder, true, true>(lds, g, S, E);
            if (L == DEPTH - 1 || L == N_A - 1) GROUP_BAR(); else GRID_BAR();
        }
        if (L == N_A - 1) {
            for (int rep = 0; rep < REP11; ++rep) if (IN(pb + 11) && !NOS11) { SITE();
                pg8::Gemm g{XNB2, (const bf16*)(wsp + WS_WKV), M, 1024, DM, 1}; pg8::StaticOrder S; S.init(M, 1024, Gs, bxs);
                pg8::rs_finalize(RTAB, S, SSQ(3 * L + 2), tids);
                pg8::EpiBf16Map E{2, nullptr, 0, KVB, nullptr, nullptr, RTAB, nullptr};
                pg8::gemm_phase<pg8::EpiBf16Map, pg8::StaticOrder, true, true>(lds, g, S, E);
                GRID_BAR();
            }
        }
        }
    { constexpr int L = 2;
        const int pb = 1 + 12 * L; const bool dsa = L < N_A; const int Lb = L - N_A;
        for (int rep = 0; rep < REP1; ++rep) if (IN(pb + 1) && !NOS1) { SITE();
            const bf16* Bt = dsa ? (const bf16*)(wsp + WS_WIN) + (size_t)L * A_INP * DM : (const bf16*)(wsp + WS_WQB) + (size_t)Lb * DM * DM; const int N = dsa ? A_INP : DM;
            const bool part = DEFER_CONV && dsa && Gs == 256; const int Gg = part ? CONV_GG : Gs;
            pg8::Gemm g{XNB2, Bt, M, N, DM, 1}; pg8::StaticOrder S; S.init(M, N, Gg, bxs); if (part && bxs >= Gg) S.nwg = 0;
            pg8::rs_finalize(RTAB, S, SSQ(L == 0 ? 12 : 3 * (L - 1) + 2), tids);
            pg8::EpiBf16Map E{dsa ? 1 : 0, Qb, DM, KVA, QIb, KIWb, RTAB, KITb};
            pg8::gemm_phase<pg8::EpiBf16Map, pg8::StaticOrder, true, true>(lds, g, S, E);
            if (part && rep == 0 && bxs >= Gg) {
                __syncthreads();
                LAS float* scr = (LAS float*)(lds + waves * 16640); int rot = 0; const int gw2 = (bxs - Gg) * NWAVES + waves, NGW2 = (Gs - Gg) * NWAVES; const int Ld = L + 1;
                conv_matrix(args.in[12] + (size_t)Ld * DM * DFF, args.in[11] + (size_t)Ld * DM, DM, DFF, (bf16*)(wsp + WS_W13) + (size_t)Ld * 2 * DFF * DM, 3, scr, gw2, NGW2, lanes, rot);
                conv_matrix(args.in[13] + (size_t)Ld * DM * DFF, args.in[11] + (size_t)Ld * DM, DM, DFF, (bf16*)(wsp + WS_W13) + (size_t)Ld * 2 * DFF * DM, 4, scr, gw2, NGW2, lanes, rot);
                if (L == 0) { conv_matrix(args.in[17] + (size_t)1 * DM * DM, args.in[15] + (size_t)1 * DM, DM, DM, (bf16*)(wsp + WS_WPG) + (size_t)1 * DM * DM, 0, scr, gw2, NGW2, lanes, rot);
                              conv_matrix(args.in[3] + (size_t)1 * DM * DM, nullptr, DM, DM, (bf16*)(wsp + WS_WOA) + (size_t)1 * DM * DM, 0, scr, gw2, NGW2, lanes, rot); }
                else conv_matrix(args.in[14] + (size_t)2 * DFF * DM, nullptr, DFF, DM, (bf16*)(wsp + WS_W2) + (size_t)2 * DM * DFF, 0, scr, gw2, NGW2, lanes, rot);
            }
            GRID_BAR();
        }
#ifndef NO_IDX
        for (int rep = 0; rep < REP2; ++rep) if (dsa && IN(pb + 2)) { SITE(); indexer_phase(lds, QIb, KIWb, KITb, IDXb, bxs, Gs, tids, waves, lanes); GRID_BAR(); }
#endif
        for (int rep = 0; rep < (dsa ? REP3D : REP3S); ++rep) if (IN(pb + 3)) { SITE();
#ifndef NO_DSA
            if (dsa) dsa_attn_phase(lds, Qb, (const unsigned char*)KVA, IDXb, AOb, args.in[9], bxs, Gs, tids, waves, lanes);
#endif
#ifndef NO_SWA
            if (!dsa) swa_attn_phase(lds, Qb, KVB, AOb, args.in[9], args.in[6] + (size_t)Lb * NHEAD, bxs, Gs, tids, waves, lanes);
#endif
            GRID_BAR();
        }
        for (int rep = 0; rep < REP4; ++rep) if (IN(pb + 4) && !NOS4) { SITE();
            const bf16* Bt = dsa ? (const bf16*)(wsp + WS_WOA) + (size_t)L * DM * DM : (const bf16*)(wsp + WS_WOB) + (size_t)Lb * DM * DM;
            pg8::Gemm g{AOb, Bt, M, DM, DM}; pg8::StaticOrder S; S.init(M, DM, Gs, bxs);
            pg8::EpiResid E{XNB2, rep ? Qb : XN, rep ? (float*)(wsp + WS_QI) : SSQ(3 * L)};
            pg8::gemm_phase<pg8::EpiResid, pg8::StaticOrder, true, true>(lds, g, S, E);
            GROUP_BAR();
        }
        for (int rep = 0; rep < REP6; ++rep) if (IN(pb + 6) && !NOS6) { SITE();
            pg8::Gemm g{XN, (const bf16*)(wsp + WS_W13) + (size_t)L * 2 * DFF * DM, M, 2 * DFF, DM, 1}; pg8::StaticOrder S; S.init(M, 2 * DFF, Gs, bxs);
            pg8::rs_finalize(RTAB, S, SSQ(3 * L), tids);
            pg8::EpiSwiglu E{Ub, RTAB};
            pg8::gemm_phase<pg8::EpiSwiglu, pg8::StaticOrder, true, true>(lds, g, S, E);
            GROUP_BAR();
        }
        for (int rep = 0; rep < REP7; ++rep) if (IN(pb + 7) && !NOS7) { SITE();
            { pg8::Gemm g{Ub, (const bf16*)(wsp + WS_W2) + (size_t)L * DM * DFF, M, DM, DFF, 1}; pg8::StaticOrder S; S.init(M, DM, Gs, bxs);
              pg8::EpiResid E{XN, rep ? XNB2 : XN, rep ? SSQ(3 * L + 2) : SSQ(3 * L + 1)};
              pg8::gemm_phase<pg8::EpiResid, pg8::StaticOrder, true, true>(lds, g, S, E); }
            { pg8::Gemm g{PB + (size_t)L * M * PLE, (const bf16*)(wsp + WS_WPE) + (size_t)L * DM * PLE, M, DM, PLE}; pg8::StaticOrder S; S.init(M, DM, Gs, bxs);
              pg8::EpiBf16Map E{3, PEb, DM, nullptr, nullptr, nullptr, nullptr, nullptr};
              pg8::gemm_phase<pg8::EpiBf16Map, pg8::StaticOrder, true, true>(lds, g, S, E); }
            GROUP_BAR();
        }
        for (int rep = 0; rep < REP9; ++rep) if (IN(pb + 9) && !NOS9) { SITE();
            pg8::Gemm g{XN, (const bf16*)(wsp + WS_WPG) + (size_t)L * DM * DM, M, DM, DM, 1}; pg8::StaticOrder S; S.init(M, DM, Gs, bxs);
            pg8::rs_finalize(RTAB, S, SSQ(3 * L + 1), tids);
            pg8::EpiGate E{XN, PEb, RTAB, rep ? Qb : XNB2, rep ? (float*)(wsp + WS_QI) : SSQ(3 * L + 2)};
            pg8::gemm_phase<pg8::EpiGate, pg8::StaticOrder, true, true>(lds, g, S, E);
            if (L == DEPTH - 1 || L == N_A - 1) GROUP_BAR(); else GRID_BAR();
        }
        if (L == N_A - 1) {
            for (int rep = 0; rep < REP11; ++rep) if (IN(pb + 11) && !NOS11) { SITE();
                pg8::Gemm g{XNB2, (const bf16*)(wsp + WS_WKV), M, 1024, DM, 1}; pg8::StaticOrder S; S.init(M, 1024, Gs, bxs);
                pg8::rs_finalize(RTAB, S, SSQ(3 * L + 2), tids);
                pg8::EpiBf16Map E{2, nullptr, 0, KVB, nullptr, nullptr, RTAB, nullptr};
                pg8::gemm_phase<pg8::EpiBf16Map, pg8::StaticOrder, true, true>(lds, g, S, E);
                GRID_BAR();
            }
        }
        }
    { constexpr int L = 3;
        const int pb = 1 + 12 * L; const bool dsa = L < N_A; const int Lb = L - N_A;
        for (int rep = 0; rep < REP1; ++rep) if (IN(pb + 1) && !NOS1) { SITE();
            const bf16* Bt = dsa ? (const bf16*)(wsp + WS_WIN) + (size_t)L * A_INP * DM : (const bf16*)(wsp + WS_WQB) + (size_t)Lb * DM * DM; const int N = dsa ? A_INP : DM;
            const bool part = DEFER_CONV && dsa && Gs == 256; const int Gg = part ? CONV_GG : Gs;
            pg8::Gemm g{XNB2, Bt, M, N, DM, 1}; pg8::StaticOrder S; S.init(M, N, Gg, bxs); if (part && bxs >= Gg) S.nwg = 0;
            pg8::rs_finalize(RTAB, S, SSQ(L == 0 ? 12 : 3 * (L - 1) + 2), tids);
            pg8::EpiBf16Map E{dsa ? 1 : 0, Qb, DM, KVA, QIb, KIWb, RTAB, KITb};
            pg8::gemm_phase<pg8::EpiBf16Map, pg8::StaticOrder, true, true>(lds, g, S, E);
            if (part && rep == 0 && bxs >= Gg) {
                __syncthreads();
                LAS float* scr = (LAS float*)(lds + waves * 16640); int rot = 0; const int gw2 = (bxs - Gg) * NWAVES + waves, NGW2 = (Gs - Gg) * NWAVES; const int Ld = L + 1;
                conv_matrix(args.in[12] + (size_t)Ld * DM * DFF, args.in[11] + (size_t)Ld * DM, DM, DFF, (bf16*)(wsp + WS_W13) + (size_t)Ld * 2 * DFF * DM, 3, scr, gw2, NGW2, lanes, rot);
                conv_matrix(args.in[13] + (size_t)Ld * DM * DFF, args.in[11] + (size_t)Ld * DM, DM, DFF, (bf16*)(wsp + WS_W13) + (size_t)Ld * 2 * DFF * DM, 4, scr, gw2, NGW2, lanes, rot);
                if (L == 0) { conv_matrix(args.in[17] + (size_t)1 * DM * DM, args.in[15] + (size_t)1 * DM, DM, DM, (bf16*)(wsp + WS_WPG) + (size_t)1 * DM * DM, 0, scr, gw2, NGW2, lanes, rot);
                              conv_matrix(args.in[3] + (size_t)1 * DM * DM, nullptr, DM, DM, (bf16*)(wsp + WS_WOA) + (size_t)1 * DM * DM, 0, scr, gw2, NGW2, lanes, rot); }
                else conv_matrix(args.in[14] + (size_t)2 * DFF * DM, nullptr, DFF, DM, (bf16*)(wsp + WS_W2) + (size_t)2 * DM * DFF, 0, scr, gw2, NGW2, lanes, rot);
            }
            GRID_BAR();
        }
#ifndef NO_IDX
        for (int rep = 0; rep < REP2; ++rep) if (dsa && IN(pb + 2)) { SITE(); indexer_phase(lds, QIb, KIWb, KITb, IDXb, bxs, Gs, tids, waves, lanes); GRID_BAR(); }
#endif
        for (int rep = 0; rep < (dsa ? REP3D : REP3S); ++rep) if (IN(pb + 3)) { SITE();
#ifndef NO_DSA
            if (dsa) dsa_attn_phase(lds, Qb, (const unsigned char*)KVA, IDXb, AOb, args.in[9], bxs, Gs, tids, waves, lanes);
#endif
#ifndef NO_SWA
            if (!dsa) swa_attn_phase(lds, Qb, KVB, AOb, args.in[9], args.in[6] + (size_t)Lb * NHEAD, bxs, Gs, tids, waves, lanes);
#endif
            GRID_BAR();
        }
        for (int rep = 0; rep < REP4; ++rep) if (IN(pb + 4) && !NOS4) { SITE();
            const bf16* Bt = dsa ? (const bf16*)(wsp + WS_WOA) + (size_t)L * DM * DM : (const bf16*)(wsp + WS_WOB) + (size_t)Lb * DM * DM;
            pg8::Gemm g{AOb, Bt, M, DM, DM}; pg8::StaticOrder S; S.init(M, DM, Gs, bxs);
            pg8::EpiResid E{XNB2, rep ? Qb : XN, rep ? (float*)(wsp + WS_QI) : SSQ(3 * L)};
            pg8::gemm_phase<pg8::EpiResid, pg8::StaticOrder, true, true>(lds, g, S, E);
            GROUP_BAR();
        }
        for (int rep = 0; rep < REP6; ++rep) if (IN(pb + 6) && !NOS6) { SITE();
            pg8::Gemm g{XN, (const bf16*)(wsp + WS_W13) + (size_t)L * 2 * DFF * DM, M, 2 * DFF, DM, 1}; pg8::StaticOrder S; S.init(M, 2 * DFF, Gs, bxs);
            pg8::rs_finalize(RTAB, S, SSQ(3 * L), tids);
            pg8::EpiSwiglu E{Ub, RTAB};
            pg8::gemm_phase<pg8::EpiSwiglu, pg8::StaticOrder, true, true>(lds, g, S, E);
            GROUP_BAR();
        }
        for (int rep = 0; rep < REP7; ++rep) if (IN(pb + 7) && !NOS7) { SITE();
            { pg8::Gemm g{Ub, (const bf16*)(wsp + WS_W2) + (size_t)L * DM * DFF, M, DM, DFF, 1}; pg8::StaticOrder S; S.init(M, DM, Gs, bxs);
              pg8::EpiResid E{XN, rep ? XNB2 : XN, rep ? SSQ(3 * L + 2) : SSQ(3 * L + 1)};
              pg8::gemm_phase<pg8::EpiResid, pg8::StaticOrder, true, true>(lds, g, S, E); }
            { pg8::Gemm g{PB + (size_t)L * M * PLE, (const bf16*)(wsp + WS_WPE) + (size_t)L * DM * PLE, M, DM, PLE}; pg8::StaticOrder S; S.init(M, DM, Gs, bxs);
              pg8::EpiBf16Map E{3, PEb, DM, nullptr, nullptr, nullptr, nullptr, nullptr};
              pg8::gemm_phase<pg8::EpiBf16Map, pg8::StaticOrder, true, true>(lds, g, S, E); }
            GROUP_BAR();
        }
        for (int rep = 0; rep < REP9; ++rep) if (IN(pb + 9) && !NOS9) { SITE();
            pg8::Gemm g{XN, (const bf16*)(wsp + WS_WPG) + (size_t)L * DM * DM, M, DM, DM, 1}; pg8::StaticOrder S; S.init(M, DM, Gs, bxs);
            pg8::rs_finalize(RTAB, S, SSQ(3 * L + 1), tids);
            pg8::EpiGate E{XN, PEb, RTAB, rep ? Qb : XNB2, rep ? (float*)(wsp + WS_QI) : SSQ(3 * L + 2)};
            pg8::gemm_phase<pg8::EpiGate, pg8::StaticOrder, true, true>(lds, g, S, E);
            if (L == DEPTH - 1 || L == N_A - 1) GROUP_BAR(); else GRID_BAR();
        }
        if (L == N_A - 1) {
            for (int rep = 0; rep < REP11; ++rep) if (IN(pb + 11) && !NOS11) { SITE();
                pg8::Gemm g{XNB2, (const bf16*)(wsp + WS_WKV), M, 1024, DM, 1}; pg8::StaticOrder S; S.init(M, 1024, Gs, bxs);
                pg8::rs_finalize(RTAB, S, SSQ(3 * L + 2), tids);
                pg8::EpiBf16Map E{2, nullptr, 0, KVB, nullptr, nullptr, RTAB, nullptr};
                pg8::gemm_phase<pg8::EpiBf16Map, pg8::StaticOrder, true, true>(lds, g, S, E);
                GRID_BAR();
            }
        }
        }

    if (IN(PH_FINAL)) { SITE();
        if (!MK_PER_PHASE && GRP_BAR && Gs == 256) { const int r0 = 256 * (8 * (bxs % 8) + (bxs / 8) % 8) + 64 * ((bxs / 8) / 8);
            final_norm_phase(XNB2, args.in[18], X, r0 + waves, NWAVES, r0 + 64, lanes); }
        else final_norm_phase(XNB2, args.in[18], X, gws, NGWs, M, lanes); }
#undef IN
#undef SITE
#undef GRID_BAR
#undef GROUP_BAR
#undef x_in
#undef X
#undef XN
#undef Qb
#undef AOb
#undef QIb
#undef KIWb
#undef IDXb
#undef KITb
#undef KVA
#undef KVB
#undef Ub
#undef PEb
#undef PB
#undef XNB2
#undef SSQ
#undef RTAB
}

static bool phase_exists(int p) {
    if (p == 0 || p == PH_FINAL) return true;
    if (p < 0 || p > PH_FINAL) return false;
    const int L = (p - 1) / 12, s = (p - 1) % 12;
    if (s == 0 || s == 5 || s == 8 || s == 10) return false;
    if (s == 2) return L < N_A;
    if (s == 11) return L == N_A - 1;
    return true;
}
extern "C" void kernel_launch(void* const* d_in, const int* in_sizes, int n_in, void* d_out, int out_size, void* d_ws, size_t ws_size, hipStream_t stream) {
    static int grid = 0;
    if (grid == 0) {
        if (n_in != 19 || in_sizes[0] != M * DM || out_size != M * DM || ws_size < WS_END) { fprintf(stderr, "kernel_launch: shape/workspace mismatch (n_in %d, in0 %d, out %d, ws %zu, need %zu); nothing launched\n", n_in, n_in > 0 ? in_sizes[0] : -1, out_size, ws_size, (size_t)WS_END); grid = -1; return; }
        int dev = 0, cus = 0, per_cu = 0;
        if (hipGetDevice(&dev) != hipSuccess || hipDeviceGetAttribute(&cus, hipDeviceAttributeMultiprocessorCount, dev) != hipSuccess) { fprintf(stderr, "kernel_launch: device query failed\n"); grid = -1; return; }
        if (hipFuncSetAttribute((const void*)yoco_fwd, hipFuncAttributeMaxDynamicSharedMemorySize, LDS_BYTES) != hipSuccess) { fprintf(stderr, "kernel_launch: hipFuncSetAttribute failed\n"); grid = -1; return; }
        if (hipOccupancyMaxActiveBlocksPerMultiprocessor(&per_cu, (const void*)yoco_fwd, NWAVES * 64, LDS_BYTES) != hipSuccess || per_cu < 1) fprintf(stderr, "kernel_launch: note: occupancy query reports %d workgroups per CU\n", per_cu);
        (void)hipGetLastError();
        grid = cus;
    }
    if (grid < 0) return;
    if (hipMemsetAsync((char*)d_ws + WS_CTL, 0, CTL_ZERO_BYTES, stream) != hipSuccess) { fprintf(stderr, "kernel_launch: memset failed\n"); return; }
    Args a{};
    for (int i = 0; i < 19; ++i) a.in[i] = (const float*)d_in[i];
    a.out = (float*)d_out; a.ws = (unsigned char*)d_ws;
#if MK_PER_PHASE
    for (int p = 0; p < PH_END; ++p) { if (!phase_exists(p)) continue; a.ph_lo = p; a.ph_hi = p + 1;
        hipLaunchKernelGGL(yoco_fwd, dim3(grid), dim3(NWAVES * 64), LDS_BYTES, stream, a); }
#else
    a.ph_lo = 0; a.ph_hi = PH_END;
    hipLaunchKernelGGL(yoco_fwd, dim3(grid), dim3(NWAVES * 64), LDS_BYTES, stream, a);
#endif
    const hipError_t le = hipPeekAtLastError();
    if (le != hipSuccess) fprintf(stderr, "kernel_launch: launch failed: %s\n", hipGetErrorName(le));
}
```
